# Optimizing an MI355X kernel written in HIP

```python
import math
import jax, jax.numpy as jnp
from jax import lax
import numpy as np

D_MODEL = 1024
BATCH = 8
SEQ = 2048
DEPTH = 2

MIX_WIDTH = D_MODEL
ATTN_WIDTH = MIX_WIDTH // 2
REC_WIDTH = MIX_WIDTH - ATTN_WIDTH
ATTN_HEAD_DIM = 64
ATTN_HEADS = ATTN_WIDTH // ATTN_HEAD_DIM
DILATED_PATTERNS = ((128, 1), (512, 4), (2048, 16))
ROPE_THETA = 10000.0
REC_EXPAND = 128
REC_HEADS = REC_WIDTH // REC_EXPAND
REC_HEAD_DIM = REC_WIDTH // REC_HEADS
REC_CHUNK = 64
IN_SPLIT_SIZES = (ATTN_WIDTH, ATTN_WIDTH, ATTN_WIDTH,
                  REC_HEADS * REC_EXPAND, REC_HEADS * REC_EXPAND, REC_HEADS * REC_EXPAND,
                  REC_WIDTH, REC_WIDTH)
IN_COLS = sum(IN_SPLIT_SIZES)
D_FF_DENSE = ((8 * D_MODEL // 3 + 63) // 64) * 64
N_EXPERTS = 8
TOP_K = 2
D_FF_EXPERT = 7 * D_MODEL // 2
N_DENSE = (DEPTH + 1) // 2
N_MOE = DEPTH // 2
DN_ALPHA = (2 * DEPTH) ** 0.25
DN_BETA = (8 * DEPTH) ** -0.25
LN_EPS = 1e-5
RMS_EPS = 1e-6
MASK_VALUE = -1e30
POS_OFFSET_RANGE = 4096

kernel_name = "hybrid_dilated_attn_hgrn2_moe_encoder"


def layer_norm(x, gain, bias):
    xf = x.astype(jnp.float32)
    mu = jnp.mean(xf, axis=-1, keepdims=True)
    var = jnp.mean(jnp.square(xf - mu), axis=-1, keepdims=True)
    return ((xf - mu) * lax.rsqrt(var + LN_EPS)).astype(x.dtype) * gain + bias


def rms_norm(x, gain):
    xf = x.astype(jnp.float32)
    y = xf * lax.rsqrt(jnp.mean(xf * xf, axis=-1, keepdims=True) + RMS_EPS)
    return y.astype(x.dtype) * gain


def rope(x, positions):
    half = x.shape[-1] // 2
    inv_freq = ROPE_THETA ** (-jnp.arange(half, dtype=jnp.float32) / half)
    ang = positions.astype(jnp.float32)[..., None] * inv_freq
    cos = jnp.cos(ang)[:, :, None, :]
    sin = jnp.sin(ang)[:, :, None, :]
    xf = x.astype(jnp.float32)
    x1, x2 = xf[..., :half], xf[..., half:]
    return jnp.concatenate([x1 * cos - x2 * sin, x2 * cos + x1 * sin], axis=-1)


def split_columns(proj):
    parts, start = [], 0
    for size in IN_SPLIT_SIZES:
        parts.append(proj[..., start:start + size])
        start += size
    return parts


def dilated_window_attention(q, k, v, dilation, radius):
    B, H, S, dh = q.shape
    L = S // dilation
    blk = radius
    nb = -(-L // blk)
    Lp = nb * blk

    def to_residue(t):
        t = t.reshape(B, H, L, dilation, dh).transpose(0, 1, 3, 2, 4)
        return jnp.pad(t, ((0, 0), (0, 0), (0, 0), (0, Lp - L), (0, 0)))

    def key_windows(t):
        t = jnp.pad(to_residue(t), ((0, 0), (0, 0), (0, 0), (blk, blk), (0, 0)))
        t = t.reshape(B, H, dilation, nb + 2, blk, dh)
        return jnp.concatenate([t[:, :, :, :-2], t[:, :, :, 1:-1], t[:, :, :, 2:]], axis=4)

    qb = to_residue(q).reshape(B, H, dilation, nb, blk, dh)
    kw = key_windows(k)
    vw = key_windows(v)
    scores = jnp.einsum('bhrnqd,bhrnkd->bhrnqk', qb, kw)
    q_idx = jnp.arange(nb)[:, None, None] * blk + jnp.arange(blk)[None, :, None]
    k_idx = (jnp.arange(nb)[:, None, None] - 1) * blk + jnp.arange(3 * blk)[None, None, :]
    valid = (jnp.abs(k_idx - q_idx) <= radius) & (k_idx >= 0) & (k_idx < L)
    scores = jnp.where(valid, scores, MASK_VALUE)
    m = jnp.max(scores, axis=-1, keepdims=True)
    p = jnp.exp(scores - m)
    denom = jnp.sum(p, axis=-1, keepdims=True)
    out = jnp.einsum('bhrnqk,bhrnkd->bhrnqd', p, vw) / denom
    lse = (m + jnp.log(denom))[..., 0]
    out = out.reshape(B, H, dilation, Lp, dh)[:, :, :, :L].transpose(0, 1, 3, 2, 4).reshape(B, H, S, dh)
    lse = lse.reshape(B, H, dilation, Lp)[:, :, :, :L].transpose(0, 1, 3, 2).reshape(B, H, S)
    return out, lse


def dilated_mixture_attention(q, k, v):
    outs, lses = [], []
    for window, dilation in DILATED_PATTERNS:
        o, l = dilated_window_attention(q, k, v, dilation, window // (2 * dilation))
        outs.append(o)
        lses.append(l)
    w = jax.nn.softmax(jnp.stack(lses, axis=0), axis=0)
    return jnp.einsum('pbhs,pbhsd->bhsd', w, jnp.stack(outs, axis=0))


def gla_chunk_scan(q, k, v, log_f):
    B, H, S, dk = q.shape
    dv = v.shape[-1]
    C = REC_CHUNK
    nc = S // C
    causal = jnp.tril(jnp.ones((C, C), dtype=bool))[:, :, None]

    def split(t):
        return t.reshape(B, H, nc, C, t.shape[-1]).transpose(2, 0, 1, 3, 4)

    def step(state, inp):
        qc, kc, vc, gc = inp
        b = jnp.cumsum(gc, axis=2)
        inter = jnp.einsum('bhtc,bhcv->bhtv', qc * jnp.exp(b), state)
        diff = b[:, :, :, None, :] - b[:, :, None, :, :]
        decay = jnp.exp(jnp.where(causal, diff, -jnp.inf))
        attn = jnp.einsum('bhtc,bhsc,bhtsc->bhts', qc, kc, decay)
        out = inter + jnp.einsum('bhts,bhsv->bhtv', attn, vc)
        b_last = b[:, :, -1, :]
        state = (jnp.exp(b_last)[..., None] * state
                 + jnp.einsum('bhsc,bhsv->bhcv', kc * jnp.exp(b_last[:, :, None, :] - b), vc))
        return state, out

    state0 = jnp.zeros((B, H, dk, dv), jnp.float32)
    _, out = lax.scan(step, state0, (split(q), split(k), split(v), split(log_f)))
    return out.transpose(1, 2, 0, 3, 4).reshape(B, H, S, dv)


def hgrn2_direction(q, f_logit, v, lb):
    lb = lb[None, :, None, :]
    log_f = jnp.logaddexp(jnp.log(lb), jnp.log1p(-lb) + jax.nn.log_sigmoid(f_logit))
    k = (1.0 - lb) * jax.nn.sigmoid(-f_logit)
    return gla_chunk_scan(q, k, v, log_f)


def lower_bounds(lb_logits):
    p = jax.nn.softmax(lb_logits.astype(jnp.float32), axis=0)
    cum = jnp.cumsum(p, axis=0)
    return cum - cum[0:1]


def hybrid_mixer(u, positions, w_in, w_out, attn_gain, rec_gain, lb):
    B, S, _ = u.shape
    proj = u @ w_in
    aq, ak, av, rq, rf_fwd, rf_bwd, ri, rg = split_columns(proj)

    q = rope(aq.reshape(B, S, ATTN_HEADS, ATTN_HEAD_DIM), positions) * (ATTN_HEAD_DIM ** -0.5)
    k = rope(ak.reshape(B, S, ATTN_HEADS, ATTN_HEAD_DIM), positions)
    v = av.reshape(B, S, ATTN_HEADS, ATTN_HEAD_DIM).astype(jnp.float32)
    q, k, v = (t.transpose(0, 2, 1, 3) for t in (q, k, v))
    attn = dilated_mixture_attention(q, k, v)
    attn = attn.transpose(0, 2, 1, 3).reshape(B, S, ATTN_WIDTH)
    attn = rms_norm(attn, attn_gain).astype(u.dtype)

    def rec_heads(t, d):
        return t.reshape(B, S, REC_HEADS, d).transpose(0, 2, 1, 3).astype(jnp.float32)

    def flip(t):
        return jnp.flip(t, axis=2)

    lb = lb.reshape(2, REC_HEADS, REC_EXPAND)
    rq_h = rec_heads(jax.nn.silu(rq), REC_EXPAND)
    ri_h = rec_heads(ri, REC_HEAD_DIM)
    o_fwd = hgrn2_direction(rq_h, rec_heads(rf_fwd, REC_EXPAND), ri_h, lb[0])
    o_bwd = flip(hgrn2_direction(flip(rq_h), flip(rec_heads(rf_bwd, REC_EXPAND)), flip(ri_h), lb[1]))
    rec = (o_fwd + o_bwd).transpose(0, 2, 1, 3)
    rec = rms_norm(rec, rec_gain.reshape(REC_HEADS, REC_HEAD_DIM)).reshape(B, S, REC_WIDTH)
    rec = rec.astype(u.dtype) * jax.nn.sigmoid(rg)

    return jnp.concatenate([attn, rec], axis=-1) @ w_out


def swiglu(u, w_gate, w_up, w_down):
    return (jax.nn.silu(u @ w_gate) * (u @ w_up)) @ w_down


def moe_swiglu(u, w_router, w_gate, w_up, w_down):
    B, S, D = u.shape
    t = u.reshape(B * S, D)
    logits = (t @ w_router).astype(jnp.float32)
    top_vals, top_idx = lax.top_k(logits, TOP_K)
    top_w = jax.nn.softmax(top_vals, axis=-1)
    combine = jnp.einsum('tk,tke->te', top_w, jax.nn.one_hot(top_idx, N_EXPERTS, dtype=jnp.float32))
    combine = combine.astype(u.dtype)
    out = jnp.zeros_like(t)
    for e in range(N_EXPERTS):
        out = out + combine[:, e:e + 1] * swiglu(t, w_gate[e], w_up[e], w_down[e])
    return out.reshape(B, S, D)


def ada_modulation(c_act, w_ada, b_ada):
    ada = (c_act @ w_ada + b_ada)[:, None, :]
    return ada[..., :D_MODEL], ada[..., D_MODEL:2 * D_MODEL], ada[..., 2 * D_MODEL:]


def setup_inputs(seed: int = 0) -> dict:
    key = jax.random.key(seed)
    ks = jax.random.split(key, 20)

    def nrm(k, shape, s):
        return jax.random.normal(k, shape, jnp.float32) * s

    x = nrm(ks[0], (BATCH, SEQ, D_MODEL), 1.0)
    c = nrm(ks[1], (BATCH, D_MODEL), 1.0)
    positions = (jax.random.randint(ks[2], (BATCH, 1), 0, POS_OFFSET_RANGE, jnp.int32)
                 + jnp.arange(SEQ, dtype=jnp.int32)[None, :])
    w_in = nrm(ks[3], (DEPTH, D_MODEL, IN_COLS), D_MODEL ** -0.5)
    w_out = nrm(ks[4], (DEPTH, MIX_WIDTH, D_MODEL), MIX_WIDTH ** -0.5 * DN_BETA)
    attn_norm_gain = 1.0 + nrm(ks[5], (DEPTH, ATTN_WIDTH), 0.02)
    rec_norm_gain = 1.0 + nrm(ks[6], (DEPTH, REC_WIDTH), 0.02)
    rec_lb_logits = nrm(ks[7], (DEPTH, 2, REC_WIDTH), 0.5)
    ada_w = nrm(ks[8], (DEPTH, 2, D_MODEL, 3 * D_MODEL), 0.01)
    ada_b = nrm(ks[9], (DEPTH, 2, 3 * D_MODEL), 0.02)
    ln_gain = 1.0 + nrm(ks[10], (DEPTH, 2, D_MODEL), 0.02)
    ln_bias = nrm(ks[11], (DEPTH, 2, D_MODEL), 0.02)
    ffn_w_gate = nrm(ks[12], (N_DENSE, D_MODEL, D_FF_DENSE), D_MODEL ** -0.5)
    ffn_w_up = nrm(ks[13], (N_DENSE, D_MODEL, D_FF_DENSE), D_MODEL ** -0.5)
    ffn_w_down = nrm(ks[14], (N_DENSE, D_FF_DENSE, D_MODEL), D_FF_DENSE ** -0.5 * DN_BETA)
    moe_router = nrm(ks[15], (N_MOE, D_MODEL, N_EXPERTS), D_MODEL ** -0.5)
    moe_w_gate = nrm(ks[16], (N_MOE, N_EXPERTS, D_MODEL, D_FF_EXPERT), D_MODEL ** -0.5)
    moe_w_up = nrm(ks[17], (N_MOE, N_EXPERTS, D_MODEL, D_FF_EXPERT), D_MODEL ** -0.5)
    moe_w_down = nrm(ks[18], (N_MOE, N_EXPERTS, D_FF_EXPERT, D_MODEL), D_FF_EXPERT ** -0.5 * DN_BETA)
    return {"x": x, "c": c, "positions": positions, "w_in": w_in, "w_out": w_out,
            "attn_norm_gain": attn_norm_gain, "rec_norm_gain": rec_norm_gain,
            "rec_lb_logits": rec_lb_logits, "ada_w": ada_w, "ada_b": ada_b,
            "ln_gain": ln_gain, "ln_bias": ln_bias,
            "ffn_w_gate": ffn_w_gate, "ffn_w_up": ffn_w_up, "ffn_w_down": ffn_w_down,
            "moe_router": moe_router, "moe_w_gate": moe_w_gate, "moe_w_up": moe_w_up,
            "moe_w_down": moe_w_down}


def reference(x, c, positions, w_in, w_out, attn_norm_gain, rec_norm_gain, rec_lb_logits,
              ada_w, ada_b, ln_gain, ln_bias, ffn_w_gate, ffn_w_up, ffn_w_down,
              moe_router, moe_w_gate, moe_w_up, moe_w_down):
    lb_all = lower_bounds(rec_lb_logits)
    c_act = jax.nn.silu(c)
    for layer in range(DEPTH):
        shift, scale, gate = ada_modulation(c_act, ada_w[layer, 0], ada_b[layer, 0])
        u = x * (1.0 + scale) + shift
        y = hybrid_mixer(u, positions, w_in[layer], w_out[layer],
                         attn_norm_gain[layer], rec_norm_gain[layer], lb_all[layer])
        x = layer_norm(DN_ALPHA * x + (1.0 + gate) * y, ln_gain[layer, 0], ln_bias[layer, 0])
        shift, scale, gate = ada_modulation(c_act, ada_w[layer, 1], ada_b[layer, 1])
        u = x * (1.0 + scale) + shift
        j = layer // 2
        if layer % 2 == 0:
            y = swiglu(u, ffn_w_gate[j], ffn_w_up[j], ffn_w_down[j])
        else:
            y = moe_swiglu(u, moe_router[j], moe_w_gate[j], moe_w_up[j], moe_w_down[j])
        x = layer_norm(DN_ALPHA * x + (1.0 + gate) * y, ln_gain[layer, 1], ln_bias[layer, 1])
    return x
```

```cpp
#include <hip/hip_runtime.h>
#include <cstdio>
#include <cstdint>
#include <cmath>
#define MK_N_LAUNCHES 0
namespace pg8 {
#define PG8_LAS __attribute__((address_space(3)))
typedef unsigned short bf16_t;
typedef short bf16x8 __attribute__((ext_vector_type(8)));
typedef float f32x4 __attribute__((ext_vector_type(4)));
typedef unsigned u32x4 __attribute__((ext_vector_type(4)));
constexpr int BM = 256, BK = 64, HALF = 128, HTB = HALF * BK * 2  , STAGE_BYTES = 8 * HTB, NXCD = 8, WGM = 8;

__host__ __device__ __forceinline__ int lds_byte(int r, int c) { const int st = (r >> 4) * 2 + (c >> 5), rr = r & 15, cc = c & 31, ob = rr * 64 + cc * 2; return st * 1024 + (ob ^ (((ob >> 9) & 1) << 5)); }
__host__ __device__ __forceinline__ void stage_rc(int b, int& R, int& C) { const int st = b / 1024, sb = b % 1024, swz = sb ^ (((sb >> 9) & 1) << 5); R = (st >> 1) * 16 + swz / 64; C = (st & 1) * 32 + (swz % 64) / 2; }
__host__ __device__ __forceinline__ int perm32(int rho) { const int n = rho >> 4, i = rho & 15; return 8 * (i >> 2) + 4 * n + (i & 3); }

struct Unit { int pm, pn; };
struct Gemm { const bf16_t* A; const bf16_t* Bt; int M, N, K; };

struct StaticOrder {
    int nM, nN, nwg, G, c;
    __host__ __device__ void init(int M, int N, int G_, int c_) { nM = M / BM; nN = N / BM; nwg = nM * nN; G = G_; c = c_; }
    __host__ __device__ bool next(int i, Unit& u) const {
        const long L = (long)i * G + c; if (L >= nwg) return false;
        int wgid = (int)L; { const int q = nwg / NXCD, r = nwg % NXCD, xcd = wgid % NXCD, off = wgid / NXCD; wgid = (xcd < r ? xcd * (q + 1) : r * (q + 1) + (xcd - r) * q) + off; }
        const int nig = WGM * nN, gid = wgid / nig, fm = gid * WGM, gsz = (nM - fm) < WGM ? (nM - fm) : WGM;
        u.pm = fm + ((wgid % nig) % gsz); u.pn = (wgid % nig) / gsz; return true;
    }
    __device__ __forceinline__ void a_ready(const Unit&) const {}
    __device__ __forceinline__ void done(const Unit&) const {}
};
__device__ __forceinline__ unsigned cvt_pk_bf16(float lo, float hi) { unsigned r; asm volatile("v_cvt_pk_bf16_f32 %0, %1, %2" : "=v"(r) : "v"(lo), "v"(hi)); return r; }

typedef float f32x2 __attribute__((ext_vector_type(2)));
typedef unsigned u32x2 __attribute__((ext_vector_type(2)));
__device__ __forceinline__ float fast_sigmoid(float x) { return __builtin_amdgcn_rcpf(1.0f + __expf(-x)); }
__device__ __forceinline__ float fast_silu(float x) { return x * fast_sigmoid(x); }

struct EpiIn {
    static constexpr bool PERM = false, AFTER_DRAIN = false;
    bf16_t* proj; const float* rope; const float* lb;
    __device__ __forceinline__ void operator()(const f32x4 (&acc)[2][2][4][2], const Unit& u, int wr, int wc, int fr, int fq) const {
        const int row0 = u.pm * BM + wr * 64 + fr;
        const int type = u.pn >> 1;
        if (type < 2) {
            const float sc = (type == 0) ? 0.125f : 1.0f;
            const int g = wc & 1;
#pragma unroll
            for (int ai = 0; ai < 2; ++ai)
#pragma unroll
                for (int m = 0; m < 4; ++m) {
                    const int row = row0 + ai * HALF + m * 16;
                    const f32x4* rp = (const f32x4*)(rope + ((size_t)row * 32 + 16 * g + 4 * fq) * 2);
                    const f32x4 cs0 = rp[0], cs1 = rp[1];
                    const float cc[4] = {cs0[0], cs0[2], cs1[0], cs1[2]}, ss[4] = {cs0[1], cs0[3], cs1[1], cs1[3]};
#pragma unroll
                    for (int bj = 0; bj < 2; ++bj) {
                        const int col = u.pn * BM + (2 * bj + (wc >> 1)) * 64 + 16 * g + 4 * fq;
                        const f32x4 x1 = acc[ai][bj][m][0], x2 = acc[ai][bj][m][1];
                        float o1[4], o2[4];
#pragma unroll
                        for (int j = 0; j < 4; ++j) { o1[j] = (x1[j] * cc[j] - x2[j] * ss[j]) * sc; o2[j] = (x2[j] * cc[j] + x1[j] * ss[j]) * sc; }
                        u32x2 w1, w2; w1.x = cvt_pk_bf16(o1[0], o1[1]); w1.y = cvt_pk_bf16(o1[2], o1[3]); w2.x = cvt_pk_bf16(o2[0], o2[1]); w2.y = cvt_pk_bf16(o2[2], o2[3]);
                        bf16_t* dst = proj + (size_t)row * 4096 + col;
                        *(u32x2*)dst = w1; *(u32x2*)(dst + 32) = w2;
                    }
                }
        } else {
            const int lc0 = u.pn * BM + wc * 32 + 8 * fq;
            f32x4 lbv[2][2];
            if (type == 4 || type == 5) {
#pragma unroll
                for (int bj = 0; bj < 2; ++bj)
#pragma unroll
                    for (int n = 0; n < 2; ++n) lbv[bj][n] = *(const f32x4*)(lb + (lc0 + bj * HALF - 2048) + 4 * n);
            }
#pragma unroll
            for (int ai = 0; ai < 2; ++ai)
#pragma unroll
                for (int m = 0; m < 4; ++m) {
                    const int row = row0 + ai * HALF + m * 16;
#pragma unroll
                    for (int bj = 0; bj < 2; ++bj) {
                        f32x4 v0 = acc[ai][bj][m][0], v1 = acc[ai][bj][m][1];
                        if (type == 3) {
#pragma unroll
                            for (int j = 0; j < 4; ++j) { v0[j] = fast_silu(v0[j]); v1[j] = fast_silu(v1[j]); }
                        } else if (type == 7) {
#pragma unroll
                            for (int j = 0; j < 4; ++j) { v0[j] = fast_sigmoid(v0[j]); v1[j] = fast_sigmoid(v1[j]); }
                        } else if (type == 4 || type == 5) {
#pragma unroll
                            for (int j = 0; j < 4; ++j) {
                                const float l0 = lbv[bj][0][j], l1 = lbv[bj][1][j];
                                v0[j] = __logf(l0 + (1.0f - l0) * fast_sigmoid(v0[j]));
                                v1[j] = __logf(l1 + (1.0f - l1) * fast_sigmoid(v1[j]));
                            }
                        }
                        u32x4 w; w.x = cvt_pk_bf16(v0[0], v0[1]); w.y = cvt_pk_bf16(v0[2], v0[3]); w.z = cvt_pk_bf16(v1[0], v1[1]); w.w = cvt_pk_bf16(v1[2], v1[3]);
                        *(u32x4*)(proj + (size_t)row * 4096 + lc0 + bj * HALF) = w;
                    }
                }
        }
    }
};

struct EpiRes {
    static constexpr bool PERM = false, AFTER_DRAIN = false;
    const float* xres; float* t; const float* gate; float alpha;
    __device__ __forceinline__ void operator()(const f32x4 (&acc)[2][2][4][2], const Unit& u, int wr, int wc, int fr, int fq) const {
        const int row0 = u.pm * BM + wr * 64 + fr, col0 = u.pn * BM + wc * 32 + 4 * fq;
        const int b = u.pm >> 3;
        f32x4 gv[2][2];
#pragma unroll
        for (int bj = 0; bj < 2; ++bj)
#pragma unroll
            for (int n = 0; n < 2; ++n) gv[bj][n] = *(const f32x4*)(gate + (size_t)b * 3072 + 2048 + col0 + bj * HALF + n * 16) + 1.0f;
#pragma unroll
        for (int ai = 0; ai < 2; ++ai)
#pragma unroll
            for (int m = 0; m < 4; ++m) {
                const size_t off = (size_t)(row0 + ai * HALF + m * 16) * 1024 + col0;
#pragma unroll
                for (int bj = 0; bj < 2; ++bj)
#pragma unroll
                    for (int n = 0; n < 2; ++n) {
                        const f32x4 xr = *(const f32x4*)(xres + off + bj * HALF + n * 16);
                        *(f32x4*)(t + off + bj * HALF + n * 16) = xr * alpha + gv[bj][n] * acc[ai][bj][m][n];
                    }
            }
    }
};

template <int ldh, int nNloc> struct EpiGU {
    static constexpr bool PERM = false, AFTER_DRAIN = false;
    bf16_t* hid;
    __device__ __forceinline__ void operator()(const f32x4 (&acc)[2][2][4][2], const Unit& u, int wr, int wc, int fr, int fq) const {
        const int row0 = u.pm * BM + wr * 64 + fr, col0 = (u.pn % nNloc) * HALF + wc * 32 + 8 * fq;
#pragma unroll
        for (int ai = 0; ai < 2; ++ai)
#pragma unroll
            for (int m = 0; m < 4; ++m) {
                const f32x4 g0 = acc[ai][0][m][0], g1 = acc[ai][0][m][1], u0 = acc[ai][1][m][0], u1 = acc[ai][1][m][1];
                f32x4 h0, h1;
#pragma unroll
                for (int j = 0; j < 4; ++j) { h0[j] = fast_silu(g0[j]) * u0[j]; h1[j] = fast_silu(g1[j]) * u1[j]; }
                u32x4 w; w.x = cvt_pk_bf16(h0[0], h0[1]); w.y = cvt_pk_bf16(h0[2], h0[3]); w.z = cvt_pk_bf16(h1[0], h1[1]); w.w = cvt_pk_bf16(h1[2], h1[3]);
                *(u32x4*)(hid + (size_t)(row0 + ai * HALF + m * 16) * ldh + col0) = w;
            }
    }
};

struct EpiMoeDn {
    static constexpr bool PERM = false, AFTER_DRAIN = false;
    const unsigned* rowinfo; bf16_t* yslot;
    __device__ __forceinline__ void operator()(const f32x4 (&acc)[2][2][4][2], const Unit& u, int wr, int wc, int fr, int fq) const {
        const int row0 = u.pm * BM + wr * 64 + fr, col0 = (u.pn & 3) * BM + wc * 32 + 4 * fq;
#pragma unroll
        for (int ai = 0; ai < 2; ++ai)
#pragma unroll
            for (int m = 0; m < 4; ++m) {
                const int row = row0 + ai * HALF + m * 16;
                const u32x2 inf = *(const u32x2*)(rowinfo + 2 * (size_t)row);
                if (inf.x != 0xffffffffu) {
                    const float w = __uint_as_float(inf.y);
                    bf16_t* dst = yslot + ((size_t)(inf.x >> 16) * 16384 + (inf.x & 0xffffu)) * 1024 + col0;
#pragma unroll
                    for (int bj = 0; bj < 2; ++bj)
#pragma unroll
                        for (int n = 0; n < 2; ++n) {
                            const f32x4 v = acc[ai][bj][m][n] * w;
                            u32x2 o; o.x = cvt_pk_bf16(v[0], v[1]); o.y = cvt_pk_bf16(v[2], v[3]);
                            *(u32x2*)(dst + bj * HALF + n * 16) = o;
                        }
                }
            }
    }
};

struct MoeOrder : StaticOrder {
    int ts1, ts2, ts3, ts4, ts5, ts6, ts7, nNloc;
    __device__ __forceinline__ bool next(int i, Unit& u) const {
        if (!StaticOrder::next(i, u)) return false;
        const int e = (u.pm >= ts1) + (u.pm >= ts2) + (u.pm >= ts3) + (u.pm >= ts4) + (u.pm >= ts5) + (u.pm >= ts6) + (u.pm >= ts7);
        u.pn += e * nNloc; return true;
    }
};

template <class Epi, class Sched, bool ALIGN_EPI = false, bool SP2 = false>
__device__ __forceinline__ void gemm_phase(PG8_LAS unsigned char* lds, const Gemm g, const Sched& S, const Epi& E) {
    const int tid = threadIdx.x, wid = __builtin_amdgcn_readfirstlane(tid >> 6), lane = tid & 63, wr = wid >> 2, wc = wid & 3, fr = lane & 15, fq = lane >> 4;
    const int K = g.K, nt = K / BK;
    unsigned voffA[2], voffB[2];
#pragma unroll
    for (int i = 0; i < 2; ++i) { int R, C; stage_rc(tid * 16 + i * 8192, R, C); const int Rb = Epi::PERM ? ((R & ~31) + perm32(R & 31)) : R;
        voffA[i] = (unsigned)(R * K + C) * 2u; voffB[i] = (unsigned)(Rb * K + C) * 2u; }
    const size_t kstep = (size_t)(BK * 2);
    const size_t hstep = (size_t)HALF * K * 2;
    const size_t tstep = 2 * hstep;
    const unsigned ldsw = (unsigned)wid * 1024u;
    const int aoff = lds_byte(wr * 64 + fr, fq * 8), boff = lds_byte(wc * 32 + fr, fq * 8);
#define PG8_SA(b, h) (((b) * 2 + (h)) * HTB)
#define PG8_SB(b, h) ((4 + (b) * 2 + (h)) * HTB)
#define PG8_STAGE(bufoff, gbase, voff) do { _Pragma("unroll") for (int _i = 0; _i < 2; ++_i) \
        __builtin_amdgcn_global_load_lds((const unsigned*)((const char*)(gbase) + (voff)[_i]), (PG8_LAS unsigned*)(lds + (bufoff) + ldsw + _i * 8192), 16, 0, 0); } while (0)
#define PG8_LDA(dst, b, h) do { _Pragma("unroll") for (int m = 0; m < 4; ++m) _Pragma("unroll") for (int k = 0; k < 2; ++k) dst[m][k] = *(const PG8_LAS bf16x8*)(lds + PG8_SA(b, h) + aoff + m * 2048 + k * 1024); } while (0)
#define PG8_LDB(dst, b, h) do { _Pragma("unroll") for (int n = 0; n < 2; ++n) _Pragma("unroll") for (int k = 0; k < 2; ++k) dst[n][k] = *(const PG8_LAS bf16x8*)(lds + PG8_SB(b, h) + boff + n * 2048 + k * 1024); } while (0)
#define PG8_MMA(ai, bj, At, Bt) do { __builtin_amdgcn_s_setprio(1); _Pragma("unroll") for (int m = 0; m < 4; ++m) _Pragma("unroll") for (int n = 0; n < 2; ++n) _Pragma("unroll") for (int k = 0; k < 2; ++k) \
        acc[ai][bj][m][n] = __builtin_amdgcn_mfma_f32_16x16x32_bf16(Bt[n][k], At[m][k], acc[ai][bj][m][n], 0, 0, 0); __builtin_amdgcn_s_setprio(0); } while (0)
#define PG8_WAIT_V(n) asm volatile("s_waitcnt vmcnt(" #n ")" ::: "memory")
#define PG8_WAIT_L(n) asm volatile("s_waitcnt lgkmcnt(" #n ")" ::: "memory")
#define PG8_BAR __builtin_amdgcn_s_barrier()
#define PG8_SCHED __builtin_amdgcn_sched_barrier(0)
    Unit cur, nxt; int ui = 0;
    if (!S.next(0, cur)) return;
    f32x4 acc[2][2][4][2];
#pragma unroll
    for (int a = 0; a < 2; ++a)
#pragma unroll
        for (int b = 0; b < 2; ++b)
#pragma unroll
            for (int m = 0; m < 4; ++m)
#pragma unroll
                for (int n = 0; n < 2; ++n) acc[a][b][m][n] = (f32x4){0.f, 0.f, 0.f, 0.f};
    bf16x8 At[4][2], B0[2][2], B1[2][2];
    const char* cA = (const char*)g.A + (size_t)cur.pm * tstep; const char* cB = (const char*)g.Bt + (size_t)cur.pn * tstep;
    S.a_ready(cur);
    if constexpr (SP2) {
        PG8_STAGE(PG8_SB(0, 0), cB, voffB); PG8_STAGE(PG8_SB(0, 1), cB + hstep, voffB); PG8_STAGE(PG8_SA(0, 0), cA, voffA); PG8_STAGE(PG8_SA(0, 1), cA + hstep, voffA);
        if (wr == 1) PG8_BAR;
        PG8_WAIT_V(2); PG8_BAR;
        PG8_STAGE(PG8_SB(1, 0), cB + kstep, voffB); PG8_STAGE(PG8_SA(1, 0), cA + kstep, voffA); PG8_STAGE(PG8_SB(1, 1), cB + hstep + kstep, voffB);
        PG8_WAIT_V(6); PG8_BAR;
    } else {
        PG8_STAGE(PG8_SB(0, 0), cB, voffB); PG8_STAGE(PG8_SA(0, 0), cA, voffA); PG8_STAGE(PG8_SB(0, 1), cB + hstep, voffB); PG8_STAGE(PG8_SA(0, 1), cA + hstep, voffA);
        if (wr == 1) PG8_BAR;
        PG8_WAIT_V(4); PG8_BAR;
        PG8_STAGE(PG8_SB(1, 0), cB + kstep, voffB); PG8_STAGE(PG8_SA(1, 0), cA + kstep, voffA); PG8_STAGE(PG8_SB(1, 1), cB + hstep + kstep, voffB);
        PG8_WAIT_V(6); PG8_BAR;
    }
    for (;;) {
        const bool has_next = S.next(ui + 1, nxt);
        const char* nA = has_next ? (const char*)g.A + (size_t)nxt.pm * tstep : cA; const char* nB = has_next ? (const char*)g.Bt + (size_t)nxt.pn * tstep : cB;
        for (int t = 0; t < nt; t += 2) {
            const bool last = (t == nt - 2);
            const char* a1 = cA + (size_t)(t + 1) * kstep;
            const char* a2 = last ? nA : cA + (size_t)(t + 2) * kstep; const char* b2 = last ? nB : cB + (size_t)(t + 2) * kstep;
            const char* a3 = a2 + kstep; const char* b3 = b2 + kstep;
            if (last && has_next) S.a_ready(nxt);
            if constexpr (SP2) {
            PG8_LDB(B0, 0, 0); PG8_LDB(B1, 0, 1); PG8_SCHED; PG8_LDA(At, 0, 0); PG8_STAGE(PG8_SA(1, 1), a1 + hstep, voffA);
            PG8_WAIT_V(8); PG8_WAIT_L(0); PG8_BAR; PG8_MMA(0, 0, At, B0); PG8_MMA(0, 1, At, B1); PG8_BAR; PG8_SCHED;
            PG8_LDA(At, 0, 1); PG8_STAGE(PG8_SB(0, 0), b2, voffB); PG8_STAGE(PG8_SB(0, 1), b2 + hstep, voffB); PG8_STAGE(PG8_SA(0, 0), a2, voffA);
            PG8_WAIT_V(8); PG8_WAIT_L(0); PG8_BAR; PG8_MMA(1, 0, At, B0); PG8_MMA(1, 1, At, B1); PG8_BAR; PG8_SCHED;
            PG8_LDB(B0, 1, 0); PG8_LDB(B1, 1, 1); PG8_SCHED; PG8_LDA(At, 1, 0); PG8_STAGE(PG8_SA(0, 1), a2 + hstep, voffA);
            PG8_WAIT_V(8); PG8_WAIT_L(0); PG8_BAR; PG8_MMA(0, 0, At, B0); PG8_MMA(0, 1, At, B1); PG8_BAR; PG8_SCHED;
            PG8_LDA(At, 1, 1); PG8_STAGE(PG8_SB(1, 0), b3, voffB); PG8_STAGE(PG8_SB(1, 1), b3 + hstep, voffB); PG8_STAGE(PG8_SA(1, 0), a3, voffA);
            PG8_WAIT_V(8); PG8_WAIT_L(0); PG8_BAR; PG8_MMA(1, 0, At, B0); PG8_MMA(1, 1, At, B1); PG8_BAR; PG8_SCHED;
            } else {
            PG8_LDB(B0, 0, 0); PG8_SCHED; PG8_LDA(At, 0, 0); PG8_STAGE(PG8_SA(1, 1), a1 + hstep, voffA);
            PG8_WAIT_L(8); PG8_BAR; PG8_WAIT_L(0); PG8_MMA(0, 0, At, B0); PG8_BAR; PG8_SCHED;
            PG8_LDB(B1, 0, 1); PG8_STAGE(PG8_SB(0, 0), b2, voffB);
            PG8_BAR; PG8_WAIT_L(0); PG8_MMA(0, 1, At, B1); PG8_BAR;
            PG8_LDA(At, 0, 1); PG8_STAGE(PG8_SA(0, 0), a2, voffA);
            PG8_BAR; PG8_WAIT_L(0); PG8_MMA(1, 0, At, B0); PG8_BAR; PG8_SCHED;
            PG8_STAGE(PG8_SB(0, 1), b2 + hstep, voffB);
            PG8_WAIT_V(6); PG8_BAR; PG8_MMA(1, 1, At, B1); PG8_BAR;
            PG8_LDB(B0, 1, 0); PG8_SCHED; PG8_LDA(At, 1, 0); PG8_STAGE(PG8_SA(0, 1), a2 + hstep, voffA);
            PG8_WAIT_L(8); PG8_BAR; PG8_WAIT_L(0); PG8_MMA(0, 0, At, B0); PG8_BAR; PG8_SCHED;
            PG8_LDB(B1, 1, 1); PG8_STAGE(PG8_SB(1, 0), b3, voffB);
            PG8_BAR; PG8_WAIT_L(0); PG8_MMA(0, 1, At, B1); PG8_BAR;
            PG8_LDA(At, 1, 1); PG8_STAGE(PG8_SA(1, 0), a3, voffA);
            PG8_BAR; PG8_WAIT_L(0); PG8_MMA(1, 0, At, B0); PG8_BAR; PG8_SCHED;
            PG8_STAGE(PG8_SB(1, 1), b3 + hstep, voffB);
            PG8_WAIT_V(6); PG8_BAR; PG8_MMA(1, 1, At, B1); PG8_BAR;
            }
        }
        if constexpr (ALIGN_EPI) { if (wr == 0) PG8_BAR; }
        if constexpr (!Epi::AFTER_DRAIN) { E(acc, cur, wr, wc, fr, fq); S.done(cur); }
        if (!has_next) break;
#pragma unroll
        for (int a = 0; a < 2; ++a)
#pragma unroll
            for (int b = 0; b < 2; ++b)
#pragma unroll
                for (int m = 0; m < 4; ++m)
#pragma unroll
                    for (int n = 0; n < 2; ++n) acc[a][b][m][n] = (f32x4){0.f, 0.f, 0.f, 0.f};
        cur = nxt; cA = nA; cB = nB; ++ui;
        if constexpr (ALIGN_EPI) { if (wr == 1) PG8_BAR; }
    }
    PG8_WAIT_V(0);
    if constexpr (!ALIGN_EPI) { if (wr == 0) PG8_BAR; }
    PG8_BAR;
    if constexpr (Epi::AFTER_DRAIN) { E.fused(acc, cur, wr, wc, fr, fq, lds, wid, lane); S.done(cur); }
#undef PG8_SA
#undef PG8_SB
#undef PG8_STAGE
#undef PG8_LDA
#undef PG8_LDB
#undef PG8_MMA
#undef PG8_WAIT_V
#undef PG8_WAIT_L
#undef PG8_BAR
#undef PG8_SCHED
}
}


#ifndef PG8_SP2
#define PG8_SP2 true
#endif
#ifndef PG8_ALIGN
#define PG8_ALIGN true
#endif
#ifndef MK_N_LAUNCHES
#define MK_N_LAUNCHES 1
#endif

constexpr int NB = 8, SEQ = 2048, DM = 1024, MT = NB * SEQ;
constexpr int INC = 4096, NAH = 8;
constexpr int FFD = 2752, FFDP = 2816, NEX = 8, FFE = 3584;
constexpr int MOE_ROWS = 2 * MT + NEX * 256;
constexpr float DN_ALPHA = 1.41421356237309515f;
constexpr float LN_EPS = 1e-5f, RMS_EPS = 1e-6f;
constexpr int NWAVES = 8;

constexpr size_t MiB = 1u << 20;
constexpr size_t WS_CTL = 0, CTL_ZERO_BYTES = 1 * MiB;
constexpr size_t WS_ADA = 1 * MiB;
constexpr size_t WS_LB = 1 * MiB + 512 * 1024;
constexpr size_t WS_ROPE = 2 * MiB;
constexpr size_t WS_ROUTE = 6 * MiB;
constexpr size_t WS_ROWINFO = 6 * MiB + 512 * 1024;
constexpr size_t WS_WMGU = 8 * MiB;
constexpr size_t WS_WMDN = 120 * MiB;
constexpr size_t WS_WIN = 176 * MiB;
constexpr size_t WS_WOUT = 192 * MiB;
constexpr size_t WS_WGU = 196 * MiB;
constexpr size_t WS_WDN = 207 * MiB;
constexpr size_t WS_ABUF = 213 * MiB;
constexpr size_t WS_GATH = 176 * MiB;
constexpr size_t WS_YSLOT = 176 * MiB;
constexpr size_t WS_BIG = 245 * MiB;
constexpr size_t WS_PROJ = WS_BIG;
constexpr size_t WS_ATTO = WS_BIG + 128 * MiB;
constexpr size_t WS_ODIR = WS_BIG + 178 * MiB;
constexpr size_t WS_HID = WS_BIG;
constexpr size_t WS_END = 483 * MiB;
static_assert(WS_GATH + (size_t)MOE_ROWS * 1024 * 2 <= WS_BIG && WS_HID + (size_t)MOE_ROWS * FFE * 2 <= WS_END && WS_WDN + (size_t)1024 * FFDP * 2 <= WS_ABUF, "d_ws map");
constexpr int CW_TMO = 0, CW_BAR = 4096, CW_CNT = 16384;

constexpr int LDS_BYTES = 147456;
constexpr int MISC_OFF = 131072 + 320;

#define GAS __attribute__((address_space(1)))
#define LAS __attribute__((address_space(3)))
typedef unsigned short bf16;
typedef unsigned v4u __attribute__((ext_vector_type(4)));
typedef unsigned v2u __attribute__((ext_vector_type(2)));
typedef float f32x4 __attribute__((ext_vector_type(4)));
typedef GAS unsigned gu32;
#define RLX_AGENT __ATOMIC_RELAXED, __HIP_MEMORY_SCOPE_AGENT
#define LDS_WAIT() asm volatile("s_waitcnt lgkmcnt(0)" ::: "memory")
__device__ __forceinline__ unsigned f2bf(float f) { unsigned u = __builtin_bit_cast(unsigned, f); return (u + 0x7fffu + ((u >> 16) & 1u)) >> 16; }
__device__ __forceinline__ unsigned pk2(float lo, float hi) { return f2bf(lo) | (f2bf(hi) << 16); }
__device__ __forceinline__ float bflo(unsigned w) { return __uint_as_float(w << 16); }
__device__ __forceinline__ float bfhi(unsigned w) { return __uint_as_float(w & 0xffff0000u); }
__device__ __forceinline__ float bf1(bf16 h) { return __uint_as_float(((unsigned)h) << 16); }

#define XB_TMO      128
#define XB_XCNT(j)  (256  + 64 * (j))
#define XB_XSUB(j)  (1280 + 64 * (j))
#define XB_XGEN(j)  (2304 + 64 * (j))
#define XB_TOP      3328
#define XB_TOPGEN   3392
#define XCD_BAR_WORDS 3456
#define XB_SPIN_CAP (1u << 18)

__device__ __forceinline__ unsigned xb_ld(unsigned* p)              { return __hip_atomic_load(p, __ATOMIC_RELAXED, __HIP_MEMORY_SCOPE_AGENT); }
__device__ __forceinline__ unsigned xb_add(unsigned* p, unsigned v) { return __hip_atomic_fetch_add(p, v, __ATOMIC_RELAXED, __HIP_MEMORY_SCOPE_AGENT); }
__device__ __forceinline__ unsigned xb_xcc_id() { return (unsigned)__builtin_amdgcn_s_getreg((3 << 11) | 20) & 0xFu; }
#define XB_SPIN(cond, bar) do { unsigned _sp = 0; while (cond) { __builtin_amdgcn_s_sleep(1); \
    if ((++_sp & 255u) == 0u) { if (xb_ld(&(bar)[XB_TMO])) break; if (_sp > XB_SPIN_CAP) { atomicAdd(&(bar)[XB_TMO], 1u); break; } } } } while (0)

struct XcdBarrier {
    unsigned* bar; unsigned x;
    volatile LAS unsigned* st;
};

__device__ __forceinline__ XcdBarrier xcd_barrier_post(unsigned* bar, volatile LAS unsigned* st) {
    XcdBarrier b; b.bar = bar; b.x = xb_xcc_id(); b.st = st;
    if (threadIdx.x == 0) (void)xb_add(&bar[XB_XCNT(b.x)], 1u);
    return b;
}
__device__ __forceinline__ void xcd_barrier_complete(unsigned* bar, unsigned x, unsigned& nloc, unsigned& nx) {
    const unsigned G = gridDim.x * gridDim.y * gridDim.z;
    unsigned sum, cnt, mine, sp = 0u;
    for (;;) {
        sum = 0u; cnt = 0u; mine = 0u;
#pragma unroll
        for (unsigned j = 0; j < 16; ++j) { const unsigned c = xb_ld(&bar[XB_XCNT(j)]); sum += c; cnt += (c > 0u) ? 1u : 0u; mine = (j == x) ? c : mine; }
        if (sum == G) break;
        __builtin_amdgcn_s_sleep(1);
        if ((++sp & 255u) == 0u) { if (xb_ld(&bar[XB_TMO])) break; if (sp > XB_SPIN_CAP) { atomicAdd(&bar[XB_TMO], 1u); break; } }
    }
    nloc = mine > 0u ? mine : 1u; nx = cnt > 0u ? cnt : 1u;
}

__device__ __forceinline__ void xcd_barrier(const XcdBarrier& b) {
    asm volatile("s_waitcnt vmcnt(0)" ::: "memory");
    __syncthreads();
    if (threadIdx.x == 0) {
        unsigned* bar = b.bar;
        __builtin_amdgcn_s_waitcnt(0);
        unsigned nloc = b.st[0], nx = b.st[1];
        if (nloc == 0u) { xcd_barrier_complete(bar, b.x, nloc, nx); b.st[0] = nloc; b.st[1] = nx; }
        const unsigned old = xb_add(&bar[XB_XSUB(b.x)], 1u);
        const unsigned gen = old / nloc;
        if (old + 1u == (gen + 1u) * nloc) {
            __builtin_amdgcn_fence(__ATOMIC_RELEASE, "agent");
            asm volatile("s_waitcnt vmcnt(0)" ::: "memory");
            const unsigned og = xb_add(&bar[XB_TOP], 1u);
            const unsigned tg = og / nx;
            if (og + 1u == (tg + 1u) * nx) xb_add(&bar[XB_TOPGEN], 1u);
            else XB_SPIN(xb_ld(&bar[XB_TOPGEN]) == tg, bar);
            __builtin_amdgcn_fence(__ATOMIC_ACQUIRE, "agent");
            xb_add(&bar[XB_XGEN(b.x)], 1u);
            asm volatile("s_waitcnt vmcnt(0)" ::: "memory");
        } else {
            XB_SPIN(xb_ld(&bar[XB_XGEN(b.x)]) == gen, bar);
            __builtin_amdgcn_fence(__ATOMIC_ACQUIRE, "agent");
            asm volatile("s_waitcnt vmcnt(0)" ::: "memory");
        }
    }
    __syncthreads();
}


struct Args { const void* in[19]; float* out; unsigned char* ws; int ph_lo, ph_hi; };

struct Frame {
    LAS unsigned char* lds; unsigned char* ws; gu32* ctl;
    int tid, lane, wave, G, vcu;
};

__device__ __forceinline__ float wave_sum(float v) {
#pragma unroll
    for (int o = 1; o < 64; o <<= 1) v += __shfl_xor(v, o);
    return v;
}

template <int KIND>
__device__ __forceinline__ void p0_tile(const float* W, int ldn, int k0, int n0, bool zero, bf16* dst, int ldk, int sel, LAS float* scr, int lane) {
    if (!zero) {
#pragma unroll 8
        for (int i = 0; i < 32; ++i) { const int kk = 2 * i + (lane >> 5); scr[kk * 33 + (lane & 31)] = W[(size_t)(k0 + kk) * ldn + n0 + (lane & 31)]; }
    }
    LDS_WAIT(); asm volatile("" ::: "memory");
    const int c = lane & 7;
#pragma unroll
    for (int j = 0; j < 4; ++j) {
        const int n = (lane >> 3) + 8 * j, lc = n0 + n; int prow;
        if (KIND == 0) {
            if (lc < 1024) { const int d = lc & 63; prow = (lc & ~63) + 32 * ((d >> 4) & 1) + 16 * (d >> 5) + (d & 15); }
            else { const int x = lc & 31; prow = (lc & ~31) + 16 * ((x >> 2) & 1) + 4 * (x >> 3) + (x & 3); }
        } else if (KIND == 1) prow = lc;
        else { const int x = lc & 31; prow = 256 * (lc >> 7) + 128 * sel + 32 * ((lc >> 5) & 3) + 16 * ((x >> 2) & 1) + 4 * (x >> 3) + (x & 3); }
        v4u o;
        if (zero) { o = (v4u){0u, 0u, 0u, 0u}; }
        else { const LAS float* s = scr + (8 * c) * 33 + n;
            o.x = pk2(s[0 * 33], s[1 * 33]); o.y = pk2(s[2 * 33], s[3 * 33]); o.z = pk2(s[4 * 33], s[5 * 33]); o.w = pk2(s[6 * 33], s[7 * 33]); }
        *(v4u*)(dst + (size_t)prow * ldk + k0 + 8 * c) = o;
    }
    LDS_WAIT(); asm volatile("" ::: "memory");
}

__device__ __forceinline__ void p0_prologue(Frame& F, const Args& a) {
    const float* c_in = (const float*)a.in[1]; const int* positions = (const int*)a.in[2];
    const float* w_in = (const float*)a.in[3]; const float* w_out = (const float*)a.in[4];
    const float* lb_logits = (const float*)a.in[7]; const float* ada_w = (const float*)a.in[8]; const float* ada_b = (const float*)a.in[9];
    const float* ffn_g = (const float*)a.in[12]; const float* ffn_u = (const float*)a.in[13]; const float* ffn_d = (const float*)a.in[14];
    const float* moe_g = (const float*)a.in[16]; const float* moe_u = (const float*)a.in[17]; const float* moe_d = (const float*)a.in[18];
    float* ada = (float*)(F.ws + WS_ADA); float* lbt = (float*)(F.ws + WS_LB); float* rope = (float*)(F.ws + WS_ROPE);
    if (F.vcu < 24) {
        LAS float* cact = (LAS float*)F.lds;
        for (int i = F.tid; i < NB * DM; i += 512) { const float v = c_in[i]; cact[i] = v / (1.0f + __expf(-v)); }
        __syncthreads();
        const int ls = F.vcu / 6, n = (F.vcu % 6) * 512 + F.tid;
        const float* w = ada_w + (size_t)ls * DM * 3072 + n;
        float acc[8];
#pragma unroll
        for (int b = 0; b < 8; ++b) acc[b] = 0.f;
#pragma unroll 4
        for (int k = 0; k < DM; ++k) { const float wv = w[(size_t)k * 3072];
#pragma unroll
            for (int b = 0; b < 8; ++b) acc[b] += cact[b * DM + k] * wv; }
        const float bias = ada_b[ls * 3072 + n];
#pragma unroll
        for (int b = 0; b < 8; ++b) ada[(size_t)(ls * 8 + b) * 3072 + n] = acc[b] + bias;
        __syncthreads();
    }
    const int gt = F.vcu * 512 + F.tid, GT = F.G * 512;
    for (int i = gt; i < MT * 32; i += GT) {
        const int m = i >> 5, d = i & 31;
        const float ang = (float)positions[m] * exp2f(-(float)d * 0.41524101186092029f);
        const double rev = (double)ang * 0.15915494309189533577;
        const float fr = (float)(rev - __builtin_rint(rev));
        rope[2 * (size_t)i] = __builtin_amdgcn_cosf(fr); rope[2 * (size_t)i + 1] = __builtin_amdgcn_sinf(fr);
    }
    for (int i = gt; i < 2 * 512; i += GT) {
        const float a0 = lb_logits[i], a1 = lb_logits[1024 + i];
        lbt[i] = 0.f; lbt[1024 + i] = 1.0f / (1.0f + __expf(a0 - a1));
    }
    LAS float* scr = (LAS float*)(F.lds + 32768 + F.wave * 8704);
    const int gw = F.vcu * NWAVES + F.wave, NGW = F.G * NWAVES;
    constexpr int I0 = 2 * 16 * 128, I1 = 2 * 16 * 32, I2 = 2 * 16 * 88, I3 = 44 * 32, I4 = 8 * 2 * 16 * 112, I5 = 8 * 56 * 32;
    constexpr int NITEMS = I0 + I1 + I2 + I3 + I4 + I5;
    for (int it = gw; it < NITEMS; it += NGW) {
        int r = it;
        if (r < I0) { const int l = r / 2048, q = r % 2048, kb = q / 128, nb = q % 128;
            p0_tile<0>(w_in + (size_t)l * DM * INC, INC, 64 * kb, 32 * nb, false, (bf16*)(F.ws + WS_WIN) + (size_t)l * INC * DM, DM, 0, scr, F.lane); continue; } r -= I0;
        if (r < I1) { const int l = r / 512, q = r % 512, kb = q / 32, nb = q % 32;
            p0_tile<1>(w_out + (size_t)l * DM * DM, DM, 64 * kb, 32 * nb, false, (bf16*)(F.ws + WS_WOUT) + (size_t)l * DM * DM, DM, 0, scr, F.lane); continue; } r -= I1;
        if (r < I2) { const int sel = r / 1408, q = r % 1408, kb = q / 88, nb = q % 88;
            p0_tile<2>(sel ? ffn_u : ffn_g, FFD, 64 * kb, 32 * nb, nb >= 86, (bf16*)(F.ws + WS_WGU), DM, sel, scr, F.lane); continue; } r -= I2;
        if (r < I3) { const int kb = r / 32, nb = r % 32;
            p0_tile<1>(ffn_d, DM, 64 * kb, 32 * nb, kb >= 43, (bf16*)(F.ws + WS_WDN), FFDP, 0, scr, F.lane); continue; } r -= I3;
        if (r < I4) { const int e = r / 3584, q0 = r % 3584, sel = q0 / 1792, q = q0 % 1792, kb = q / 112, nb = q % 112;
            p0_tile<2>((sel ? moe_u : moe_g) + (size_t)e * DM * FFE, FFE, 64 * kb, 32 * nb, false, (bf16*)(F.ws + WS_WMGU) + (size_t)e * 2 * FFE * DM, DM, sel, scr, F.lane); continue; } r -= I4;
        { const int e = r / 1792, q = r % 1792, kb = q / 32, nb = q % 32;
            p0_tile<1>(moe_d + (size_t)e * FFE * DM, DM, 64 * kb, 32 * nb, false, (bf16*)(F.ws + WS_WMDN) + (size_t)e * DM * FFE, FFE, 0, scr, F.lane); }
    }
}

__device__ __forceinline__ void p1_mod0(Frame& F, const float* x, const float* adar  , bf16* abuf) {
    const int gw = F.vcu * NWAVES + F.wave, NGW = F.G * NWAVES;
    for (int m = gw; m < MT; m += NGW) {
        const int b = m >> 11; const float* ar = adar + (size_t)b * 3072;
        const f32x4* xr = (const f32x4*)(x + (size_t)m * DM) + F.lane;
        unsigned long long* o8 = (unsigned long long*)(abuf + (size_t)m * DM) + F.lane;
#pragma unroll
        for (int j = 0; j < 4; ++j) {
            const f32x4 v = xr[64 * j]; const int col = 4 * F.lane + 256 * j;
            const f32x4 sh = *(const f32x4*)(ar + col), sc = *(const f32x4*)(ar + 1024 + col);
            const f32x4 u = v * (sc + 1.0f) + sh;
            o8[64 * j] = (unsigned long long)pk2(u[0], u[1]) | ((unsigned long long)pk2(u[2], u[3]) << 32);
        }
    }
}

__device__ __forceinline__ void attn_simple(Frame& F, const bf16* proj, bf16* atto) {
    for (int gid = F.vcu * 512 + F.tid; gid < NB * NAH * SEQ; gid += F.G * 512) {
        const int i = gid & (SEQ - 1), h = (gid >> 11) & 7, b = gid >> 14;
        const size_t rowb = (size_t)b * SEQ;
        float q[64], o[64];
        { const v4u* qp = (const v4u*)(proj + (rowb + i) * INC + h * 64);
#pragma unroll
          for (int c = 0; c < 8; ++c) { const v4u w = qp[c]; q[8 * c] = bflo(w.x); q[8 * c + 1] = bfhi(w.x); q[8 * c + 2] = bflo(w.y); q[8 * c + 3] = bfhi(w.y); q[8 * c + 4] = bflo(w.z); q[8 * c + 5] = bfhi(w.z); q[8 * c + 6] = bflo(w.w); q[8 * c + 7] = bfhi(w.w); } }
#pragma unroll
        for (int d = 0; d < 64; ++d) o[d] = 0.f;
        float mx = -1e30f, l = 0.f;
        for (int p = 0; p < 3; ++p) {
            const int dl = (p == 0) ? 1 : (p == 1 ? 4 : 16);
            for (int j = -64; j <= 64; ++j) {
                const int pos = i + dl * j;
                if (pos < 0 || pos >= SEQ) continue;
                const v4u* kp = (const v4u*)(proj + (rowb + pos) * INC + 512 + h * 64);
                float s = 0.f;
#pragma unroll
                for (int c = 0; c < 8; ++c) { const v4u w = kp[c];
                    s += q[8 * c] * bflo(w.x) + q[8 * c + 1] * bfhi(w.x) + q[8 * c + 2] * bflo(w.y) + q[8 * c + 3] * bfhi(w.y) + q[8 * c + 4] * bflo(w.z) + q[8 * c + 5] * bfhi(w.z) + q[8 * c + 6] * bflo(w.w) + q[8 * c + 7] * bfhi(w.w); }
                if (s > mx) { const float r = __expf(mx - s); l *= r;
#pragma unroll
                    for (int d = 0; d < 64; ++d) o[d] *= r;
                    mx = s; }
                const float pe = __expf(s - mx); l += pe;
                const v4u* vp = (const v4u*)(proj + (rowb + pos) * INC + 1024 + h * 64);
#pragma unroll
                for (int c = 0; c < 8; ++c) { const v4u w = vp[c];
                    o[8 * c] += pe * bflo(w.x); o[8 * c + 1] += pe * bfhi(w.x); o[8 * c + 2] += pe * bflo(w.y); o[8 * c + 3] += pe * bfhi(w.y); o[8 * c + 4] += pe * bflo(w.z); o[8 * c + 5] += pe * bfhi(w.z); o[8 * c + 6] += pe * bflo(w.w); o[8 * c + 7] += pe * bfhi(w.w); }
            }
        }
        const float inv = 1.0f / l;
        v4u* op = (v4u*)(atto + (rowb + i) * 512 + h * 64);
#pragma unroll
        for (int c = 0; c < 8; ++c) { v4u w; w.x = pk2(o[8 * c] * inv, o[8 * c + 1] * inv); w.y = pk2(o[8 * c + 2] * inv, o[8 * c + 3] * inv); w.z = pk2(o[8 * c + 4] * inv, o[8 * c + 5] * inv); w.w = pk2(o[8 * c + 6] * inv, o[8 * c + 7] * inv); op[c] = w; }
    }
}

__device__ __forceinline__ void gla_simple(Frame& F, const bf16* proj, bf16* odir) {
    LAS float* red = (LAS float*)F.lds;
    const int sub = F.tid >> 7, c = F.tid & 127, wsub = (F.tid >> 6) & 1;
    for (int ug = F.vcu; ug < 256; ug += F.G) {
        const int unit = ug * 4 + sub, chain = unit >> 4, cg = unit & 15;
        const int dir = chain & 1, h = (chain >> 1) & 3, b = chain >> 3;
        const size_t rowb = (size_t)b * SEQ;
        float S[8];
#pragma unroll
        for (int j = 0; j < 8; ++j) S[j] = 0.f;
        for (int t0 = 0; t0 < SEQ; t0 += 8) {
            float pr[64];
#pragma unroll
            for (int tt = 0; tt < 8; ++tt) {
                const int t = t0 + tt, pos = dir ? (SEQ - 1 - t) : t;
                const bf16* rp = proj + (rowb + pos) * INC;
                const float g = bf1(rp[2048 + 512 * dir + h * 128 + c]);
                const float qv = bf1(rp[1536 + h * 128 + c]);
                const v4u vw = *(const v4u*)(rp + 3072 + h * 128 + cg * 8);
                const float f = __expf(g), kk = 1.0f - f;
                const float vv[8] = {bflo(vw.x), bfhi(vw.x), bflo(vw.y), bfhi(vw.y), bflo(vw.z), bfhi(vw.z), bflo(vw.w), bfhi(vw.w)};
#pragma unroll
                for (int j = 0; j < 8; ++j) { S[j] = f * S[j] + kk * vv[j]; pr[tt * 8 + j] = qv * S[j]; }
            }
#pragma unroll
            for (int step = 0; step < 6; ++step) {
                const int off = 32 >> step, half = 32 >> step;
                const bool up = (F.lane & off) != 0;
#pragma unroll
                for (int i = 0; i < half; ++i) {
                    const float keep = up ? pr[i + half] : pr[i], send = up ? pr[i] : pr[i + half];
                    pr[i] = keep + __shfl_xor(send, off);
                }
            }
            __syncthreads();
            if (wsub == 1) red[sub * 64 + F.lane] = pr[0];
            __syncthreads();
            if (wsub == 0) {
                const float tot = pr[0] + red[sub * 64 + F.lane];
                const int t = t0 + (F.lane >> 3), j = F.lane & 7, pos = dir ? (SEQ - 1 - t) : t;
                odir[((size_t)dir * MT + rowb + pos) * 512 + h * 128 + cg * 8 + j] = (bf16)f2bf(tot);
            }
        }
    }
}

__device__ __forceinline__ void combine_phase(Frame& F, const bf16* proj, const bf16* atto, const bf16* odir, const float* again, const float* rgain, bf16* abuf) {
    const int gw = F.vcu * NWAVES + F.wave, NGW = F.G * NWAVES;
    for (int m = gw; m < MT; m += NGW) {
        const int c0 = 8 * F.lane;
        { const v4u w = *(const v4u*)(atto + (size_t)m * 512 + c0);
          float v[8] = {bflo(w.x), bfhi(w.x), bflo(w.y), bfhi(w.y), bflo(w.z), bfhi(w.z), bflo(w.w), bfhi(w.w)};
          float ss = 0.f;
#pragma unroll
          for (int j = 0; j < 8; ++j) ss += v[j] * v[j];
          const float r = 1.0f / sqrtf(wave_sum(ss) * (1.0f / 512.0f) + RMS_EPS);
          const f32x4 g0 = *(const f32x4*)(again + c0), g1 = *(const f32x4*)(again + c0 + 4);
          v4u o; o.x = pk2(v[0] * r * g0[0], v[1] * r * g0[1]); o.y = pk2(v[2] * r * g0[2], v[3] * r * g0[3]); o.z = pk2(v[4] * r * g1[0], v[5] * r * g1[1]); o.w = pk2(v[6] * r * g1[2], v[7] * r * g1[3]);
          *(v4u*)(abuf + (size_t)m * DM + c0) = o; }
        { const v4u wf = *(const v4u*)(odir + (size_t)m * 512 + c0), wb = *(const v4u*)(odir + ((size_t)MT + m) * 512 + c0);
          const v4u wg = *(const v4u*)(proj + (size_t)m * INC + 3584 + c0);
          float v[8] = {bflo(wf.x) + bflo(wb.x), bfhi(wf.x) + bfhi(wb.x), bflo(wf.y) + bflo(wb.y), bfhi(wf.y) + bfhi(wb.y), bflo(wf.z) + bflo(wb.z), bfhi(wf.z) + bfhi(wb.z), bflo(wf.w) + bflo(wb.w), bfhi(wf.w) + bfhi(wb.w)};
          const float sg[8] = {bflo(wg.x), bfhi(wg.x), bflo(wg.y), bfhi(wg.y), bflo(wg.z), bfhi(wg.z), bflo(wg.w), bfhi(wg.w)};
          float ss = 0.f;
#pragma unroll
          for (int j = 0; j < 8; ++j) ss += v[j] * v[j];
          ss += __shfl_xor(ss, 1); ss += __shfl_xor(ss, 2); ss += __shfl_xor(ss, 4); ss += __shfl_xor(ss, 8);
          const float r = 1.0f / sqrtf(ss * (1.0f / 128.0f) + RMS_EPS);
          const f32x4 g0 = *(const f32x4*)(rgain + c0), g1 = *(const f32x4*)(rgain + c0 + 4);
          v4u o; o.x = pk2(v[0] * r * g0[0] * sg[0], v[1] * r * g0[1] * sg[1]); o.y = pk2(v[2] * r * g0[2] * sg[2], v[3] * r * g0[3] * sg[3]);
          o.z = pk2(v[4] * r * g1[0] * sg[4], v[5] * r * g1[1] * sg[5]); o.w = pk2(v[6] * r * g1[2] * sg[6], v[7] * r * g1[3] * sg[7]);
          *(v4u*)(abuf + (size_t)m * DM + 512 + c0) = o; }
    }
}

template <int MODE>
__device__ __forceinline__ void ln_phase(Frame& F, float* xs, const float* lng, const float* lnb, const float* adan  , bf16* abuf,
                                         const float* wrt  , unsigned* route) {
    const int gw = F.vcu * NWAVES + F.wave, NGW = F.G * NWAVES;
    for (int m = gw; m < MT; m += NGW) {
        f32x4* xr = (f32x4*)(xs + (size_t)m * DM) + F.lane;
        f32x4 v[4]; float s = 0.f;
#pragma unroll
        for (int j = 0; j < 4; ++j) { v[j] = xr[64 * j]; s += (v[j][0] + v[j][1]) + (v[j][2] + v[j][3]); }
        const float mean = wave_sum(s) * (1.0f / DM); float s2 = 0.f;
#pragma unroll
        for (int j = 0; j < 4; ++j) { v[j] = v[j] - mean; s2 += (v[j][0] * v[j][0] + v[j][1] * v[j][1]) + (v[j][2] * v[j][2] + v[j][3] * v[j][3]); }
        const float rstd = 1.0f / sqrtf(wave_sum(s2) * (1.0f / DM) + LN_EPS);
        const int b = m >> 11; const float* ar = adan + (size_t)b * 3072;
        float lg[8];
#pragma unroll
        for (int e = 0; e < 8; ++e) lg[e] = 0.f;
#pragma unroll
        for (int j = 0; j < 4; ++j) {
            const int col = 4 * F.lane + 256 * j;
            const f32x4 xn = v[j] * rstd * *(const f32x4*)(lng + col) + *(const f32x4*)(lnb + col);
            xr[64 * j] = xn;
            const f32x4 u = xn * (*(const f32x4*)(ar + 1024 + col) + 1.0f) + *(const f32x4*)(ar + col);
            if (MODE == 0) ((unsigned long long*)(abuf + (size_t)m * DM) + F.lane)[64 * j] = (unsigned long long)pk2(u[0], u[1]) | ((unsigned long long)pk2(u[2], u[3]) << 32);
            if (MODE == 1) {
#pragma unroll
                for (int i = 0; i < 4; ++i) { const f32x4 w0 = *(const f32x4*)(wrt + (size_t)(col + i) * 8), w1 = *(const f32x4*)(wrt + (size_t)(col + i) * 8 + 4);
                    lg[0] += u[i] * w0[0]; lg[1] += u[i] * w0[1]; lg[2] += u[i] * w0[2]; lg[3] += u[i] * w0[3]; lg[4] += u[i] * w1[0]; lg[5] += u[i] * w1[1]; lg[6] += u[i] * w1[2]; lg[7] += u[i] * w1[3]; }
            }
        }
        if (MODE == 1) {
#pragma unroll
            for (int e = 0; e < 8; ++e) lg[e] = wave_sum(lg[e]);
            int e1 = 0; float l1 = lg[0];
#pragma unroll
            for (int e = 1; e < 8; ++e) if (lg[e] > l1) { l1 = lg[e]; e1 = e; }
            int e2 = -1; float l2 = -3.0e38f;
#pragma unroll
            for (int e = 0; e < 8; ++e) if (e != e1 && lg[e] > l2) { l2 = lg[e]; e2 = e; }
            if (F.lane == 0) {
                const float w1 = 1.0f / (1.0f + __expf(l2 - l1)), w2 = 1.0f - w1;
                const unsigned p1 = __hip_atomic_fetch_add((unsigned*)(F.ctl + CW_CNT + 64 * e1), 1u, RLX_AGENT);
                const unsigned p2 = __hip_atomic_fetch_add((unsigned*)(F.ctl + CW_CNT + 64 * e2), 1u, RLX_AGENT);
                unsigned* rt = route + (size_t)m * 8;
                rt[0] = (unsigned)e1; rt[1] = p1; rt[2] = __float_as_uint(w1); rt[3] = (unsigned)e2; rt[4] = p2; rt[5] = __float_as_uint(w2);
            }
        }
    }
}

struct MoeOff { int off[9]; int cnt[8]; };
__device__ __forceinline__ void moe_offsets(Frame& F, int (&off)[9], int (&cnt)[8]) {
    off[0] = 0;
#pragma unroll
    for (int e = 0; e < 8; ++e) { cnt[e] = (int)__hip_atomic_load((unsigned*)(F.ctl + CW_CNT + 64 * e), RLX_AGENT); off[e + 1] = off[e] + ((cnt[e] + 255) & ~255); }
}

__device__ __forceinline__ void gather_phase(Frame& F, const float* xs, const float* adan, const unsigned* route, bf16* gath, unsigned* rowinfo) {
    int off[9], cnt[8]; moe_offsets(F, off, cnt);
    const int gw = F.vcu * NWAVES + F.wave, NGW = F.G * NWAVES;
    for (int m = gw; m < MT; m += NGW) {
        const unsigned* rt = route + (size_t)m * 8;
        const int e1 = (int)rt[0], p1 = (int)rt[1], e2 = (int)rt[3], p2 = (int)rt[4]; const unsigned w1 = rt[2], w2 = rt[5];
        int o1 = 0, o2 = 0;
#pragma unroll
        for (int e = 0; e < 8; ++e) { o1 = (e1 == e) ? off[e] : o1; o2 = (e2 == e) ? off[e] : o2; }
        const int r1 = o1 + p1, r2 = o2 + p2;
        const int b = m >> 11; const float* ar = adan + (size_t)b * 3072;
        const f32x4* xr = (const f32x4*)(xs + (size_t)m * DM) + F.lane;
        unsigned long long* d1 = (unsigned long long*)(gath + (size_t)r1 * DM) + F.lane; unsigned long long* d2 = (unsigned long long*)(gath + (size_t)r2 * DM) + F.lane;
#pragma unroll
        for (int j = 0; j < 4; ++j) {
            const int col = 4 * F.lane + 256 * j;
            const f32x4 u = xr[64 * j] * (*(const f32x4*)(ar + 1024 + col) + 1.0f) + *(const f32x4*)(ar + col);
            const unsigned long long w = (unsigned long long)pk2(u[0], u[1]) | ((unsigned long long)pk2(u[2], u[3]) << 32);
            d1[64 * j] = w; d2[64 * j] = w;
        }
        if (F.lane == 0) { rowinfo[2 * (size_t)r1] = (unsigned)m; rowinfo[2 * (size_t)r1 + 1] = w1; rowinfo[2 * (size_t)r2] = (unsigned)m | (1u << 16); rowinfo[2 * (size_t)r2 + 1] = w2; }
    }
    for (int it = gw; it < 8 * 256; it += NGW) {
        const int e = it >> 8, i = it & 255; int oe = 0, ce = 0;
#pragma unroll
        for (int k = 0; k < 8; ++k) { oe = (e == k) ? off[k] : oe; ce = (e == k) ? cnt[k] : ce; }
        const int npad = ((ce + 255) & ~255) - ce;
        if (i < npad) { const int row = oe + ce + i;
            v4u* d = (v4u*)(gath + (size_t)row * DM) + F.lane; d[0] = (v4u){0u, 0u, 0u, 0u}; d[64] = (v4u){0u, 0u, 0u, 0u};
            if (F.lane == 0) { rowinfo[2 * (size_t)row] = 0xffffffffu; rowinfo[2 * (size_t)row + 1] = 0u; } }
    }
}

__device__ __forceinline__ void final_phase(Frame& F, float* xs, const bf16* yslot, const float* adar  , const float* lng, const float* lnb) {
    const int gw = F.vcu * NWAVES + F.wave, NGW = F.G * NWAVES;
    for (int m = gw; m < MT; m += NGW) {
        f32x4* xr = (f32x4*)(xs + (size_t)m * DM) + F.lane;
        const v2u* y0 = (const v2u*)(yslot + (size_t)m * DM) + F.lane; const v2u* y1 = (const v2u*)(yslot + ((size_t)MT + m) * DM) + F.lane;
        const int b = m >> 11; const float* ar = adar + (size_t)b * 3072 + 2048;
        f32x4 v[4]; float s = 0.f;
#pragma unroll
        for (int j = 0; j < 4; ++j) {
            const int col = 4 * F.lane + 256 * j;
            const v2u a = y0[64 * j], c = y1[64 * j];
            const f32x4 y = (f32x4){bflo(a.x) + bflo(c.x), bfhi(a.x) + bfhi(c.x), bflo(a.y) + bflo(c.y), bfhi(a.y) + bfhi(c.y)};
            v[j] = xr[64 * j] * DN_ALPHA + (*(const f32x4*)(ar + col) + 1.0f) * y;
            s += (v[j][0] + v[j][1]) + (v[j][2] + v[j][3]);
        }
        const float mean = wave_sum(s) * (1.0f / DM); float s2 = 0.f;
#pragma unroll
        for (int j = 0; j < 4; ++j) { v[j] = v[j] - mean; s2 += (v[j][0] * v[j][0] + v[j][1] * v[j][1]) + (v[j][2] * v[j][2] + v[j][3] * v[j][3]); }
        const float rstd = 1.0f / sqrtf(wave_sum(s2) * (1.0f / DM) + LN_EPS);
#pragma unroll
        for (int j = 0; j < 4; ++j) { const int col = 4 * F.lane + 256 * j; xr[64 * j] = v[j] * rstd * *(const f32x4*)(lng + col) + *(const f32x4*)(lnb + col); }
    }
}

constexpr int NPH = 20;
#define IN(k) (lo <= (k) && (k) < hi)
#define SEAM(k) do { if (IN(k) && IN((k) + 1)) xcd_barrier(bar); } while (0)
template <int L>
__device__ __forceinline__ void layer_phases(Frame& F, const Args& args, const XcdBarrier& bar, const int lo, const int hi) {
    constexpr int pb = 2 + 9 * L;
    unsigned char* const ws = args.ws;
    float* const xs = args.out;
    if (IN(pb + 0)) {
        pg8::Gemm g{(const bf16*)(ws + WS_ABUF), (const bf16*)(ws + WS_WIN) + (size_t)L * INC * DM, MT, INC, DM}; pg8::StaticOrder S; S.init(MT, INC, F.G, (int)blockIdx.x);
        pg8::EpiIn E{(bf16*)(ws + WS_PROJ), (const float*)(ws + WS_ROPE), (const float*)(ws + WS_LB) + (size_t)L * 1024};
        pg8::gemm_phase<pg8::EpiIn, pg8::StaticOrder, PG8_ALIGN, PG8_SP2>(F.lds, g, S, E);
        SEAM(pb + 0);
    }
    if (IN(pb + 1)) { attn_simple(F, (const bf16*)(ws + WS_PROJ), (bf16*)(ws + WS_ATTO)); gla_simple(F, (const bf16*)(ws + WS_PROJ), (bf16*)(ws + WS_ODIR)); SEAM(pb + 1); }
    if (IN(pb + 2)) { combine_phase(F, (const bf16*)(ws + WS_PROJ), (const bf16*)(ws + WS_ATTO), (const bf16*)(ws + WS_ODIR), (const float*)args.in[5] + (size_t)L * 512, (const float*)args.in[6] + (size_t)L * 512, (bf16*)(ws + WS_ABUF)); SEAM(pb + 2); }
    if (IN(pb + 3)) {
        pg8::Gemm g{(const bf16*)(ws + WS_ABUF), (const bf16*)(ws + WS_WOUT) + (size_t)L * DM * DM, MT, DM, DM}; pg8::StaticOrder S; S.init(MT, DM, F.G, (int)blockIdx.x);
        pg8::EpiRes E{L == 0 ? (const float*)args.in[0] : (const float*)xs, xs, (const float*)(ws + WS_ADA) + (size_t)(L * 2 + 0) * 8 * 3072, DN_ALPHA};
        pg8::gemm_phase<pg8::EpiRes, pg8::StaticOrder, PG8_ALIGN, PG8_SP2>(F.lds, g, S, E);
        SEAM(pb + 3);
    }
    const float* const ada1 = (const float*)(ws + WS_ADA) + (size_t)(L * 2 + 1) * 8 * 3072;
    const float* const lng = (const float*)args.in[10] + (size_t)L * 2 * DM; const float* const lnb = (const float*)args.in[11] + (size_t)L * 2 * DM;
    if constexpr (L == 0) {
        if (IN(pb + 4)) { ln_phase<0>(F, xs, lng, lnb, ada1, (bf16*)(ws + WS_ABUF), nullptr, nullptr); if (IN(pb + 6)) xcd_barrier(bar); }
        if (IN(pb + 6)) {
            pg8::Gemm g{(const bf16*)(ws + WS_ABUF), (const bf16*)(ws + WS_WGU), MT, 2 * FFDP, DM}; pg8::StaticOrder S; S.init(MT, 2 * FFDP, F.G, (int)blockIdx.x);
            pg8::EpiGU<FFDP, 22> E{(bf16*)(ws + WS_HID)};
            pg8::gemm_phase<pg8::EpiGU<FFDP, 22>, pg8::StaticOrder, PG8_ALIGN, PG8_SP2>(F.lds, g, S, E);
            SEAM(pb + 6);
        }
        if (IN(pb + 7)) {
            pg8::Gemm g{(const bf16*)(ws + WS_HID), (const bf16*)(ws + WS_WDN), MT, DM, FFDP}; pg8::StaticOrder S; S.init(MT, DM, F.G, (int)blockIdx.x);
            pg8::EpiRes E{(const float*)xs, xs, ada1, DN_ALPHA};
            pg8::gemm_phase<pg8::EpiRes, pg8::StaticOrder, PG8_ALIGN, PG8_SP2>(F.lds, g, S, E);
            SEAM(pb + 7);
        }
        if (IN(pb + 8)) { ln_phase<0>(F, xs, lng + DM, lnb + DM, (const float*)(ws + WS_ADA) + (size_t)2 * 8 * 3072, (bf16*)(ws + WS_ABUF), nullptr, nullptr); SEAM(pb + 8); }
    } else {
        unsigned* const route = (unsigned*)(ws + WS_ROUTE); unsigned* const rowinfo = (unsigned*)(ws + WS_ROWINFO);
        if (IN(pb + 4)) { ln_phase<1>(F, xs, lng, lnb, ada1, nullptr, (const float*)args.in[15], route); SEAM(pb + 4); }
        if (IN(pb + 5)) { gather_phase(F, xs, ada1, route, (bf16*)(ws + WS_GATH), rowinfo); SEAM(pb + 5); }
        if (IN(pb + 6)) {
            int off[9], cnt[8]; moe_offsets(F, off, cnt);
            const int nT = off[8] >> 8;
            pg8::Gemm g{(const bf16*)(ws + WS_GATH), (const bf16*)(ws + WS_WMGU), nT * 256, 2 * FFE, DM};
            pg8::MoeOrder S; S.init(nT * 256, 2 * FFE, F.G, (int)blockIdx.x);
            S.ts1 = off[1] >> 8; S.ts2 = off[2] >> 8; S.ts3 = off[3] >> 8; S.ts4 = off[4] >> 8; S.ts5 = off[5] >> 8; S.ts6 = off[6] >> 8; S.ts7 = off[7] >> 8; S.nNloc = 28;
            pg8::EpiGU<FFE, 28> E{(bf16*)(ws + WS_HID)};
            pg8::gemm_phase<pg8::EpiGU<FFE, 28>, pg8::MoeOrder, PG8_ALIGN, PG8_SP2>(F.lds, g, S, E);
            SEAM(pb + 6);
        }
        if (IN(pb + 7)) {
            int off[9], cnt[8]; moe_offsets(F, off, cnt);
            const int nT = off[8] >> 8;
            pg8::Gemm g{(const bf16*)(ws + WS_HID), (const bf16*)(ws + WS_WMDN), nT * 256, DM, FFE};
            pg8::MoeOrder S; S.init(nT * 256, DM, F.G, (int)blockIdx.x);
            S.ts1 = off[1] >> 8; S.ts2 = off[2] >> 8; S.ts3 = off[3] >> 8; S.ts4 = off[4] >> 8; S.ts5 = off[5] >> 8; S.ts6 = off[6] >> 8; S.ts7 = off[7] >> 8; S.nNloc = 4;
            pg8::EpiMoeDn E{rowinfo, (bf16*)(ws + WS_YSLOT)};
            pg8::gemm_phase<pg8::EpiMoeDn, pg8::MoeOrder, PG8_ALIGN, PG8_SP2>(F.lds, g, S, E);
            SEAM(pb + 7);
        }
        if (IN(pb + 8)) { final_phase(F, xs, (const bf16*)(ws + WS_YSLOT), ada1, lng + DM, lnb + DM); }
    }
}

__global__ void __launch_bounds__(NWAVES * 64, 2) fwd_kernel(Args args) {
    extern __shared__ __attribute__((aligned(16))) unsigned char lds[];
    Frame F;
    F.lds = (LAS unsigned char*)lds; F.ws = args.ws; F.ctl = (gu32*)(args.ws + WS_CTL);
    F.tid = threadIdx.x; F.lane = F.tid & 63; F.wave = __builtin_amdgcn_readfirstlane(F.tid >> 6);
    F.G = gridDim.x; { const int bx = blockIdx.x; F.vcu = (F.G % 8 == 0) ? (bx % 8) * (F.G / 8) + bx / 8 : bx; }
    volatile LAS unsigned* MISC = (volatile LAS unsigned*)(F.lds + MISC_OFF);
    for (int u = F.tid; u < (LDS_BYTES - 131072) / 4; u += NWAVES * 64) ((LAS unsigned*)(F.lds + 131072))[u] = 0u;
    __syncthreads();
    XcdBarrier bar; bar.bar = (unsigned*)(F.ctl + CW_BAR); bar.x = 0; bar.st = nullptr;
    const int lo = args.ph_lo, hi = args.ph_hi;
    if (hi - lo > 1) bar = xcd_barrier_post((unsigned*)(F.ctl + CW_BAR), MISC + 8);
    if (IN(0)) { p0_prologue(F, args); SEAM(0); }
    if (IN(1)) { p1_mod0(F, (const float*)args.in[0], (const float*)(args.ws + WS_ADA), (bf16*)(args.ws + WS_ABUF)); SEAM(1); }
    layer_phases<0>(F, args, bar, lo, hi);
    layer_phases<1>(F, args, bar, lo, hi);
}
#undef IN
#undef SEAM

extern "C" void kernel_launch(void* const* d_in, const int* in_sizes, int n_in, void* d_out, int out_size, void* d_ws, size_t ws_size, hipStream_t stream) {
    static int grid = 0;
    if (grid == 0) {
        int dev = 0, cus = 0, per_cu = 0;
        if (n_in != 19 || ws_size < WS_END) { fprintf(stderr, "kernel_launch: unexpected n_in %d / ws_size %zu\n", n_in, ws_size); }
        if (hipGetDevice(&dev) != hipSuccess || hipDeviceGetAttribute(&cus, hipDeviceAttributeMultiprocessorCount, dev) != hipSuccess) { grid = -1; return; }
        if (hipFuncSetAttribute((const void*)fwd_kernel, hipFuncAttributeMaxDynamicSharedMemorySize, LDS_BYTES) != hipSuccess) { grid = -1; return; }
        if (hipOccupancyMaxActiveBlocksPerMultiprocessor(&per_cu, (const void*)fwd_kernel, NWAVES * 64, LDS_BYTES) != hipSuccess || per_cu < 1) fprintf(stderr, "kernel_launch: occupancy query says %d\n", per_cu);
        (void)hipGetLastError();
        grid = cus;
    }
    if (grid < 0) return;
    (void)hipMemsetAsync((char*)d_ws + WS_CTL, 0, CTL_ZERO_BYTES, stream);
    Args a{};
    for (int i = 0; i < 19; ++i) a.in[i] = d_in[i];
    a.out = (float*)d_out; a.ws = (unsigned char*)d_ws;
#if MK_N_LAUNCHES == 1
    a.ph_lo = 0; a.ph_hi = NPH;
    hipLaunchKernelGGL(fwd_kernel, dim3(grid), dim3(NWAVES * 64), LDS_BYTES, stream, a);
#else
    for (int p = 0; p < NPH; ++p) {
        if (p == 2 + 5) continue;
        a.ph_lo = p; a.ph_hi = p + 1;
        hipLaunchKernelGGL(fwd_kernel, dim3(grid), dim3(NWAVES * 64), LDS_BYTES, stream, a);
    }
#endif
}
```

```cpp
#include <hip/hip_runtime.h>
#include <cstdio>
#include <cstdint>
#include <cmath>
#define MK_N_LAUNCHES 1
namespace pg8 {
#define PG8_LAS __attribute__((address_space(3)))
typedef unsigned short bf16_t;
typedef short bf16x8 __attribute__((ext_vector_type(8)));
typedef float f32x4 __attribute__((ext_vector_type(4)));
typedef unsigned u32x4 __attribute__((ext_vector_type(4)));
constexpr int BM = 256, BK = 64, HALF = 128, HTB = HALF * BK * 2  , STAGE_BYTES = 8 * HTB, NXCD = 8, WGM = 8;

__host__ __device__ __forceinline__ int lds_byte(int r, int c) { const int st = (r >> 4) * 2 + (c >> 5), rr = r & 15, cc = c & 31, ob = rr * 64 + cc * 2; return st * 1024 + (ob ^ (((ob >> 9) & 1) << 5)); }
__host__ __device__ __forceinline__ void stage_rc(int b, int& R, int& C) { const int st = b / 1024, sb = b % 1024, swz = sb ^ (((sb >> 9) & 1) << 5); R = (st >> 1) * 16 + swz / 64; C = (st & 1) * 32 + (swz % 64) / 2; }
__host__ __device__ __forceinline__ int perm32(int rho) { const int n = rho >> 4, i = rho & 15; return 8 * (i >> 2) + 4 * n + (i & 3); }

struct Unit { int pm, pn; };
struct Gemm { const bf16_t* A; const bf16_t* Bt; int M, N, K; };

struct StaticOrder {
    int nM, nN, nwg, G, c;
    __host__ __device__ void init(int M, int N, int G_, int c_) { nM = M / BM; nN = N / BM; nwg = nM * nN; G = G_; c = c_; }
    __host__ __device__ bool next(int i, Unit& u) const {
        const long L = (long)i * G + c; if (L >= nwg) return false;
        int wgid = (int)L; { const int q = nwg / NXCD, r = nwg % NXCD, xcd = wgid % NXCD, off = wgid / NXCD; wgid = (xcd < r ? xcd * (q + 1) : r * (q + 1) + (xcd - r) * q) + off; }
        const int nig = WGM * nN, gid = wgid / nig, fm = gid * WGM, gsz = (nM - fm) < WGM ? (nM - fm) : WGM;
        u.pm = fm + ((wgid % nig) % gsz); u.pn = (wgid % nig) / gsz; return true;
    }
    __device__ __forceinline__ void a_ready(const Unit&) const {}
    __device__ __forceinline__ void done(const Unit&) const {}
};
__device__ __forceinline__ unsigned cvt_pk_bf16(float lo, float hi) { unsigned r; asm volatile("v_cvt_pk_bf16_f32 %0, %1, %2" : "=v"(r) : "v"(lo), "v"(hi)); return r; }

typedef float f32x2 __attribute__((ext_vector_type(2)));
typedef unsigned u32x2 __attribute__((ext_vector_type(2)));
__device__ __forceinline__ float fast_sigmoid(float x) { return __builtin_amdgcn_rcpf(1.0f + __expf(-x)); }
__device__ __forceinline__ float fast_silu(float x) { return x * fast_sigmoid(x); }

struct EpiIn {
    static constexpr bool PERM = false, AFTER_DRAIN = false;
    bf16_t* proj; const float* rope; const float* lb;
    __device__ __forceinline__ void operator()(const f32x4 (&acc)[2][2][4][2], const Unit& u, int wr, int wc, int fr, int fq) const {
        const int row0 = u.pm * BM + wr * 64 + fr;
        const int type = u.pn >> 1;
        if (type < 2) {
            const float sc = (type == 0) ? 0.125f : 1.0f;
            const int g = wc & 1;
#pragma unroll
            for (int ai = 0; ai < 2; ++ai)
#pragma unroll
                for (int m = 0; m < 4; ++m) {
                    const int row = row0 + ai * HALF + m * 16;
                    const f32x4* rp = (const f32x4*)(rope + ((size_t)row * 32 + 16 * g + 4 * fq) * 2);
                    const f32x4 cs0 = rp[0], cs1 = rp[1];
                    const float cc[4] = {cs0[0], cs0[2], cs1[0], cs1[2]}, ss[4] = {cs0[1], cs0[3], cs1[1], cs1[3]};
#pragma unroll
                    for (int bj = 0; bj < 2; ++bj) {
                        const int col = u.pn * BM + (2 * bj + (wc >> 1)) * 64 + 16 * g + 4 * fq;
                        const f32x4 x1 = acc[ai][bj][m][0], x2 = acc[ai][bj][m][1];
                        float o1[4], o2[4];
#pragma unroll
                        for (int j = 0; j < 4; ++j) { o1[j] = (x1[j] * cc[j] - x2[j] * ss[j]) * sc; o2[j] = (x2[j] * cc[j] + x1[j] * ss[j]) * sc; }
                        u32x2 w1, w2; w1.x = cvt_pk_bf16(o1[0], o1[1]); w1.y = cvt_pk_bf16(o1[2], o1[3]); w2.x = cvt_pk_bf16(o2[0], o2[1]); w2.y = cvt_pk_bf16(o2[2], o2[3]);
                        bf16_t* dst = proj + (size_t)row * 4096 + col;
                        *(u32x2*)dst = w1; *(u32x2*)(dst + 32) = w2;
                    }
                }
        } else {
            const int lc0 = u.pn * BM + wc * 32 + 8 * fq;
            f32x4 lbv[2][2];
            if (type == 4 || type == 5) {
#pragma unroll
                for (int bj = 0; bj < 2; ++bj)
#pragma unroll
                    for (int n = 0; n < 2; ++n) lbv[bj][n] = *(const f32x4*)(lb + (lc0 + bj * HALF - 2048) + 4 * n);
            }
#pragma unroll
            for (int ai = 0; ai < 2; ++ai)
#pragma unroll
                for (int m = 0; m < 4; ++m) {
                    const int row = row0 + ai * HALF + m * 16;
#pragma unroll
                    for (int bj = 0; bj < 2; ++bj) {
                        f32x4 v0 = acc[ai][bj][m][0], v1 = acc[ai][bj][m][1];
                        if (type == 3) {
#pragma unroll
                            for (int j = 0; j < 4; ++j) { v0[j] = fast_silu(v0[j]); v1[j] = fast_silu(v1[j]); }
                        } else if (type == 7) {
#pragma unroll
                            for (int j = 0; j < 4; ++j) { v0[j] = fast_sigmoid(v0[j]); v1[j] = fast_sigmoid(v1[j]); }
                        } else if (type == 4 || type == 5) {
#pragma unroll
                            for (int j = 0; j < 4; ++j) {
                                const float l0 = lbv[bj][0][j], l1 = lbv[bj][1][j];
                                v0[j] = __logf(l0 + (1.0f - l0) * fast_sigmoid(v0[j]));
                                v1[j] = __logf(l1 + (1.0f - l1) * fast_sigmoid(v1[j]));
                            }
                        }
                        u32x4 w; w.x = cvt_pk_bf16(v0[0], v0[1]); w.y = cvt_pk_bf16(v0[2], v0[3]); w.z = cvt_pk_bf16(v1[0], v1[1]); w.w = cvt_pk_bf16(v1[2], v1[3]);
                        *(u32x4*)(proj + (size_t)row * 4096 + lc0 + bj * HALF) = w;
                    }
                }
        }
    }
};

struct EpiRes {
    static constexpr bool PERM = false, AFTER_DRAIN = false;
    const float* xres; float* t; const float* gate; float alpha;
    __device__ __forceinline__ void operator()(const f32x4 (&acc)[2][2][4][2], const Unit& u, int wr, int wc, int fr, int fq) const {
        const int row0 = u.pm * BM + wr * 64 + fr, col0 = u.pn * BM + wc * 32 + 4 * fq;
        const int b = u.pm >> 3;
        f32x4 gv[2][2];
#pragma unroll
        for (int bj = 0; bj < 2; ++bj)
#pragma unroll
            for (int n = 0; n < 2; ++n) gv[bj][n] = *(const f32x4*)(gate + (size_t)b * 3072 + 2048 + col0 + bj * HALF + n * 16) + 1.0f;
#pragma unroll
        for (int ai = 0; ai < 2; ++ai)
#pragma unroll
            for (int m = 0; m < 4; ++m) {
                const size_t off = (size_t)(row0 + ai * HALF + m * 16) * 1024 + col0;
#pragma unroll
                for (int bj = 0; bj < 2; ++bj)
#pragma unroll
                    for (int n = 0; n < 2; ++n) {
                        const f32x4 xr = *(const f32x4*)(xres + off + bj * HALF + n * 16);
                        *(f32x4*)(t + off + bj * HALF + n * 16) = xr * alpha + gv[bj][n] * acc[ai][bj][m][n];
                    }
            }
    }
};

template <int ldh, int nNloc> struct EpiGU {
    static constexpr bool PERM = false, AFTER_DRAIN = false;
    bf16_t* hid;
    __device__ __forceinline__ void operator()(const f32x4 (&acc)[2][2][4][2], const Unit& u, int wr, int wc, int fr, int fq) const {
        const int row0 = u.pm * BM + wr * 64 + fr, col0 = (u.pn % nNloc) * HALF + wc * 32 + 8 * fq;
#pragma unroll
        for (int ai = 0; ai < 2; ++ai)
#pragma unroll
            for (int m = 0; m < 4; ++m) {
                const f32x4 g0 = acc[ai][0][m][0], g1 = acc[ai][0][m][1], u0 = acc[ai][1][m][0], u1 = acc[ai][1][m][1];
                f32x4 h0, h1;
#pragma unroll
                for (int j = 0; j < 4; ++j) { h0[j] = fast_silu(g0[j]) * u0[j]; h1[j] = fast_silu(g1[j]) * u1[j]; }
                u32x4 w; w.x = cvt_pk_bf16(h0[0], h0[1]); w.y = cvt_pk_bf16(h0[2], h0[3]); w.z = cvt_pk_bf16(h1[0], h1[1]); w.w = cvt_pk_bf16(h1[2], h1[3]);
                *(u32x4*)(hid + (size_t)(row0 + ai * HALF + m * 16) * ldh + col0) = w;
            }
    }
};

struct EpiMoeDn {
    static constexpr bool PERM = false, AFTER_DRAIN = false;
    const unsigned* rowinfo; bf16_t* yslot;
    __device__ __forceinline__ void operator()(const f32x4 (&acc)[2][2][4][2], const Unit& u, int wr, int wc, int fr, int fq) const {
        const int row0 = u.pm * BM + wr * 64 + fr, col0 = (u.pn & 3) * BM + wc * 32 + 4 * fq;
#pragma unroll
        for (int ai = 0; ai < 2; ++ai)
#pragma unroll
            for (int m = 0; m < 4; ++m) {
                const int row = row0 + ai * HALF + m * 16;
                const u32x2 inf = *(const u32x2*)(rowinfo + 2 * (size_t)row);
                if (inf.x != 0xffffffffu) {
                    const float w = __uint_as_float(inf.y);
                    bf16_t* dst = yslot + ((size_t)(inf.x >> 16) * 16384 + (inf.x & 0xffffu)) * 1024 + col0;
#pragma unroll
                    for (int bj = 0; bj < 2; ++bj)
#pragma unroll
                        for (int n = 0; n < 2; ++n) {
                            const f32x4 v = acc[ai][bj][m][n] * w;
                            u32x2 o; o.x = cvt_pk_bf16(v[0], v[1]); o.y = cvt_pk_bf16(v[2], v[3]);
                            *(u32x2*)(dst + bj * HALF + n * 16) = o;
                        }
                }
            }
    }
};

struct MoeOrder : StaticOrder {
    int ts1, ts2, ts3, ts4, ts5, ts6, ts7, nNloc;
    __device__ __forceinline__ bool next(int i, Unit& u) const {
        if (!StaticOrder::next(i, u)) return false;
        const int e = (u.pm >= ts1) + (u.pm >= ts2) + (u.pm >= ts3) + (u.pm >= ts4) + (u.pm >= ts5) + (u.pm >= ts6) + (u.pm >= ts7);
        u.pn += e * nNloc; return true;
    }
};

template <class Epi, class Sched, bool ALIGN_EPI = false, bool SP2 = false>
__device__ __forceinline__ void gemm_phase(PG8_LAS unsigned char* lds, const Gemm g, const Sched& S, const Epi& E) {
    const int tid = threadIdx.x, wid = __builtin_amdgcn_readfirstlane(tid >> 6), lane = tid & 63, wr = wid >> 2, wc = wid & 3, fr = lane & 15, fq = lane >> 4;
    const int K = g.K, nt = K / BK;
    unsigned voffA[2], voffB[2];
#pragma unroll
    for (int i = 0; i < 2; ++i) { int R, C; stage_rc(tid * 16 + i * 8192, R, C); const int Rb = Epi::PERM ? ((R & ~31) + perm32(R & 31)) : R;
        voffA[i] = (unsigned)(R * K + C) * 2u; voffB[i] = (unsigned)(Rb * K + C) * 2u; }
    const size_t kstep = (size_t)(BK * 2);
    const size_t hstep = (size_t)HALF * K * 2;
    const size_t tstep = 2 * hstep;
    const unsigned ldsw = (unsigned)wid * 1024u;
    const int aoff = lds_byte(wr * 64 + fr, fq * 8), boff = lds_byte(wc * 32 + fr, fq * 8);
#define PG8_SA(b, h) (((b) * 2 + (h)) * HTB)
#define PG8_SB(b, h) ((4 + (b) * 2 + (h)) * HTB)
#define PG8_STAGE(bufoff, gbase, voff) do { _Pragma("unroll") for (int _i = 0; _i < 2; ++_i) \
        __builtin_amdgcn_global_load_lds((const unsigned*)((const char*)(gbase) + (voff)[_i]), (PG8_LAS unsigned*)(lds + (bufoff) + ldsw + _i * 8192), 16, 0, 0); } while (0)
#define PG8_LDA(dst, b, h) do { _Pragma("unroll") for (int m = 0; m < 4; ++m) _Pragma("unroll") for (int k = 0; k < 2; ++k) dst[m][k] = *(const PG8_LAS bf16x8*)(lds + PG8_SA(b, h) + aoff + m * 2048 + k * 1024); } while (0)
#define PG8_LDB(dst, b, h) do { _Pragma("unroll") for (int n = 0; n < 2; ++n) _Pragma("unroll") for (int k = 0; k < 2; ++k) dst[n][k] = *(const PG8_LAS bf16x8*)(lds + PG8_SB(b, h) + boff + n * 2048 + k * 1024); } while (0)
#define PG8_MMA(ai, bj, At, Bt) do { __builtin_amdgcn_s_setprio(1); _Pragma("unroll") for (int m = 0; m < 4; ++m) _Pragma("unroll") for (int n = 0; n < 2; ++n) _Pragma("unroll") for (int k = 0; k < 2; ++k) \
        acc[ai][bj][m][n] = __builtin_amdgcn_mfma_f32_16x16x32_bf16(Bt[n][k], At[m][k], acc[ai][bj][m][n], 0, 0, 0); __builtin_amdgcn_s_setprio(0); } while (0)
#define PG8_WAIT_V(n) asm volatile("s_waitcnt vmcnt(" #n ")" ::: "memory")
#define PG8_WAIT_L(n) asm volatile("s_waitcnt lgkmcnt(" #n ")" ::: "memory")
#define PG8_BAR __builtin_amdgcn_s_barrier()
#define PG8_SCHED __builtin_amdgcn_sched_barrier(0)
    Unit cur, nxt; int ui = 0;
    if (!S.next(0, cur)) return;
    f32x4 acc[2][2][4][2];
#pragma unroll
    for (int a = 0; a < 2; ++a)
#pragma unroll
        for (int b = 0; b < 2; ++b)
#pragma unroll
            for (int m = 0; m < 4; ++m)
#pragma unroll
                for (int n = 0; n < 2; ++n) acc[a][b][m][n] = (f32x4){0.f, 0.f, 0.f, 0.f};
    bf16x8 At[4][2], B0[2][2], B1[2][2];
    const char* cA = (const char*)g.A + (size_t)cur.pm * tstep; const char* cB = (const char*)g.Bt + (size_t)cur.pn * tstep;
    S.a_ready(cur);
    if constexpr (SP2) {
        PG8_STAGE(PG8_SB(0, 0), cB, voffB); PG8_STAGE(PG8_SB(0, 1), cB + hstep, voffB); PG8_STAGE(PG8_SA(0, 0), cA, voffA); PG8_STAGE(PG8_SA(0, 1), cA + hstep, voffA);
        if (wr == 1) PG8_BAR;
        PG8_WAIT_V(2); PG8_BAR;
        PG8_STAGE(PG8_SB(1, 0), cB + kstep, voffB); PG8_STAGE(PG8_SA(1, 0), cA + kstep, voffA); PG8_STAGE(PG8_SB(1, 1), cB + hstep + kstep, voffB);
        PG8_WAIT_V(6); PG8_BAR;
    } else {
        PG8_STAGE(PG8_SB(0, 0), cB, voffB); PG8_STAGE(PG8_SA(0, 0), cA, voffA); PG8_STAGE(PG8_SB(0, 1), cB + hstep, voffB); PG8_STAGE(PG8_SA(0, 1), cA + hstep, voffA);
        if (wr == 1) PG8_BAR;
        PG8_WAIT_V(4); PG8_BAR;
        PG8_STAGE(PG8_SB(1, 0), cB + kstep, voffB); PG8_STAGE(PG8_SA(1, 0), cA + kstep, voffA); PG8_STAGE(PG8_SB(1, 1), cB + hstep + kstep, voffB);
        PG8_WAIT_V(6); PG8_BAR;
    }
    for (;;) {
        const bool has_next = S.next(ui + 1, nxt);
        const char* nA = has_next ? (const char*)g.A + (size_t)nxt.pm * tstep : cA; const char* nB = has_next ? (const char*)g.Bt + (size_t)nxt.pn * tstep : cB;
        for (int t = 0; t < nt; t += 2) {
            const bool last = (t == nt - 2);
            const char* a1 = cA + (size_t)(t + 1) * kstep;
            const char* a2 = last ? nA : cA + (size_t)(t + 2) * kstep; const char* b2 = last ? nB : cB + (size_t)(t + 2) * kstep;
            const char* a3 = a2 + kstep; const char* b3 = b2 + kstep;
            if (last && has_next) S.a_ready(nxt);
            if constexpr (SP2) {
            PG8_LDB(B0, 0, 0); PG8_LDB(B1, 0, 1); PG8_SCHED; PG8_LDA(At, 0, 0); PG8_STAGE(PG8_SA(1, 1), a1 + hstep, voffA);
            PG8_WAIT_V(8); PG8_WAIT_L(0); PG8_BAR; PG8_MMA(0, 0, At, B0); PG8_MMA(0, 1, At, B1); PG8_BAR; PG8_SCHED;
            PG8_LDA(At, 0, 1); PG8_STAGE(PG8_SB(0, 0), b2, voffB); PG8_STAGE(PG8_SB(0, 1), b2 + hstep, voffB); PG8_STAGE(PG8_SA(0, 0), a2, voffA);
            PG8_WAIT_V(8); PG8_WAIT_L(0); PG8_BAR; PG8_MMA(1, 0, At, B0); PG8_MMA(1, 1, At, B1); PG8_BAR; PG8_SCHED;
            PG8_LDB(B0, 1, 0); PG8_LDB(B1, 1, 1); PG8_SCHED; PG8_LDA(At, 1, 0); PG8_STAGE(PG8_SA(0, 1), a2 + hstep, voffA);
            PG8_WAIT_V(8); PG8_WAIT_L(0); PG8_BAR; PG8_MMA(0, 0, At, B0); PG8_MMA(0, 1, At, B1); PG8_BAR; PG8_SCHED;
            PG8_LDA(At, 1, 1); PG8_STAGE(PG8_SB(1, 0), b3, voffB); PG8_STAGE(PG8_SB(1, 1), b3 + hstep, voffB); PG8_STAGE(PG8_SA(1, 0), a3, voffA);
            PG8_WAIT_V(8); PG8_WAIT_L(0); PG8_BAR; PG8_MMA(1, 0, At, B0); PG8_MMA(1, 1, At, B1); PG8_BAR; PG8_SCHED;
            } else {
            PG8_LDB(B0, 0, 0); PG8_SCHED; PG8_LDA(At, 0, 0); PG8_STAGE(PG8_SA(1, 1), a1 + hstep, voffA);
            PG8_WAIT_L(8); PG8_BAR; PG8_WAIT_L(0); PG8_MMA(0, 0, At, B0); PG8_BAR; PG8_SCHED;
            PG8_LDB(B1, 0, 1); PG8_STAGE(PG8_SB(0, 0), b2, voffB);
            PG8_BAR; PG8_WAIT_L(0); PG8_MMA(0, 1, At, B1); PG8_BAR;
            PG8_LDA(At, 0, 1); PG8_STAGE(PG8_SA(0, 0), a2, voffA);
            PG8_BAR; PG8_WAIT_L(0); PG8_MMA(1, 0, At, B0); PG8_BAR; PG8_SCHED;
            PG8_STAGE(PG8_SB(0, 1), b2 + hstep, voffB);
            PG8_WAIT_V(6); PG8_BAR; PG8_MMA(1, 1, At, B1); PG8_BAR;
            PG8_LDB(B0, 1, 0); PG8_SCHED; PG8_LDA(At, 1, 0); PG8_STAGE(PG8_SA(0, 1), a2 + hstep, voffA);
            PG8_WAIT_L(8); PG8_BAR; PG8_WAIT_L(0); PG8_MMA(0, 0, At, B0); PG8_BAR; PG8_SCHED;
            PG8_LDB(B1, 1, 1); PG8_STAGE(PG8_SB(1, 0), b3, voffB);
            PG8_BAR; PG8_WAIT_L(0); PG8_MMA(0, 1, At, B1); PG8_BAR;
            PG8_LDA(At, 1, 1); PG8_STAGE(PG8_SA(1, 0), a3, voffA);
            PG8_BAR; PG8_WAIT_L(0); PG8_MMA(1, 0, At, B0); PG8_BAR; PG8_SCHED;
            PG8_STAGE(PG8_SB(1, 1), b3 + hstep, voffB);
            PG8_WAIT_V(6); PG8_BAR; PG8_MMA(1, 1, At, B1); PG8_BAR;
            }
        }
        if constexpr (ALIGN_EPI) { if (wr == 0) PG8_BAR; }
        if constexpr (!Epi::AFTER_DRAIN) { E(acc, cur, wr, wc, fr, fq); S.done(cur); }
        if (!has_next) break;
#pragma unroll
        for (int a = 0; a < 2; ++a)
#pragma unroll
            for (int b = 0; b < 2; ++b)
#pragma unroll
                for (int m = 0; m < 4; ++m)
#pragma unroll
                    for (int n = 0; n < 2; ++n) acc[a][b][m][n] = (f32x4){0.f, 0.f, 0.f, 0.f};
        cur = nxt; cA = nA; cB = nB; ++ui;
        if constexpr (ALIGN_EPI) { if (wr == 1) PG8_BAR; }
    }
    PG8_WAIT_V(0);
    if constexpr (!ALIGN_EPI) { if (wr == 0) PG8_BAR; }
    PG8_BAR;
    if constexpr (Epi::AFTER_DRAIN) { E.fused(acc, cur, wr, wc, fr, fq, lds, wid, lane); S.done(cur); }
#undef PG8_SA
#undef PG8_SB
#undef PG8_STAGE
#undef PG8_LDA
#undef PG8_LDB
#undef PG8_MMA
#undef PG8_WAIT_V
#undef PG8_WAIT_L
#undef PG8_BAR
#undef PG8_SCHED
}
}


#ifndef PG8_SP2
#define PG8_SP2 true
#endif
#ifndef PG8_ALIGN
#define PG8_ALIGN true
#endif
#ifndef MK_N_LAUNCHES
#define MK_N_LAUNCHES 1
#endif

constexpr int NB = 8, SEQ = 2048, DM = 1024, MT = NB * SEQ;
constexpr int INC = 4096, NAH = 8;
constexpr int FFD = 2752, FFDP = 2816, NEX = 8, FFE = 3584;
constexpr int MOE_ROWS = 2 * MT + NEX * 256;
constexpr float DN_ALPHA = 1.41421356237309515f;
constexpr float LN_EPS = 1e-5f, RMS_EPS = 1e-6f;
constexpr int NWAVES = 8;

constexpr size_t MiB = 1u << 20;
constexpr size_t WS_CTL = 0, CTL_ZERO_BYTES = 1 * MiB;
constexpr size_t WS_ADA = 1 * MiB;
constexpr size_t WS_LB = 1 * MiB + 512 * 1024;
constexpr size_t WS_ROPE = 2 * MiB;
constexpr size_t WS_ROUTE = 6 * MiB;
constexpr size_t WS_ROWINFO = 6 * MiB + 512 * 1024;
constexpr size_t WS_WMGU = 8 * MiB;
constexpr size_t WS_WMDN = 120 * MiB;
constexpr size_t WS_WIN = 176 * MiB;
constexpr size_t WS_WOUT = 192 * MiB;
constexpr size_t WS_WGU = 196 * MiB;
constexpr size_t WS_WDN = 207 * MiB;
constexpr size_t WS_ABUF = 213 * MiB;
constexpr size_t WS_GATH = 176 * MiB;
constexpr size_t WS_YSLOT = 176 * MiB;
constexpr size_t WS_BIG = 245 * MiB;
constexpr size_t WS_PROJ = WS_BIG;
constexpr size_t WS_ATTO = WS_BIG + 128 * MiB;
constexpr size_t WS_ODIR = WS_BIG + 178 * MiB;
constexpr size_t WS_HID = WS_BIG;
constexpr size_t WS_END = 483 * MiB;
static_assert(WS_GATH + (size_t)MOE_ROWS * 1024 * 2 <= WS_BIG && WS_HID + (size_t)MOE_ROWS * FFE * 2 <= WS_END && WS_WDN + (size_t)1024 * FFDP * 2 <= WS_ABUF, "d_ws map");
constexpr int CW_TMO = 0, CW_BAR = 4096, CW_CNT = 16384;

constexpr int LDS_BYTES = 147456;
constexpr int MISC_OFF = 131072 + 320;

#define GAS __attribute__((address_space(1)))
#define LAS __attribute__((address_space(3)))
typedef unsigned short bf16;
typedef unsigned v4u __attribute__((ext_vector_type(4)));
typedef unsigned v2u __attribute__((ext_vector_type(2)));
typedef float f32x4 __attribute__((ext_vector_type(4)));
typedef GAS unsigned gu32;
#define RLX_AGENT __ATOMIC_RELAXED, __HIP_MEMORY_SCOPE_AGENT
#define LDS_WAIT() asm volatile("s_waitcnt lgkmcnt(0)" ::: "memory")
__device__ __forceinline__ unsigned f2bf(float f) { unsigned u = __builtin_bit_cast(unsigned, f); return (u + 0x7fffu + ((u >> 16) & 1u)) >> 16; }
__device__ __forceinline__ unsigned pk2(float lo, float hi) { return f2bf(lo) | (f2bf(hi) << 16); }
__device__ __forceinline__ float bflo(unsigned w) { return __uint_as_float(w << 16); }
__device__ __forceinline__ float bfhi(unsigned w) { return __uint_as_float(w & 0xffff0000u); }
__device__ __forceinline__ float bf1(bf16 h) { return __uint_as_float(((unsigned)h) << 16); }

#define XB_TMO      128
#define XB_XCNT(j)  (256  + 64 * (j))
#define XB_XSUB(j)  (1280 + 64 * (j))
#define XB_XGEN(j)  (2304 + 64 * (j))
#define XB_TOP      3328
#define XB_TOPGEN   3392
#define XCD_BAR_WORDS 3456
#define XB_SPIN_CAP (1u << 18)

__device__ __forceinline__ unsigned xb_ld(unsigned* p)              { return __hip_atomic_load(p, __ATOMIC_RELAXED, __HIP_MEMORY_SCOPE_AGENT); }
__device__ __forceinline__ unsigned xb_add(unsigned* p, unsigned v) { return __hip_atomic_fetch_add(p, v, __ATOMIC_RELAXED, __HIP_MEMORY_SCOPE_AGENT); }
__device__ __forceinline__ unsigned xb_xcc_id() { return (unsigned)__builtin_amdgcn_s_getreg((3 << 11) | 20) & 0xFu; }
#define XB_SPIN(cond, bar) do { unsigned _sp = 0; while (cond) { __builtin_amdgcn_s_sleep(1); \
    if ((++_sp & 255u) == 0u) { if (xb_ld(&(bar)[XB_TMO])) break; if (_sp > XB_SPIN_CAP) { atomicAdd(&(bar)[XB_TMO], 1u); break; } } } } while (0)

struct XcdBarrier {
    unsigned* bar; unsigned x;
    volatile LAS unsigned* st;
};

__device__ __forceinline__ XcdBarrier xcd_barrier_post(unsigned* bar, volatile LAS unsigned* st) {
    XcdBarrier b; b.bar = bar; b.x = xb_xcc_id(); b.st = st;
    if (threadIdx.x == 0) (void)xb_add(&bar[XB_XCNT(b.x)], 1u);
    return b;
}
__device__ __forceinline__ void xcd_barrier_complete(unsigned* bar, unsigned x, unsigned& nloc, unsigned& nx) {
    const unsigned G = gridDim.x * gridDim.y * gridDim.z;
    unsigned sum, cnt, mine, sp = 0u;
    for (;;) {
        sum = 0u; cnt = 0u; mine = 0u;
#pragma unroll
        for (unsigned j = 0; j < 16; ++j) { const unsigned c = xb_ld(&bar[XB_XCNT(j)]); sum += c; cnt += (c > 0u) ? 1u : 0u; mine = (j == x) ? c : mine; }
        if (sum == G) break;
        __builtin_amdgcn_s_sleep(1);
        if ((++sp & 255u) == 0u) { if (xb_ld(&bar[XB_TMO])) break; if (sp > XB_SPIN_CAP) { atomicAdd(&bar[XB_TMO], 1u); break; } }
    }
    nloc = mine > 0u ? mine : 1u; nx = cnt > 0u ? cnt : 1u;
}

__device__ __forceinline__ void xcd_barrier(const XcdBarrier& b) {
    asm volatile("s_waitcnt vmcnt(0)" ::: "memory");
    __syncthreads();
    if (threadIdx.x == 0) {
        unsigned* bar = b.bar;
        __builtin_amdgcn_s_waitcnt(0);
        unsigned nloc = b.st[0], nx = b.st[1];
        if (nloc == 0u) { xcd_barrier_complete(bar, b.x, nloc, nx); b.st[0] = nloc; b.st[1] = nx; }
        const unsigned old = xb_add(&bar[XB_XSUB(b.x)], 1u);
        const unsigned gen = old / nloc;
        if (old + 1u == (gen + 1u) * nloc) {
            __builtin_amdgcn_fence(__ATOMIC_RELEASE, "agent");
            asm volatile("s_waitcnt vmcnt(0)" ::: "memory");
            const unsigned og = xb_add(&bar[XB_TOP], 1u);
            const unsigned tg = og / nx;
            if (og + 1u == (tg + 1u) * nx) xb_add(&bar[XB_TOPGEN], 1u);
            else XB_SPIN(xb_ld(&bar[XB_TOPGEN]) == tg, bar);
            __builtin_amdgcn_fence(__ATOMIC_ACQUIRE, "agent");
            xb_add(&bar[XB_XGEN(b.x)], 1u);
            asm volatile("s_waitcnt vmcnt(0)" ::: "memory");
        } else {
            XB_SPIN(xb_ld(&bar[XB_XGEN(b.x)]) == gen, bar);
            __builtin_amdgcn_fence(__ATOMIC_ACQUIRE, "agent");
            asm volatile("s_waitcnt vmcnt(0)" ::: "memory");
        }
    }
    __syncthreads();
}


struct Args { const void* in[19]; float* out; unsigned char* ws; int ph_lo, ph_hi; };

struct Frame {
    LAS unsigned char* lds; unsigned char* ws; gu32* ctl;
    int tid, lane, wave, G, vcu;
};

__device__ __forceinline__ float wave_sum(float v) {
#pragma unroll
    for (int o = 1; o < 64; o <<= 1) v += __shfl_xor(v, o);
    return v;
}

template <int KIND>
__device__ __forceinline__ void p0_tile(const float* W, int ldn, int k0, int n0, bool zero, bf16* dst, int ldk, int sel, LAS float* scr, int lane) {
    if (!zero) {
#pragma unroll 8
        for (int i = 0; i < 32; ++i) { const int kk = 2 * i + (lane >> 5); scr[kk * 33 + (lane & 31)] = W[(size_t)(k0 + kk) * ldn + n0 + (lane & 31)]; }
    }
    LDS_WAIT(); asm volatile("" ::: "memory");
    const int c = lane & 7;
#pragma unroll
    for (int j = 0; j < 4; ++j) {
        const int n = (lane >> 3) + 8 * j, lc = n0 + n; int prow;
        if (KIND == 0) {
            if (lc < 1024) { const int d = lc & 63; prow = (lc & ~63) + 32 * ((d >> 4) & 1) + 16 * (d >> 5) + (d & 15); }
            else { const int x = lc & 31; prow = (lc & ~31) + 16 * ((x >> 2) & 1) + 4 * (x >> 3) + (x & 3); }
        } else if (KIND == 1) prow = lc;
        else { const int x = lc & 31; prow = 256 * (lc >> 7) + 128 * sel + 32 * ((lc >> 5) & 3) + 16 * ((x >> 2) & 1) + 4 * (x >> 3) + (x & 3); }
        v4u o;
        if (zero) { o = (v4u){0u, 0u, 0u, 0u}; }
        else { const LAS float* s = scr + (8 * c) * 33 + n;
            o.x = pk2(s[0 * 33], s[1 * 33]); o.y = pk2(s[2 * 33], s[3 * 33]); o.z = pk2(s[4 * 33], s[5 * 33]); o.w = pk2(s[6 * 33], s[7 * 33]); }
        *(v4u*)(dst + (size_t)prow * ldk + k0 + 8 * c) = o;
    }
    LDS_WAIT(); asm volatile("" ::: "memory");
}

__device__ __forceinline__ void p0_prologue(Frame& F, const Args& a) {
    const float* c_in = (const float*)a.in[1]; const int* positions = (const int*)a.in[2];
    const float* w_in = (const float*)a.in[3]; const float* w_out = (const float*)a.in[4];
    const float* lb_logits = (const float*)a.in[7]; const float* ada_w = (const float*)a.in[8]; const float* ada_b = (const float*)a.in[9];
    const float* ffn_g = (const float*)a.in[12]; const float* ffn_u = (const float*)a.in[13]; const float* ffn_d = (const float*)a.in[14];
    const float* moe_g = (const float*)a.in[16]; const float* moe_u = (const float*)a.in[17]; const float* moe_d = (const float*)a.in[18];
    float* ada = (float*)(F.ws + WS_ADA); float* lbt = (float*)(F.ws + WS_LB); float* rope = (float*)(F.ws + WS_ROPE);
    if (F.vcu < 24) {
        LAS float* cact = (LAS float*)F.lds;
        for (int i = F.tid; i < NB * DM; i += 512) { const float v = c_in[i]; cact[i] = v / (1.0f + __expf(-v)); }
        __syncthreads();
        const int ls = F.vcu / 6, n = (F.vcu % 6) * 512 + F.tid;
        const float* w = ada_w + (size_t)ls * DM * 3072 + n;
        float acc[8];
#pragma unroll
        for (int b = 0; b < 8; ++b) acc[b] = 0.f;
#pragma unroll 4
        for (int k = 0; k < DM; ++k) { const float wv = w[(size_t)k * 3072];
#pragma unroll
            for (int b = 0; b < 8; ++b) acc[b] += cact[b * DM + k] * wv; }
        const float bias = ada_b[ls * 3072 + n];
#pragma unroll
        for (int b = 0; b < 8; ++b) ada[(size_t)(ls * 8 + b) * 3072 + n] = acc[b] + bias;
        __syncthreads();
    }
    const int gt = F.vcu * 512 + F.tid, GT = F.G * 512;
    for (int i = gt; i < MT * 32; i += GT) {
        const int m = i >> 5, d = i & 31;
        const float ang = (float)positions[m] * exp2f(-(float)d * 0.41524101186092029f);
        const double rev = (double)ang * 0.15915494309189533577;
        const float fr = (float)(rev - __builtin_rint(rev));
        rope[2 * (size_t)i] = __builtin_amdgcn_cosf(fr); rope[2 * (size_t)i + 1] = __builtin_amdgcn_sinf(fr);
    }
    for (int i = gt; i < 2 * 512; i += GT) {
        const float a0 = lb_logits[i], a1 = lb_logits[1024 + i];
        lbt[i] = 0.f; lbt[1024 + i] = 1.0f / (1.0f + __expf(a0 - a1));
    }
    LAS float* scr = (LAS float*)(F.lds + 32768 + F.wave * 8704);
    const int gw = F.vcu * NWAVES + F.wave, NGW = F.G * NWAVES;
    constexpr int I0 = 2 * 16 * 128, I1 = 2 * 16 * 32, I2 = 2 * 16 * 88, I3 = 44 * 32, I4 = 8 * 2 * 16 * 112, I5 = 8 * 56 * 32;
    constexpr int NITEMS = I0 + I1 + I2 + I3 + I4 + I5;
    for (int it = gw; it < NITEMS; it += NGW) {
        int r = it;
        if (r < I0) { const int l = r / 2048, q = r % 2048, kb = q / 128, nb = q % 128;
            p0_tile<0>(w_in + (size_t)l * DM * INC, INC, 64 * kb, 32 * nb, false, (bf16*)(F.ws + WS_WIN) + (size_t)l * INC * DM, DM, 0, scr, F.lane); continue; } r -= I0;
        if (r < I1) { const int l = r / 512, q = r % 512, kb = q / 32, nb = q % 32;
            p0_tile<1>(w_out + (size_t)l * DM * DM, DM, 64 * kb, 32 * nb, false, (bf16*)(F.ws + WS_WOUT) + (size_t)l * DM * DM, DM, 0, scr, F.lane); continue; } r -= I1;
        if (r < I2) { const int sel = r / 1408, q = r % 1408, kb = q / 88, nb = q % 88;
            p0_tile<2>(sel ? ffn_u : ffn_g, FFD, 64 * kb, 32 * nb, nb >= 86, (bf16*)(F.ws + WS_WGU), DM, sel, scr, F.lane); continue; } r -= I2;
        if (r < I3) { const int kb = r / 32, nb = r % 32;
            p0_tile<1>(ffn_d, DM, 64 * kb, 32 * nb, kb >= 43, (bf16*)(F.ws + WS_WDN), FFDP, 0, scr, F.lane); continue; } r -= I3;
        if (r < I4) { const int e = r / 3584, q0 = r % 3584, sel = q0 / 1792, q = q0 % 1792, kb = q / 112, nb = q % 112;
            p0_tile<2>((sel ? moe_u : moe_g) + (size_t)e * DM * FFE, FFE, 64 * kb, 32 * nb, false, (bf16*)(F.ws + WS_WMGU) + (size_t)e * 2 * FFE * DM, DM, sel, scr, F.lane); continue; } r -= I4;
        { const int e = r / 1792, q = r % 1792, kb = q / 32, nb = q % 32;
            p0_tile<1>(moe_d + (size_t)e * FFE * DM, DM, 64 * kb, 32 * nb, false, (bf16*)(F.ws + WS_WMDN) + (size_t)e * DM * FFE, FFE, 0, scr, F.lane); }
    }
}

__device__ __forceinline__ void p1_mod0(Frame& F, const float* x, const float* adar  , bf16* abuf) {
    const int gw = F.vcu * NWAVES + F.wave, NGW = F.G * NWAVES;
    for (int m = gw; m < MT; m += NGW) {
        const int b = m >> 11; const float* ar = adar + (size_t)b * 3072;
        const f32x4* xr = (const f32x4*)(x + (size_t)m * DM) + F.lane;
        unsigned long long* o8 = (unsigned long long*)(abuf + (size_t)m * DM) + F.lane;
#pragma unroll
        for (int j = 0; j < 4; ++j) {
            const f32x4 v = xr[64 * j]; const int col = 4 * F.lane + 256 * j;
            const f32x4 sh = *(const f32x4*)(ar + col), sc = *(const f32x4*)(ar + 1024 + col);
            const f32x4 u = v * (sc + 1.0f) + sh;
            o8[64 * j] = (unsigned long long)pk2(u[0], u[1]) | ((unsigned long long)pk2(u[2], u[3]) << 32);
        }
    }
}

__device__ __forceinline__ void attn_simple(Frame& F, const bf16* proj, bf16* atto) {
    for (int gid = F.vcu * 512 + F.tid; gid < NB * NAH * SEQ; gid += F.G * 512) {
        const int i = gid & (SEQ - 1), h = (gid >> 11) & 7, b = gid >> 14;
        const size_t rowb = (size_t)b * SEQ;
        float q[64], o[64];
        { const v4u* qp = (const v4u*)(proj + (rowb + i) * INC + h * 64);
#pragma unroll
          for (int c = 0; c < 8; ++c) { const v4u w = qp[c]; q[8 * c] = bflo(w.x); q[8 * c + 1] = bfhi(w.x); q[8 * c + 2] = bflo(w.y); q[8 * c + 3] = bfhi(w.y); q[8 * c + 4] = bflo(w.z); q[8 * c + 5] = bfhi(w.z); q[8 * c + 6] = bflo(w.w); q[8 * c + 7] = bfhi(w.w); } }
#pragma unroll
        for (int d = 0; d < 64; ++d) o[d] = 0.f;
        float mx = -1e30f, l = 0.f;
        for (int p = 0; p < 3; ++p) {
            const int dl = (p == 0) ? 1 : (p == 1 ? 4 : 16);
            for (int j = -64; j <= 64; ++j) {
                const int pos = i + dl * j;
                if (pos < 0 || pos >= SEQ) continue;
                const v4u* kp = (const v4u*)(proj + (rowb + pos) * INC + 512 + h * 64);
                float s = 0.f;
#pragma unroll
                for (int c = 0; c < 8; ++c) { const v4u w = kp[c];
                    s += q[8 * c] * bflo(w.x) + q[8 * c + 1] * bfhi(w.x) + q[8 * c + 2] * bflo(w.y) + q[8 * c + 3] * bfhi(w.y) + q[8 * c + 4] * bflo(w.z) + q[8 * c + 5] * bfhi(w.z) + q[8 * c + 6] * bflo(w.w) + q[8 * c + 7] * bfhi(w.w); }
                if (s > mx) { const float r = __expf(mx - s); l *= r;
#pragma unroll
                    for (int d = 0; d < 64; ++d) o[d] *= r;
                    mx = s; }
                const float pe = __expf(s - mx); l += pe;
                const v4u* vp = (const v4u*)(proj + (rowb + pos) * INC + 1024 + h * 64);
#pragma unroll
                for (int c = 0; c < 8; ++c) { const v4u w = vp[c];
                    o[8 * c] += pe * bflo(w.x); o[8 * c + 1] += pe * bfhi(w.x); o[8 * c + 2] += pe * bflo(w.y); o[8 * c + 3] += pe * bfhi(w.y); o[8 * c + 4] += pe * bflo(w.z); o[8 * c + 5] += pe * bfhi(w.z); o[8 * c + 6] += pe * bflo(w.w); o[8 * c + 7] += pe * bfhi(w.w); }
            }
        }
        const float inv = 1.0f / l;
        v4u* op = (v4u*)(atto + (rowb + i) * 512 + h * 64);
#pragma unroll
        for (int c = 0; c < 8; ++c) { v4u w; w.x = pk2(o[8 * c] * inv, o[8 * c + 1] * inv); w.y = pk2(o[8 * c + 2] * inv, o[8 * c + 3] * inv); w.z = pk2(o[8 * c + 4] * inv, o[8 * c + 5] * inv); w.w = pk2(o[8 * c + 6] * inv, o[8 * c + 7] * inv); op[c] = w; }
    }
}

__device__ __forceinline__ void gla_simple(Frame& F, const bf16* proj, bf16* odir) {
    LAS float* red = (LAS float*)F.lds;
    const int sub = F.tid >> 7, c = F.tid & 127, wsub = (F.tid >> 6) & 1;
    for (int ug = F.vcu; ug < 256; ug += F.G) {
        const int unit = ug * 4 + sub, chain = unit >> 4, cg = unit & 15;
        const int dir = chain & 1, h = (chain >> 1) & 3, b = chain >> 3;
        const size_t rowb = (size_t)b * SEQ;
        float S[8];
#pragma unroll
        for (int j = 0; j < 8; ++j) S[j] = 0.f;
        for (int t0 = 0; t0 < SEQ; t0 += 8) {
            float pr[64];
#pragma unroll
            for (int tt = 0; tt < 8; ++tt) {
                const int t = t0 + tt, pos = dir ? (SEQ - 1 - t) : t;
                const bf16* rp = proj + (rowb + pos) * INC;
                const float g = bf1(rp[2048 + 512 * dir + h * 128 + c]);
                const float qv = bf1(rp[1536 + h * 128 + c]);
                const v4u vw = *(const v4u*)(rp + 3072 + h * 128 + cg * 8);
                const float f = __expf(g), kk = 1.0f - f;
                const float vv[8] = {bflo(vw.x), bfhi(vw.x), bflo(vw.y), bfhi(vw.y), bflo(vw.z), bfhi(vw.z), bflo(vw.w), bfhi(vw.w)};
#pragma unroll
                for (int j = 0; j < 8; ++j) { S[j] = f * S[j] + kk * vv[j]; pr[tt * 8 + j] = qv * S[j]; }
            }
#pragma unroll
            for (int step = 0; step < 6; ++step) {
                const int off = 32 >> step, half = 32 >> step;
                const bool up = (F.lane & off) != 0;
#pragma unroll
                for (int i = 0; i < half; ++i) {
                    const float keep = up ? pr[i + half] : pr[i], send = up ? pr[i] : pr[i + half];
                    pr[i] = keep + __shfl_xor(send, off);
                }
            }
            __syncthreads();
            if (wsub == 1) red[sub * 64 + F.lane] = pr[0];
            __syncthreads();
            if (wsub == 0) {
                const float tot = pr[0] + red[sub * 64 + F.lane];
                const int t = t0 + (F.lane >> 3), j = F.lane & 7, pos = dir ? (SEQ - 1 - t) : t;
                odir[((size_t)dir * MT + rowb + pos) * 512 + h * 128 + cg * 8 + j] = (bf16)f2bf(tot);
            }
        }
    }
}

__device__ __forceinline__ void combine_phase(Frame& F, const bf16* proj, const bf16* atto, const bf16* odir, const float* again, const float* rgain, bf16* abuf) {
    const int gw = F.vcu * NWAVES + F.wave, NGW = F.G * NWAVES;
    for (int m = gw; m < MT; m += NGW) {
        const int c0 = 8 * F.lane;
        { const v4u w = *(const v4u*)(atto + (size_t)m * 512 + c0);
          float v[8] = {bflo(w.x), bfhi(w.x), bflo(w.y), bfhi(w.y), bflo(w.z), bfhi(w.z), bflo(w.w), bfhi(w.w)};
          float ss = 0.f;
#pragma unroll
          for (int j = 0; j < 8; ++j) ss += v[j] * v[j];
          const float r = 1.0f / sqrtf(wave_sum(ss) * (1.0f / 512.0f) + RMS_EPS);
          const f32x4 g0 = *(const f32x4*)(again + c0), g1 = *(const f32x4*)(again + c0 + 4);
          v4u o; o.x = pk2(v[0] * r * g0[0], v[1] * r * g0[1]); o.y = pk2(v[2] * r * g0[2], v[3] * r * g0[3]); o.z = pk2(v[4] * r * g1[0], v[5] * r * g1[1]); o.w = pk2(v[6] * r * g1[2], v[7] * r * g1[3]);
          *(v4u*)(abuf + (size_t)m * DM + c0) = o; }
        { const v4u wf = *(const v4u*)(odir + (size_t)m * 512 + c0), wb = *(const v4u*)(odir + ((size_t)MT + m) * 512 + c0);
          const v4u wg = *(const v4u*)(proj + (size_t)m * INC + 3584 + c0);
          float v[8] = {bflo(wf.x) + bflo(wb.x), bfhi(wf.x) + bfhi(wb.x), bflo(wf.y) + bflo(wb.y), bfhi(wf.y) + bfhi(wb.y), bflo(wf.z) + bflo(wb.z), bfhi(wf.z) + bfhi(wb.z), bflo(wf.w) + bflo(wb.w), bfhi(wf.w) + bfhi(wb.w)};
          const float sg[8] = {bflo(wg.x), bfhi(wg.x), bflo(wg.y), bfhi(wg.y), bflo(wg.z), bfhi(wg.z), bflo(wg.w), bfhi(wg.w)};
          float ss = 0.f;
#pragma unroll
          for (int j = 0; j < 8; ++j) ss += v[j] * v[j];
          ss += __shfl_xor(ss, 1); ss += __shfl_xor(ss, 2); ss += __shfl_xor(ss, 4); ss += __shfl_xor(ss, 8);
          const float r = 1.0f / sqrtf(ss * (1.0f / 128.0f) + RMS_EPS);
          const f32x4 g0 = *(const f32x4*)(rgain + c0), g1 = *(const f32x4*)(rgain + c0 + 4);
          v4u o; o.x = pk2(v[0] * r * g0[0] * sg[0], v[1] * r * g0[1] * sg[1]); o.y = pk2(v[2] * r * g0[2] * sg[2], v[3] * r * g0[3] * sg[3]);
          o.z = pk2(v[4] * r * g1[0] * sg[4], v[5] * r * g1[1] * sg[5]); o.w = pk2(v[6] * r * g1[2] * sg[6], v[7] * r * g1[3] * sg[7]);
          *(v4u*)(abuf + (size_t)m * DM + 512 + c0) = o; }
    }
}

template <int MODE>
__device__ __forceinline__ void ln_phase(Frame& F, float* xs, const float* lng, const float* lnb, const float* adan  , bf16* abuf,
                                         const float* wrt  , unsigned* route) {
    const int gw = F.vcu * NWAVES + F.wave, NGW = F.G * NWAVES;
    for (int m = gw; m < MT; m += NGW) {
        f32x4* xr = (f32x4*)(xs + (size_t)m * DM) + F.lane;
        f32x4 v[4]; float s = 0.f;
#pragma unroll
        for (int j = 0; j < 4; ++j) { v[j] = xr[64 * j]; s += (v[j][0] + v[j][1]) + (v[j][2] + v[j][3]); }
        const float mean = wave_sum(s) * (1.0f / DM); float s2 = 0.f;
#pragma unroll
        for (int j = 0; j < 4; ++j) { v[j] = v[j] - mean; s2 += (v[j][0] * v[j][0] + v[j][1] * v[j][1]) + (v[j][2] * v[j][2] + v[j][3] * v[j][3]); }
        const float rstd = 1.0f / sqrtf(wave_sum(s2) * (1.0f / DM) + LN_EPS);
        const int b = m >> 11; const float* ar = adan + (size_t)b * 3072;
        float lg[8];
#pragma unroll
        for (int e = 0; e < 8; ++e) lg[e] = 0.f;
#pragma unroll
        for (int j = 0; j < 4; ++j) {
            const int col = 4 * F.lane + 256 * j;
            const f32x4 xn = v[j] * rstd * *(const f32x4*)(lng + col) + *(const f32x4*)(lnb + col);
            xr[64 * j] = xn;
            const f32x4 u = xn * (*(const f32x4*)(ar + 1024 + col) + 1.0f) + *(const f32x4*)(ar + col);
            if (MODE == 0) ((unsigned long long*)(abuf + (size_t)m * DM) + F.lane)[64 * j] = (unsigned long long)pk2(u[0], u[1]) | ((unsigned long long)pk2(u[2], u[3]) << 32);
            if (MODE == 1) {
#pragma unroll
                for (int i = 0; i < 4; ++i) { const f32x4 w0 = *(const f32x4*)(wrt + (size_t)(col + i) * 8), w1 = *(const f32x4*)(wrt + (size_t)(col + i) * 8 + 4);
                    lg[0] += u[i] * w0[0]; lg[1] += u[i] * w0[1]; lg[2] += u[i] * w0[2]; lg[3] += u[i] * w0[3]; lg[4] += u[i] * w1[0]; lg[5] += u[i] * w1[1]; lg[6] += u[i] * w1[2]; lg[7] += u[i] * w1[3]; }
            }
        }
        if (MODE == 1) {
#pragma unroll
            for (int e = 0; e < 8; ++e) lg[e] = wave_sum(lg[e]);
            int e1 = 0; float l1 = lg[0];
#pragma unroll
            for (int e = 1; e < 8; ++e) if (lg[e] > l1) { l1 = lg[e]; e1 = e; }
            int e2 = -1; float l2 = -3.0e38f;
#pragma unroll
            for (int e = 0; e < 8; ++e) if (e != e1 && lg[e] > l2) { l2 = lg[e]; e2 = e; }
            if (F.lane == 0) {
                const float w1 = 1.0f / (1.0f + __expf(l2 - l1)), w2 = 1.0f - w1;
                const unsigned p1 = __hip_atomic_fetch_add((unsigned*)(F.ctl + CW_CNT + 64 * e1), 1u, RLX_AGENT);
                const unsigned p2 = __hip_atomic_fetch_add((unsigned*)(F.ctl + CW_CNT + 64 * e2), 1u, RLX_AGENT);
                unsigned* rt = route + (size_t)m * 8;
                rt[0] = (unsigned)e1; rt[1] = p1; rt[2] = __float_as_uint(w1); rt[3] = (unsigned)e2; rt[4] = p2; rt[5] = __float_as_uint(w2);
            }
        }
    }
}

struct MoeOff { int off[9]; int cnt[8]; };
__device__ __forceinline__ void moe_offsets(Frame& F, int (&off)[9], int (&cnt)[8]) {
    off[0] = 0;
#pragma unroll
    for (int e = 0; e < 8; ++e) { cnt[e] = (int)__hip_atomic_load((unsigned*)(F.ctl + CW_CNT + 64 * e), RLX_AGENT); off[e + 1] = off[e] + ((cnt[e] + 255) & ~255); }
}

__device__ __forceinline__ void gather_phase(Frame& F, const float* xs, const float* adan, const unsigned* route, bf16* gath, unsigned* rowinfo) {
    int off[9], cnt[8]; moe_offsets(F, off, cnt);
    const int gw = F.vcu * NWAVES + F.wave, NGW = F.G * NWAVES;
    for (int m = gw; m < MT; m += NGW) {
        const unsigned* rt = route + (size_t)m * 8;
        const int e1 = (int)rt[0], p1 = (int)rt[1], e2 = (int)rt[3], p2 = (int)rt[4]; const unsigned w1 = rt[2], w2 = rt[5];
        int o1 = 0, o2 = 0;
#pragma unroll
        for (int e = 0; e < 8; ++e) { o1 = (e1 == e) ? off[e] : o1; o2 = (e2 == e) ? off[e] : o2; }
        const int r1 = o1 + p1, r2 = o2 + p2;
        const int b = m >> 11; const float* ar = adan + (size_t)b * 3072;
        const f32x4* xr = (const f32x4*)(xs + (size_t)m * DM) + F.lane;
        unsigned long long* d1 = (unsigned long long*)(gath + (size_t)r1 * DM) + F.lane; unsigned long long* d2 = (unsigned long long*)(gath + (size_t)r2 * DM) + F.lane;
#pragma unroll
        for (int j = 0; j < 4; ++j) {
            const int col = 4 * F.lane + 256 * j;
            const f32x4 u = xr[64 * j] * (*(const f32x4*)(ar + 1024 + col) + 1.0f) + *(const f32x4*)(ar + col);
            const unsigned long long w = (unsigned long long)pk2(u[0], u[1]) | ((unsigned long long)pk2(u[2], u[3]) << 32);
            d1[64 * j] = w; d2[64 * j] = w;
        }
        if (F.lane == 0) { rowinfo[2 * (size_t)r1] = (unsigned)m; rowinfo[2 * (size_t)r1 + 1] = w1; rowinfo[2 * (size_t)r2] = (unsigned)m | (1u << 16); rowinfo[2 * (size_t)r2 + 1] = w2; }
    }
    for (int it = gw; it < 8 * 256; it += NGW) {
        const int e = it >> 8, i = it & 255; int oe = 0, ce = 0;
#pragma unroll
        for (int k = 0; k < 8; ++k) { oe = (e == k) ? off[k] : oe; ce = (e == k) ? cnt[k] : ce; }
        const int npad = ((ce + 255) & ~255) - ce;
        if (i < npad) { const int row = oe + ce + i;
            v4u* d = (v4u*)(gath + (size_t)row * DM) + F.lane; d[0] = (v4u){0u, 0u, 0u, 0u}; d[64] = (v4u){0u, 0u, 0u, 0u};
            if (F.lane == 0) { rowinfo[2 * (size_t)row] = 0xffffffffu; rowinfo[2 * (size_t)row + 1] = 0u; } }
    }
}

__device__ __forceinline__ void final_phase(Frame& F, float* xs, const bf16* yslot, const float* adar  , const float* lng, const float* lnb) {
    const int gw = F.vcu * NWAVES + F.wave, NGW = F.G * NWAVES;
    for (int m = gw; m < MT; m += NGW) {
        f32x4* xr = (f32x4*)(xs + (size_t)m * DM) + F.lane;
        const v2u* y0 = (const v2u*)(yslot + (size_t)m * DM) + F.lane; const v2u* y1 = (const v2u*)(yslot + ((size_t)MT + m) * DM) + F.lane;
        const int b = m >> 11; const float* ar = adar + (size_t)b * 3072 + 2048;
        f32x4 v[4]; float s = 0.f;
#pragma unroll
        for (int j = 0; j < 4; ++j) {
            const int col = 4 * F.lane + 256 * j;
            const v2u a = y0[64 * j], c = y1[64 * j];
            const f32x4 y = (f32x4){bflo(a.x) + bflo(c.x), bfhi(a.x) + bfhi(c.x), bflo(a.y) + bflo(c.y), bfhi(a.y) + bfhi(c.y)};
            v[j] = xr[64 * j] * DN_ALPHA + (*(const f32x4*)(ar + col) + 1.0f) * y;
            s += (v[j][0] + v[j][1]) + (v[j][2] + v[j][3]);
        }
        const float mean = wave_sum(s) * (1.0f / DM); float s2 = 0.f;
#pragma unroll
        for (int j = 0; j < 4; ++j) { v[j] = v[j] - mean; s2 += (v[j][0] * v[j][0] + v[j][1] * v[j][1]) + (v[j][2] * v[j][2] + v[j][3] * v[j][3]); }
        const float rstd = 1.0f / sqrtf(wave_sum(s2) * (1.0f / DM) + LN_EPS);
#pragma unroll
        for (int j = 0; j < 4; ++j) { const int col = 4 * F.lane + 256 * j; xr[64 * j] = v[j] * rstd * *(const f32x4*)(lng + col) + *(const f32x4*)(lnb + col); }
    }
}

constexpr int NPH = 20;
#define IN(k) (lo <= (k) && (k) < hi)
#define SEAM(k) do { if (IN(k) && IN((k) + 1)) xcd_barrier(bar); } while (0)
template <int L>
__device__ __forceinline__ void layer_phases(Frame& F, const Args& args, const XcdBarrier& bar, const int lo, const int hi) {
    constexpr int pb = 2 + 9 * L;
    unsigned char* const ws = args.ws;
    float* const xs = args.out;
    if (IN(pb + 0)) {
        pg8::Gemm g{(const bf16*)(ws + WS_ABUF), (const bf16*)(ws + WS_WIN) + (size_t)L * INC * DM, MT, INC, DM}; pg8::StaticOrder S; S.init(MT, INC, F.G, (int)blockIdx.x);
        pg8::EpiIn E{(bf16*)(ws + WS_PROJ), (const float*)(ws + WS_ROPE), (const float*)(ws + WS_LB) + (size_t)L * 1024};
        pg8::gemm_phase<pg8::EpiIn, pg8::StaticOrder, PG8_ALIGN, PG8_SP2>(F.lds, g, S, E);
        SEAM(pb + 0);
    }
    if (IN(pb + 1)) { attn_simple(F, (const bf16*)(ws + WS_PROJ), (bf16*)(ws + WS_ATTO)); gla_simple(F, (const bf16*)(ws + WS_PROJ), (bf16*)(ws + WS_ODIR)); SEAM(pb + 1); }
    if (IN(pb + 2)) { combine_phase(F, (const bf16*)(ws + WS_PROJ), (const bf16*)(ws + WS_ATTO), (const bf16*)(ws + WS_ODIR), (const float*)args.in[5] + (size_t)L * 512, (const float*)args.in[6] + (size_t)L * 512, (bf16*)(ws + WS_ABUF)); SEAM(pb + 2); }
    if (IN(pb + 3)) {
        pg8::Gemm g{(const bf16*)(ws + WS_ABUF), (const bf16*)(ws + WS_WOUT) + (size_t)L * DM * DM, MT, DM, DM}; pg8::StaticOrder S; S.init(MT, DM, F.G, (int)blockIdx.x);
        pg8::EpiRes E{L == 0 ? (const float*)args.in[0] : (const float*)xs, xs, (const float*)(ws + WS_ADA) + (size_t)(L * 2 + 0) * 8 * 3072, DN_ALPHA};
        pg8::gemm_phase<pg8::EpiRes, pg8::StaticOrder, PG8_ALIGN, PG8_SP2>(F.lds, g, S, E);
        SEAM(pb + 3);
    }
    const float* const ada1 = (const float*)(ws + WS_ADA) + (size_t)(L * 2 + 1) * 8 * 3072;
    const float* const lng = (const float*)args.in[10] + (size_t)L * 2 * DM; const float* const lnb = (const float*)args.in[11] + (size_t)L * 2 * DM;
    if constexpr (L == 0) {
        if (IN(pb + 4)) { ln_phase<0>(F, xs, lng, lnb, ada1, (bf16*)(ws + WS_ABUF), nullptr, nullptr); if (IN(pb + 6)) xcd_barrier(bar); }
        if (IN(pb + 6)) {
            pg8::Gemm g{(const bf16*)(ws + WS_ABUF), (const bf16*)(ws + WS_WGU), MT, 2 * FFDP, DM}; pg8::StaticOrder S; S.init(MT, 2 * FFDP, F.G, (int)blockIdx.x);
            pg8::EpiGU<FFDP, 22> E{(bf16*)(ws + WS_HID)};
            pg8::gemm_phase<pg8::EpiGU<FFDP, 22>, pg8::StaticOrder, PG8_ALIGN, PG8_SP2>(F.lds, g, S, E);
            SEAM(pb + 6);
        }
        if (IN(pb + 7)) {
            pg8::Gemm g{(const bf16*)(ws + WS_HID), (const bf16*)(ws + WS_WDN), MT, DM, FFDP}; pg8::StaticOrder S; S.init(MT, DM, F.G, (int)blockIdx.x);
            pg8::EpiRes E{(const float*)xs, xs, ada1, DN_ALPHA};
            pg8::gemm_phase<pg8::EpiRes, pg8::StaticOrder, PG8_ALIGN, PG8_SP2>(F.lds, g, S, E);
            SEAM(pb + 7);
        }
        if (IN(pb + 8)) { ln_phase<0>(F, xs, lng + DM, lnb + DM, (const float*)(ws + WS_ADA) + (size_t)2 * 8 * 3072, (bf16*)(ws + WS_ABUF), nullptr, nullptr); SEAM(pb + 8); }
    } else {
        unsigned* const route = (unsigned*)(ws + WS_ROUTE); unsigned* const rowinfo = (unsigned*)(ws + WS_ROWINFO);
        if (IN(pb + 4)) { ln_phase<1>(F, xs, lng, lnb, ada1, nullptr, (const float*)args.in[15], route); SEAM(pb + 4); }
        if (IN(pb + 5)) { gather_phase(F, xs, ada1, route, (bf16*)(ws + WS_GATH), rowinfo); SEAM(pb + 5); }
        if (IN(pb + 6)) {
            int off[9], cnt[8]; moe_offsets(F, off, cnt);
            const int nT = off[8] >> 8;
            pg8::Gemm g{(const bf16*)(ws + WS_GATH), (const bf16*)(ws + WS_WMGU), nT * 256, 2 * FFE, DM};
            pg8::MoeOrder S; S.init(nT * 256, 2 * FFE, F.G, (int)blockIdx.x);
            S.ts1 = off[1] >> 8; S.ts2 = off[2] >> 8; S.ts3 = off[3] >> 8; S.ts4 = off[4] >> 8; S.ts5 = off[5] >> 8; S.ts6 = off[6] >> 8; S.ts7 = off[7] >> 8; S.nNloc = 28;
            pg8::EpiGU<FFE, 28> E{(bf16*)(ws + WS_HID)};
            pg8::gemm_phase<pg8::EpiGU<FFE, 28>, pg8::MoeOrder, PG8_ALIGN, PG8_SP2>(F.lds, g, S, E);
            SEAM(pb + 6);
        }
        if (IN(pb + 7)) {
            int off[9], cnt[8]; moe_offsets(F, off, cnt);
            const int nT = off[8] >> 8;
            pg8::Gemm g{(const bf16*)(ws + WS_HID), (const bf16*)(ws + WS_WMDN), nT * 256, DM, FFE};
            pg8::MoeOrder S; S.init(nT * 256, DM, F.G, (int)blockIdx.x);
            S.ts1 = off[1] >> 8; S.ts2 = off[2] >> 8; S.ts3 = off[3] >> 8; S.ts4 = off[4] >> 8; S.ts5 = off[5] >> 8; S.ts6 = off[6] >> 8; S.ts7 = off[7] >> 8; S.nNloc = 4;
            pg8::EpiMoeDn E{rowinfo, (bf16*)(ws + WS_YSLOT)};
            pg8::gemm_phase<pg8::EpiMoeDn, pg8::MoeOrder, PG8_ALIGN, PG8_SP2>(F.lds, g, S, E);
            SEAM(pb + 7);
        }
        if (IN(pb + 8)) { final_phase(F, xs, (const bf16*)(ws + WS_YSLOT), ada1, lng + DM, lnb + DM); }
    }
}

__global__ void __launch_bounds__(NWAVES * 64, 2) fwd_kernel(Args args) {
    extern __shared__ __attribute__((aligned(16))) unsigned char lds[];
    Frame F;
    F.lds = (LAS unsigned char*)lds; F.ws = args.ws; F.ctl = (gu32*)(args.ws + WS_CTL);
    F.tid = threadIdx.x; F.lane = F.tid & 63; F.wave = __builtin_amdgcn_readfirstlane(F.tid >> 6);
    F.G = gridDim.x; { const int bx = blockIdx.x; F.vcu = (F.G % 8 == 0) ? (bx % 8) * (F.G / 8) + bx / 8 : bx; }
    volatile LAS unsigned* MISC = (volatile LAS unsigned*)(F.lds + MISC_OFF);
    for (int u = F.tid; u < (LDS_BYTES - 131072) / 4; u += NWAVES * 64) ((LAS unsigned*)(F.lds + 131072))[u] = 0u;
    __syncthreads();
    XcdBarrier bar; bar.bar = (unsigned*)(F.ctl + CW_BAR); bar.x = 0; bar.st = nullptr;
    const int lo = args.ph_lo, hi = args.ph_hi;
    if (hi - lo > 1) bar = xcd_barrier_post((unsigned*)(F.ctl + CW_BAR), MISC + 8);
    if (IN(0)) { p0_prologue(F, args); SEAM(0); }
    if (IN(1)) { p1_mod0(F, (const float*)args.in[0], (const float*)(args.ws + WS_ADA), (bf16*)(args.ws + WS_ABUF)); SEAM(1); }
    layer_phases<0>(F, args, bar, lo, hi);
    layer_phases<1>(F, args, bar, lo, hi);
}
#undef IN
#undef SEAM

extern "C" void kernel_launch(void* const* d_in, const int* in_sizes, int n_in, void* d_out, int out_size, void* d_ws, size_t ws_size, hipStream_t stream) {
    static int grid = 0;
    if (grid == 0) {
        int dev = 0, cus = 0, per_cu = 0;
        if (n_in != 19 || ws_size < WS_END) { fprintf(stderr, "kernel_launch: unexpected n_in %d / ws_size %zu\n", n_in, ws_size); }
        if (hipGetDevice(&dev) != hipSuccess || hipDeviceGetAttribute(&cus, hipDeviceAttributeMultiprocessorCount, dev) != hipSuccess) { grid = -1; return; }
        if (hipFuncSetAttribute((const void*)fwd_kernel, hipFuncAttributeMaxDynamicSharedMemorySize, LDS_BYTES) != hipSuccess) { grid = -1; return; }
        if (hipOccupancyMaxActiveBlocksPerMultiprocessor(&per_cu, (const void*)fwd_kernel, NWAVES * 64, LDS_BYTES) != hipSuccess || per_cu < 1) fprintf(stderr, "kernel_launch: occupancy query says %d\n", per_cu);
        (void)hipGetLastError();
        grid = cus;
    }
    if (grid < 0) return;
    (void)hipMemsetAsync((char*)d_ws + WS_CTL, 0, CTL_ZERO_BYTES, stream);
    Args a{};
    for (int i = 0; i < 19; ++i) a.in[i] = d_in[i];
    a.out = (float*)d_out; a.ws = (unsigned char*)d_ws;
#if MK_N_LAUNCHES == 1
    a.ph_lo = 0; a.ph_hi = NPH;
    hipLaunchKernelGGL(fwd_kernel, dim3(grid), dim3(NWAVES * 64), LDS_BYTES, stream, a);
#else
    for (int p = 0; p < NPH; ++p) {
        if (p == 2 + 5) continue;
        a.ph_lo = p; a.ph_hi = p + 1;
        hipLaunchKernelGGL(fwd_kernel, dim3(grid), dim3(NWAVES * 64), LDS_BYTES, stream, a);
    }
#endif
}
```

```cpp
#include <hip/hip_runtime.h>
#include <cstdio>
#include <cstdint>
#include <cmath>
#define MK_N_LAUNCHES 1
namespace pg8 {
#define PG8_LAS __attribute__((address_space(3)))
typedef unsigned short bf16_t;
typedef short bf16x8 __attribute__((ext_vector_type(8)));
typedef float f32x4 __attribute__((ext_vector_type(4)));
typedef unsigned u32x4 __attribute__((ext_vector_type(4)));
constexpr int BM = 256, BK = 64, HALF = 128, HTB = HALF * BK * 2  , STAGE_BYTES = 8 * HTB, NXCD = 8, WGM = 8;

__host__ __device__ __forceinline__ int lds_byte(int r, int c) { const int st = (r >> 4) * 2 + (c >> 5), rr = r & 15, cc = c & 31, ob = rr * 64 + cc * 2; return st * 1024 + (ob ^ (((ob >> 9) & 1) << 5)); }
__host__ __device__ __forceinline__ void stage_rc(int b, int& R, int& C) { const int st = b / 1024, sb = b % 1024, swz = sb ^ (((sb >> 9) & 1) << 5); R = (st >> 1) * 16 + swz / 64; C = (st & 1) * 32 + (swz % 64) / 2; }
__host__ __device__ __forceinline__ int perm32(int rho) { const int n = rho >> 4, i = rho & 15; return 8 * (i >> 2) + 4 * n + (i & 3); }

struct Unit { int pm, pn; };
struct Gemm { const bf16_t* A; const bf16_t* Bt; int M, N, K; };

struct StaticOrder {
    int nM, nN, nwg, G, c;
    __host__ __device__ void init(int M, int N, int G_, int c_) { nM = M / BM; nN = N / BM; nwg = nM * nN; G = G_; c = c_; }
    __host__ __device__ bool next(int i, Unit& u) const {
        const long L = (long)i * G + c; if (L >= nwg) return false;
        int wgid = (int)L; { const int q = nwg / NXCD, r = nwg % NXCD, xcd = wgid % NXCD, off = wgid / NXCD; wgid = (xcd < r ? xcd * (q + 1) : r * (q + 1) + (xcd - r) * q) + off; }
        const int nig = WGM * nN, gid = wgid / nig, fm = gid * WGM, gsz = (nM - fm) < WGM ? (nM - fm) : WGM;
        u.pm = fm + ((wgid % nig) % gsz); u.pn = (wgid % nig) / gsz; return true;
    }
    __device__ __forceinline__ void a_ready(const Unit&) const {}
    __device__ __forceinline__ void done(const Unit&) const {}
};
__device__ __forceinline__ unsigned cvt_pk_bf16(float lo, float hi) { unsigned r; asm volatile("v_cvt_pk_bf16_f32 %0, %1, %2" : "=v"(r) : "v"(lo), "v"(hi)); return r; }

typedef float f32x2 __attribute__((ext_vector_type(2)));
typedef unsigned u32x2 __attribute__((ext_vector_type(2)));
__device__ __forceinline__ float fast_sigmoid(float x) { return __builtin_amdgcn_rcpf(1.0f + __expf(-x)); }
__device__ __forceinline__ float fast_silu(float x) { return x * fast_sigmoid(x); }

struct EpiIn {
    static constexpr bool PERM = false, AFTER_DRAIN = false;
    bf16_t* proj; const float* rope; const float* lb;
    __device__ __forceinline__ void operator()(const f32x4 (&acc)[2][2][4][2], const Unit& u, int wr, int wc, int fr, int fq) const {
        const int row0 = u.pm * BM + wr * 64 + fr;
        const int type = u.pn >> 1;
        if (type < 2) {
            const float sc = (type == 0) ? 0.125f : 1.0f;
            const int g = wc & 1;
#pragma unroll
            for (int ai = 0; ai < 2; ++ai)
#pragma unroll
                for (int m = 0; m < 4; ++m) {
                    const int row = row0 + ai * HALF + m * 16;
                    const f32x4* rp = (const f32x4*)(rope + ((size_t)row * 32 + 16 * g + 4 * fq) * 2);
                    const f32x4 cs0 = rp[0], cs1 = rp[1];
                    const float cc[4] = {cs0[0], cs0[2], cs1[0], cs1[2]}, ss[4] = {cs0[1], cs0[3], cs1[1], cs1[3]};
#pragma unroll
                    for (int bj = 0; bj < 2; ++bj) {
                        const int col = u.pn * BM + (2 * bj + (wc >> 1)) * 64 + 16 * g + 4 * fq;
                        const f32x4 x1 = acc[ai][bj][m][0], x2 = acc[ai][bj][m][1];
                        float o1[4], o2[4];
#pragma unroll
                        for (int j = 0; j < 4; ++j) { o1[j] = (x1[j] * cc[j] - x2[j] * ss[j]) * sc; o2[j] = (x2[j] * cc[j] + x1[j] * ss[j]) * sc; }
                        u32x2 w1, w2; w1.x = cvt_pk_bf16(o1[0], o1[1]); w1.y = cvt_pk_bf16(o1[2], o1[3]); w2.x = cvt_pk_bf16(o2[0], o2[1]); w2.y = cvt_pk_bf16(o2[2], o2[3]);
                        bf16_t* dst = proj + (size_t)row * 4096 + col;
                        *(u32x2*)dst = w1; *(u32x2*)(dst + 32) = w2;
                    }
                }
        } else {
            const int lc0 = u.pn * BM + wc * 32 + 8 * fq;
            f32x4 lbv[2][2];
            if (type == 4 || type == 5) {
#pragma unroll
                for (int bj = 0; bj < 2; ++bj)
#pragma unroll
                    for (int n = 0; n < 2; ++n) lbv[bj][n] = *(const f32x4*)(lb + (lc0 + bj * HALF - 2048) + 4 * n);
            }
#pragma unroll
            for (int ai = 0; ai < 2; ++ai)
#pragma unroll
                for (int m = 0; m < 4; ++m) {
                    const int row = row0 + ai * HALF + m * 16;
#pragma unroll
                    for (int bj = 0; bj < 2; ++bj) {
                        f32x4 v0 = acc[ai][bj][m][0], v1 = acc[ai][bj][m][1];
                        if (type == 3) {
#pragma unroll
                            for (int j = 0; j < 4; ++j) { v0[j] = fast_silu(v0[j]); v1[j] = fast_silu(v1[j]); }
                        } else if (type == 7) {
#pragma unroll
                            for (int j = 0; j < 4; ++j) { v0[j] = fast_sigmoid(v0[j]); v1[j] = fast_sigmoid(v1[j]); }
                        } else if (type == 4 || type == 5) {
#pragma unroll
                            for (int j = 0; j < 4; ++j) {
                                const float l0 = lbv[bj][0][j], l1 = lbv[bj][1][j];
                                v0[j] = __logf(l0 + (1.0f - l0) * fast_sigmoid(v0[j]));
                                v1[j] = __logf(l1 + (1.0f - l1) * fast_sigmoid(v1[j]));
                            }
                        }
                        u32x4 w; w.x = cvt_pk_bf16(v0[0], v0[1]); w.y = cvt_pk_bf16(v0[2], v0[3]); w.z = cvt_pk_bf16(v1[0], v1[1]); w.w = cvt_pk_bf16(v1[2], v1[3]);
                        *(u32x4*)(proj + (size_t)row * 4096 + lc0 + bj * HALF) = w;
                    }
                }
        }
    }
};

struct EpiRes {
    static constexpr bool PERM = false, AFTER_DRAIN = false;
    const float* xres; float* t; const float* gate; float alpha;
    __device__ __forceinline__ void operator()(const f32x4 (&acc)[2][2][4][2], const Unit& u, int wr, int wc, int fr, int fq) const {
        const int row0 = u.pm * BM + wr * 64 + fr, col0 = u.pn * BM + wc * 32 + 4 * fq;
        const int b = u.pm >> 3;
        f32x4 gv[2][2];
#pragma unroll
        for (int bj = 0; bj < 2; ++bj)
#pragma unroll
            for (int n = 0; n < 2; ++n) gv[bj][n] = *(const f32x4*)(gate + (size_t)b * 3072 + 2048 + col0 + bj * HALF + n * 16) + 1.0f;
#pragma unroll
        for (int ai = 0; ai < 2; ++ai)
#pragma unroll
            for (int m = 0; m < 4; ++m) {
                const size_t off = (size_t)(row0 + ai * HALF + m * 16) * 1024 + col0;
#pragma unroll
                for (int bj = 0; bj < 2; ++bj)
#pragma unroll
                    for (int n = 0; n < 2; ++n) {
                        const f32x4 xr = *(const f32x4*)(xres + off + bj * HALF + n * 16);
                        *(f32x4*)(t + off + bj * HALF + n * 16) = xr * alpha + gv[bj][n] * acc[ai][bj][m][n];
                    }
            }
    }
};

template <int ldh, int nNloc> struct EpiGU {
    static constexpr bool PERM = false, AFTER_DRAIN = false;
    bf16_t* hid;
    __device__ __forceinline__ void operator()(const f32x4 (&acc)[2][2][4][2], const Unit& u, int wr, int wc, int fr, int fq) const {
        const int row0 = u.pm * BM + wr * 64 + fr, col0 = (u.pn % nNloc) * HALF + wc * 32 + 8 * fq;
#pragma unroll
        for (int ai = 0; ai < 2; ++ai)
#pragma unroll
            for (int m = 0; m < 4; ++m) {
                const f32x4 g0 = acc[ai][0][m][0], g1 = acc[ai][0][m][1], u0 = acc[ai][1][m][0], u1 = acc[ai][1][m][1];
                f32x4 h0, h1;
#pragma unroll
                for (int j = 0; j < 4; ++j) { h0[j] = fast_silu(g0[j]) * u0[j]; h1[j] = fast_silu(g1[j]) * u1[j]; }
                u32x4 w; w.x = cvt_pk_bf16(h0[0], h0[1]); w.y = cvt_pk_bf16(h0[2], h0[3]); w.z = cvt_pk_bf16(h1[0], h1[1]); w.w = cvt_pk_bf16(h1[2], h1[3]);
                *(u32x4*)(hid + (size_t)(row0 + ai * HALF + m * 16) * ldh + col0) = w;
            }
    }
};

struct EpiMoeDn {
    static constexpr bool PERM = false, AFTER_DRAIN = false;
    const unsigned* rowinfo; bf16_t* yslot;
    __device__ __forceinline__ void operator()(const f32x4 (&acc)[2][2][4][2], const Unit& u, int wr, int wc, int fr, int fq) const {
        const int row0 = u.pm * BM + wr * 64 + fr, col0 = (u.pn & 3) * BM + wc * 32 + 4 * fq;
#pragma unroll
        for (int ai = 0; ai < 2; ++ai)
#pragma unroll
            for (int m = 0; m < 4; ++m) {
                const int row = row0 + ai * HALF + m * 16;
                const u32x2 inf = *(const u32x2*)(rowinfo + 2 * (size_t)row);
                if (inf.x != 0xffffffffu) {
                    const float w = __uint_as_float(inf.y);
                    bf16_t* dst = yslot + ((size_t)(inf.x >> 16) * 16384 + (inf.x & 0xffffu)) * 1024 + col0;
#pragma unroll
                    for (int bj = 0; bj < 2; ++bj)
#pragma unroll
                        for (int n = 0; n < 2; ++n) {
                            const f32x4 v = acc[ai][bj][m][n] * w;
                            u32x2 o; o.x = cvt_pk_bf16(v[0], v[1]); o.y = cvt_pk_bf16(v[2], v[3]);
                            *(u32x2*)(dst + bj * HALF + n * 16) = o;
                        }
                }
            }
    }
};

struct MoeOrder : StaticOrder {
    int ts1, ts2, ts3, ts4, ts5, ts6, ts7, nNloc;
    __device__ __forceinline__ bool next(int i, Unit& u) const {
        if (!StaticOrder::next(i, u)) return false;
        const int e = (u.pm >= ts1) + (u.pm >= ts2) + (u.pm >= ts3) + (u.pm >= ts4) + (u.pm >= ts5) + (u.pm >= ts6) + (u.pm >= ts7);
        u.pn += e * nNloc; return true;
    }
};

template <class Epi, class Sched, bool ALIGN_EPI = false, bool SP2 = false>
__device__ __forceinline__ void gemm_phase(PG8_LAS unsigned char* lds, const Gemm g, const Sched& S, const Epi& E) {
    const int tid = threadIdx.x, wid = __builtin_amdgcn_readfirstlane(tid >> 6), lane = tid & 63, wr = wid >> 2, wc = wid & 3, fr = lane & 15, fq = lane >> 4;
    const int K = g.K, nt = K / BK;
    unsigned voffA[2], voffB[2];
#pragma unroll
    for (int i = 0; i < 2; ++i) { int R, C; stage_rc(tid * 16 + i * 8192, R, C); const int Rb = Epi::PERM ? ((R & ~31) + perm32(R & 31)) : R;
        voffA[i] = (unsigned)(R * K + C) * 2u; voffB[i] = (unsigned)(Rb * K + C) * 2u; }
    const size_t kstep = (size_t)(BK * 2);
    const size_t hstep = (size_t)HALF * K * 2;
    const size_t tstep = 2 * hstep;
    const unsigned ldsw = (unsigned)wid * 1024u;
    const int aoff = lds_byte(wr * 64 + fr, fq * 8), boff = lds_byte(wc * 32 + fr, fq * 8);
#define PG8_SA(b, h) (((b) * 2 + (h)) * HTB)
#define PG8_SB(b, h) ((4 + (b) * 2 + (h)) * HTB)
#define PG8_STAGE(bufoff, gbase, voff) do { _Pragma("unroll") for (int _i = 0; _i < 2; ++_i) \
        __builtin_amdgcn_global_load_lds((const unsigned*)((const char*)(gbase) + (voff)[_i]), (PG8_LAS unsigned*)(lds + (bufoff) + ldsw + _i * 8192), 16, 0, 0); } while (0)
#define PG8_LDA(dst, b, h) do { _Pragma("unroll") for (int m = 0; m < 4; ++m) _Pragma("unroll") for (int k = 0; k < 2; ++k) dst[m][k] = *(const PG8_LAS bf16x8*)(lds + PG8_SA(b, h) + aoff + m * 2048 + k * 1024); } while (0)
#define PG8_LDB(dst, b, h) do { _Pragma("unroll") for (int n = 0; n < 2; ++n) _Pragma("unroll") for (int k = 0; k < 2; ++k) dst[n][k] = *(const PG8_LAS bf16x8*)(lds + PG8_SB(b, h) + boff + n * 2048 + k * 1024); } while (0)
#define PG8_MMA(ai, bj, At, Bt) do { __builtin_amdgcn_s_setprio(1); _Pragma("unroll") for (int m = 0; m < 4; ++m) _Pragma("unroll") for (int n = 0; n < 2; ++n) _Pragma("unroll") for (int k = 0; k < 2; ++k) \
        acc[ai][bj][m][n] = __builtin_amdgcn_mfma_f32_16x16x32_bf16(Bt[n][k], At[m][k], acc[ai][bj][m][n], 0, 0, 0); __builtin_amdgcn_s_setprio(0); } while (0)
#define PG8_WAIT_V(n) asm volatile("s_waitcnt vmcnt(" #n ")" ::: "memory")
#define PG8_WAIT_L(n) asm volatile("s_waitcnt lgkmcnt(" #n ")" ::: "memory")
#define PG8_BAR __builtin_amdgcn_s_barrier()
#define PG8_SCHED __builtin_amdgcn_sched_barrier(0)
    Unit cur, nxt; int ui = 0;
    if (!S.next(0, cur)) return;
    f32x4 acc[2][2][4][2];
#pragma unroll
    for (int a = 0; a < 2; ++a)
#pragma unroll
        for (int b = 0; b < 2; ++b)
#pragma unroll
            for (int m = 0; m < 4; ++m)
#pragma unroll
                for (int n = 0; n < 2; ++n) acc[a][b][m][n] = (f32x4){0.f, 0.f, 0.f, 0.f};
    bf16x8 At[4][2], B0[2][2], B1[2][2];
    const char* cA = (const char*)g.A + (size_t)cur.pm * tstep; const char* cB = (const char*)g.Bt + (size_t)cur.pn * tstep;
    S.a_ready(cur);
    if constexpr (SP2) {
        PG8_STAGE(PG8_SB(0, 0), cB, voffB); PG8_STAGE(PG8_SB(0, 1), cB + hstep, voffB); PG8_STAGE(PG8_SA(0, 0), cA, voffA); PG8_STAGE(PG8_SA(0, 1), cA + hstep, voffA);
        if (wr == 1) PG8_BAR;
        PG8_WAIT_V(2); PG8_BAR;
        PG8_STAGE(PG8_SB(1, 0), cB + kstep, voffB); PG8_STAGE(PG8_SA(1, 0), cA + kstep, voffA); PG8_STAGE(PG8_SB(1, 1), cB + hstep + kstep, voffB);
        PG8_WAIT_V(6); PG8_BAR;
    } else {
        PG8_STAGE(PG8_SB(0, 0), cB, voffB); PG8_STAGE(PG8_SA(0, 0), cA, voffA); PG8_STAGE(PG8_SB(0, 1), cB + hstep, voffB); PG8_STAGE(PG8_SA(0, 1), cA + hstep, voffA);
        if (wr == 1) PG8_BAR;
        PG8_WAIT_V(4); PG8_BAR;
        PG8_STAGE(PG8_SB(1, 0), cB + kstep, voffB); PG8_STAGE(PG8_SA(1, 0), cA + kstep, voffA); PG8_STAGE(PG8_SB(1, 1), cB + hstep + kstep, voffB);
        PG8_WAIT_V(6); PG8_BAR;
    }
    for (;;) {
        const bool has_next = S.next(ui + 1, nxt);
        const char* nA = has_next ? (const char*)g.A + (size_t)nxt.pm * tstep : cA; const char* nB = has_next ? (const char*)g.Bt + (size_t)nxt.pn * tstep : cB;
        for (int t = 0; t < nt; t += 2) {
            const bool last = (t == nt - 2);
            const char* a1 = cA + (size_t)(t + 1) * kstep;
            const char* a2 = last ? nA : cA + (size_t)(t + 2) * kstep; const char* b2 = last ? nB : cB + (size_t)(t + 2) * kstep;
            const char* a3 = a2 + kstep; const char* b3 = b2 + kstep;
            if (last && has_next) S.a_ready(nxt);
            if constexpr (SP2) {
            PG8_LDB(B0, 0, 0); PG8_LDB(B1, 0, 1); PG8_SCHED; PG8_LDA(At, 0, 0); PG8_STAGE(PG8_SA(1, 1), a1 + hstep, voffA);
            PG8_WAIT_V(8); PG8_WAIT_L(0); PG8_BAR; PG8_MMA(0, 0, At, B0); PG8_MMA(0, 1, At, B1); PG8_BAR; PG8_SCHED;
            PG8_LDA(At, 0, 1); PG8_STAGE(PG8_SB(0, 0), b2, voffB); PG8_STAGE(PG8_SB(0, 1), b2 + hstep, voffB); PG8_STAGE(PG8_SA(0, 0), a2, voffA);
            PG8_WAIT_V(8); PG8_WAIT_L(0); PG8_BAR; PG8_MMA(1, 0, At, B0); PG8_MMA(1, 1, At, B1); PG8_BAR; PG8_SCHED;
            PG8_LDB(B0, 1, 0); PG8_LDB(B1, 1, 1); PG8_SCHED; PG8_LDA(At, 1, 0); PG8_STAGE(PG8_SA(0, 1), a2 + hstep, voffA);
            PG8_WAIT_V(8); PG8_WAIT_L(0); PG8_BAR; PG8_MMA(0, 0, At, B0); PG8_MMA(0, 1, At, B1); PG8_BAR; PG8_SCHED;
            PG8_LDA(At, 1, 1); PG8_STAGE(PG8_SB(1, 0), b3, voffB); PG8_STAGE(PG8_SB(1, 1), b3 + hstep, voffB); PG8_STAGE(PG8_SA(1, 0), a3, voffA);
            PG8_WAIT_V(8); PG8_WAIT_L(0); PG8_BAR; PG8_MMA(1, 0, At, B0); PG8_MMA(1, 1, At, B1); PG8_BAR; PG8_SCHED;
            } else {
            PG8_LDB(B0, 0, 0); PG8_SCHED; PG8_LDA(At, 0, 0); PG8_STAGE(PG8_SA(1, 1), a1 + hstep, voffA);
            PG8_WAIT_L(8); PG8_BAR; PG8_WAIT_L(0); PG8_MMA(0, 0, At, B0); PG8_BAR; PG8_SCHED;
            PG8_LDB(B1, 0, 1); PG8_STAGE(PG8_SB(0, 0), b2, voffB);
            PG8_BAR; PG8_WAIT_L(0); PG8_MMA(0, 1, At, B1); PG8_BAR;
            PG8_LDA(At, 0, 1); PG8_STAGE(PG8_SA(0, 0), a2, voffA);
            PG8_BAR; PG8_WAIT_L(0); PG8_MMA(1, 0, At, B0); PG8_BAR; PG8_SCHED;
            PG8_STAGE(PG8_SB(0, 1), b2 + hstep, voffB);
            PG8_WAIT_V(6); PG8_BAR; PG8_MMA(1, 1, At, B1); PG8_BAR;
            PG8_LDB(B0, 1, 0); PG8_SCHED; PG8_LDA(At, 1, 0); PG8_STAGE(PG8_SA(0, 1), a2 + hstep, voffA);
            PG8_WAIT_L(8); PG8_BAR; PG8_WAIT_L(0); PG8_MMA(0, 0, At, B0); PG8_BAR; PG8_SCHED;
            PG8_LDB(B1, 1, 1); PG8_STAGE(PG8_SB(1, 0), b3, voffB);
            PG8_BAR; PG8_WAIT_L(0); PG8_MMA(0, 1, At, B1); PG8_BAR;
            PG8_LDA(At, 1, 1); PG8_STAGE(PG8_SA(1, 0), a3, voffA);
            PG8_BAR; PG8_WAIT_L(0); PG8_MMA(1, 0, At, B0); PG8_BAR; PG8_SCHED;
            PG8_STAGE(PG8_SB(1, 1), b3 + hstep, voffB);
            PG8_WAIT_V(6); PG8_BAR; PG8_MMA(1, 1, At, B1); PG8_BAR;
            }
        }
        if constexpr (ALIGN_EPI) { if (wr == 0) PG8_BAR; }
        if constexpr (!Epi::AFTER_DRAIN) { E(acc, cur, wr, wc, fr, fq); S.done(cur); }
        if (!has_next) break;
#pragma unroll
        for (int a = 0; a < 2; ++a)
#pragma unroll
            for (int b = 0; b < 2; ++b)
#pragma unroll
                for (int m = 0; m < 4; ++m)
#pragma unroll
                    for (int n = 0; n < 2; ++n) acc[a][b][m][n] = (f32x4){0.f, 0.f, 0.f, 0.f};
        cur = nxt; cA = nA; cB = nB; ++ui;
        if constexpr (ALIGN_EPI) { if (wr == 1) PG8_BAR; }
    }
    PG8_WAIT_V(0);
    if constexpr (!ALIGN_EPI) { if (wr == 0) PG8_BAR; }
    PG8_BAR;
    if constexpr (Epi::AFTER_DRAIN) { E.fused(acc, cur, wr, wc, fr, fq, lds, wid, lane); S.done(cur); }
#undef PG8_SA
#undef PG8_SB
#undef PG8_STAGE
#undef PG8_LDA
#undef PG8_LDB
#undef PG8_MMA
#undef PG8_WAIT_V
#undef PG8_WAIT_L
#undef PG8_BAR
#undef PG8_SCHED
}
}


#ifndef PG8_SP2
#define PG8_SP2 true
#endif
#ifndef PG8_ALIGN
#define PG8_ALIGN true
#endif
#ifndef MK_N_LAUNCHES
#define MK_N_LAUNCHES 1
#endif

constexpr int NB = 8, SEQ = 2048, DM = 1024, MT = NB * SEQ;
constexpr int INC = 4096, NAH = 8;
constexpr int FFD = 2752, FFDP = 2816, NEX = 8, FFE = 3584;
constexpr int MOE_ROWS = 2 * MT + NEX * 256;
constexpr float DN_ALPHA = 1.41421356237309515f;
constexpr float LN_EPS = 1e-5f, RMS_EPS = 1e-6f;
constexpr int NWAVES = 8;

constexpr size_t MiB = 1u << 20;
constexpr size_t WS_CTL = 0, CTL_ZERO_BYTES = 1 * MiB;
constexpr size_t WS_ADA = 1 * MiB;
constexpr size_t WS_LB = 1 * MiB + 512 * 1024;
constexpr size_t WS_ROPE = 2 * MiB;
constexpr size_t WS_ROUTE = 6 * MiB;
constexpr size_t WS_ROWINFO = 6 * MiB + 512 * 1024;
constexpr size_t WS_WMGU = 8 * MiB;
constexpr size_t WS_WMDN = 120 * MiB;
constexpr size_t WS_WIN = 176 * MiB;
constexpr size_t WS_WOUT = 192 * MiB;
constexpr size_t WS_WGU = 196 * MiB;
constexpr size_t WS_WDN = 207 * MiB;
constexpr size_t WS_ABUF = 213 * MiB;
constexpr size_t WS_GATH = 176 * MiB;
constexpr size_t WS_YSLOT = 176 * MiB;
constexpr size_t WS_BIG = 245 * MiB;
constexpr size_t WS_PROJ = WS_BIG;
constexpr size_t WS_ATTO = WS_BIG + 128 * MiB;
constexpr size_t WS_LSE = WS_BIG + 176 * MiB;
constexpr size_t WS_ODIR = WS_BIG + 178 * MiB;
constexpr size_t WS_HID = WS_BIG;
constexpr size_t WS_END = 483 * MiB;
static_assert(WS_GATH + (size_t)MOE_ROWS * 1024 * 2 <= WS_BIG && WS_HID + (size_t)MOE_ROWS * FFE * 2 <= WS_END && WS_WDN + (size_t)1024 * FFDP * 2 <= WS_ABUF, "d_ws map");
constexpr int CW_TMO = 0, CW_BAR = 4096, CW_CNT = 16384;

constexpr int LDS_BYTES = 147456;
constexpr int MISC_OFF = 131072 + 320;

#define GAS __attribute__((address_space(1)))
#define LAS __attribute__((address_space(3)))
typedef unsigned short bf16;
typedef unsigned v4u __attribute__((ext_vector_type(4)));
typedef unsigned v2u __attribute__((ext_vector_type(2)));
typedef float f32x4 __attribute__((ext_vector_type(4)));
typedef GAS unsigned gu32;
#define RLX_AGENT __ATOMIC_RELAXED, __HIP_MEMORY_SCOPE_AGENT
#define LDS_WAIT() asm volatile("s_waitcnt lgkmcnt(0)" ::: "memory")
__device__ __forceinline__ unsigned f2bf(float f) { unsigned u = __builtin_bit_cast(unsigned, f); return (u + 0x7fffu + ((u >> 16) & 1u)) >> 16; }
__device__ __forceinline__ unsigned pk2(float lo, float hi) { return f2bf(lo) | (f2bf(hi) << 16); }
__device__ __forceinline__ float bflo(unsigned w) { return __uint_as_float(w << 16); }
__device__ __forceinline__ float bfhi(unsigned w) { return __uint_as_float(w & 0xffff0000u); }
__device__ __forceinline__ float bf1(bf16 h) { return __uint_as_float(((unsigned)h) << 16); }

#define XB_TMO      128
#define XB_XCNT(j)  (256  + 64 * (j))
#define XB_XSUB(j)  (1280 + 64 * (j))
#define XB_XGEN(j)  (2304 + 64 * (j))
#define XB_TOP      3328
#define XB_TOPGEN   3392
#define XCD_BAR_WORDS 3456
#define XB_SPIN_CAP (1u << 18)

__device__ __forceinline__ unsigned xb_ld(unsigned* p)              { return __hip_atomic_load(p, __ATOMIC_RELAXED, __HIP_MEMORY_SCOPE_AGENT); }
__device__ __forceinline__ unsigned xb_add(unsigned* p, unsigned v) { return __hip_atomic_fetch_add(p, v, __ATOMIC_RELAXED, __HIP_MEMORY_SCOPE_AGENT); }
__device__ __forceinline__ unsigned xb_xcc_id() { return (unsigned)__builtin_amdgcn_s_getreg((3 << 11) | 20) & 0xFu; }
#define XB_SPIN(cond, bar) do { unsigned _sp = 0; while (cond) { __builtin_amdgcn_s_sleep(1); \
    if ((++_sp & 255u) == 0u) { if (xb_ld(&(bar)[XB_TMO])) break; if (_sp > XB_SPIN_CAP) { atomicAdd(&(bar)[XB_TMO], 1u); break; } } } } while (0)

struct XcdBarrier {
    unsigned* bar; unsigned x;
    volatile LAS unsigned* st;
};

__device__ __forceinline__ XcdBarrier xcd_barrier_post(unsigned* bar, volatile LAS unsigned* st) {
    XcdBarrier b; b.bar = bar; b.x = xb_xcc_id(); b.st = st;
    if (threadIdx.x == 0) (void)xb_add(&bar[XB_XCNT(b.x)], 1u);
    return b;
}
__device__ __forceinline__ void xcd_barrier_complete(unsigned* bar, unsigned x, unsigned& nloc, unsigned& nx) {
    const unsigned G = gridDim.x * gridDim.y * gridDim.z;
    unsigned sum, cnt, mine, sp = 0u;
    for (;;) {
        sum = 0u; cnt = 0u; mine = 0u;
#pragma unroll
        for (unsigned j = 0; j < 16; ++j) { const unsigned c = xb_ld(&bar[XB_XCNT(j)]); sum += c; cnt += (c > 0u) ? 1u : 0u; mine = (j == x) ? c : mine; }
        if (sum == G) break;
        __builtin_amdgcn_s_sleep(1);
        if ((++sp & 255u) == 0u) { if (xb_ld(&bar[XB_TMO])) break; if (sp > XB_SPIN_CAP) { atomicAdd(&bar[XB_TMO], 1u); break; } }
    }
    nloc = mine > 0u ? mine : 1u; nx = cnt > 0u ? cnt : 1u;
}

__device__ __forceinline__ void xcd_barrier(const XcdBarrier& b) {
    asm volatile("s_waitcnt vmcnt(0)" ::: "memory");
    __syncthreads();
    if (threadIdx.x == 0) {
        unsigned* bar = b.bar;
        __builtin_amdgcn_s_waitcnt(0);
        unsigned nloc = b.st[0], nx = b.st[1];
        if (nloc == 0u) { xcd_barrier_complete(bar, b.x, nloc, nx); b.st[0] = nloc; b.st[1] = nx; }
        const unsigned old = xb_add(&bar[XB_XSUB(b.x)], 1u);
        const unsigned gen = old / nloc;
        if (old + 1u == (gen + 1u) * nloc) {
            __builtin_amdgcn_fence(__ATOMIC_RELEASE, "agent");
            asm volatile("s_waitcnt vmcnt(0)" ::: "memory");
            const unsigned og = xb_add(&bar[XB_TOP], 1u);
            const unsigned tg = og / nx;
            if (og + 1u == (tg + 1u) * nx) xb_add(&bar[XB_TOPGEN], 1u);
            else XB_SPIN(xb_ld(&bar[XB_TOPGEN]) == tg, bar);
            __builtin_amdgcn_fence(__ATOMIC_ACQUIRE, "agent");
            xb_add(&bar[XB_XGEN(b.x)], 1u);
            asm volatile("s_waitcnt vmcnt(0)" ::: "memory");
        } else {
            XB_SPIN(xb_ld(&bar[XB_XGEN(b.x)]) == gen, bar);
            __builtin_amdgcn_fence(__ATOMIC_ACQUIRE, "agent");
            asm volatile("s_waitcnt vmcnt(0)" ::: "memory");
        }
    }
    __syncthreads();
}


struct Args { const void* in[19]; float* out; unsigned char* ws; int ph_lo, ph_hi; };

struct Frame {
    LAS unsigned char* lds; unsigned char* ws; gu32* ctl;
    int tid, lane, wave, G, vcu;
};

__device__ __forceinline__ float wave_sum(float v) {
#pragma unroll
    for (int o = 1; o < 64; o <<= 1) v += __shfl_xor(v, o);
    return v;
}

template <int KIND>
__device__ __forceinline__ void p0_tile(const float* W, int ldn, int k0, int n0, bool zero, bf16* dst, int ldk, int sel, LAS float* scr, int lane) {
    if (!zero) {
#pragma unroll 8
        for (int i = 0; i < 32; ++i) { const int kk = 2 * i + (lane >> 5); scr[kk * 33 + (lane & 31)] = W[(size_t)(k0 + kk) * ldn + n0 + (lane & 31)]; }
    }
    LDS_WAIT(); asm volatile("" ::: "memory");
    const int c = lane & 7;
#pragma unroll
    for (int j = 0; j < 4; ++j) {
        const int n = (lane >> 3) + 8 * j, lc = n0 + n; int prow;
        if (KIND == 0) {
            if (lc < 1024) { const int d = lc & 63; prow = (lc & ~63) + 32 * ((d >> 4) & 1) + 16 * (d >> 5) + (d & 15); }
            else { const int x = lc & 31; prow = (lc & ~31) + 16 * ((x >> 2) & 1) + 4 * (x >> 3) + (x & 3); }
        } else if (KIND == 1) prow = lc;
        else { const int x = lc & 31; prow = 256 * (lc >> 7) + 128 * sel + 32 * ((lc >> 5) & 3) + 16 * ((x >> 2) & 1) + 4 * (x >> 3) + (x & 3); }
        v4u o;
        if (zero) { o = (v4u){0u, 0u, 0u, 0u}; }
        else { const LAS float* s = scr + (8 * c) * 33 + n;
            o.x = pk2(s[0 * 33], s[1 * 33]); o.y = pk2(s[2 * 33], s[3 * 33]); o.z = pk2(s[4 * 33], s[5 * 33]); o.w = pk2(s[6 * 33], s[7 * 33]); }
        *(v4u*)(dst + (size_t)prow * ldk + k0 + 8 * c) = o;
    }
    LDS_WAIT(); asm volatile("" ::: "memory");
}

__device__ __forceinline__ void p0_prologue(Frame& F, const Args& a) {
    const float* c_in = (const float*)a.in[1]; const int* positions = (const int*)a.in[2];
    const float* w_in = (const float*)a.in[3]; const float* w_out = (const float*)a.in[4];
    const float* lb_logits = (const float*)a.in[7]; const float* ada_w = (const float*)a.in[8]; const float* ada_b = (const float*)a.in[9];
    const float* ffn_g = (const float*)a.in[12]; const float* ffn_u = (const float*)a.in[13]; const float* ffn_d = (const float*)a.in[14];
    const float* moe_g = (const float*)a.in[16]; const float* moe_u = (const float*)a.in[17]; const float* moe_d = (const float*)a.in[18];
    float* ada = (float*)(F.ws + WS_ADA); float* lbt = (float*)(F.ws + WS_LB); float* rope = (float*)(F.ws + WS_ROPE);
    if (F.vcu < 24) {
        LAS float* cact = (LAS float*)F.lds;
        for (int i = F.tid; i < NB * DM; i += 512) { const float v = c_in[i]; cact[i] = v / (1.0f + __expf(-v)); }
        __syncthreads();
        const int ls = F.vcu / 6, n = (F.vcu % 6) * 512 + F.tid;
        const float* w = ada_w + (size_t)ls * DM * 3072 + n;
        float acc[8];
#pragma unroll
        for (int b = 0; b < 8; ++b) acc[b] = 0.f;
#pragma unroll 4
        for (int k = 0; k < DM; ++k) { const float wv = w[(size_t)k * 3072];
#pragma unroll
            for (int b = 0; b < 8; ++b) acc[b] += cact[b * DM + k] * wv; }
        const float bias = ada_b[ls * 3072 + n];
#pragma unroll
        for (int b = 0; b < 8; ++b) ada[(size_t)(ls * 8 + b) * 3072 + n] = acc[b] + bias;
        __syncthreads();
    }
    const int gt = F.vcu * 512 + F.tid, GT = F.G * 512;
    for (int i = gt; i < MT * 32; i += GT) {
        const int m = i >> 5, d = i & 31;
        const float ang = (float)positions[m] * exp2f(-(float)d * 0.41524101186092029f);
        const double rev = (double)ang * 0.15915494309189533577;
        const float fr = (float)(rev - __builtin_rint(rev));
        rope[2 * (size_t)i] = __builtin_amdgcn_cosf(fr); rope[2 * (size_t)i + 1] = __builtin_amdgcn_sinf(fr);
    }
    for (int i = gt; i < 2 * 512; i += GT) {
        const float a0 = lb_logits[i], a1 = lb_logits[1024 + i];
        lbt[i] = 0.f; lbt[1024 + i] = 1.0f / (1.0f + __expf(a0 - a1));
    }
    LAS float* scr = (LAS float*)(F.lds + 32768 + F.wave * 8704);
    const int gw = F.vcu * NWAVES + F.wave, NGW = F.G * NWAVES;
    constexpr int I0 = 2 * 16 * 128, I1 = 2 * 16 * 32, I2 = 2 * 16 * 88, I3 = 44 * 32, I4 = 8 * 2 * 16 * 112, I5 = 8 * 56 * 32;
    constexpr int NITEMS = I0 + I1 + I2 + I3 + I4 + I5;
    for (int it = gw; it < NITEMS; it += NGW) {
        int r = it;
        if (r < I0) { const int l = r / 2048, q = r % 2048, kb = q / 128, nb = q % 128;
            p0_tile<0>(w_in + (size_t)l * DM * INC, INC, 64 * kb, 32 * nb, false, (bf16*)(F.ws + WS_WIN) + (size_t)l * INC * DM, DM, 0, scr, F.lane); continue; } r -= I0;
        if (r < I1) { const int l = r / 512, q = r % 512, kb = q / 32, nb = q % 32;
            p0_tile<1>(w_out + (size_t)l * DM * DM, DM, 64 * kb, 32 * nb, false, (bf16*)(F.ws + WS_WOUT) + (size_t)l * DM * DM, DM, 0, scr, F.lane); continue; } r -= I1;
        if (r < I2) { const int sel = r / 1408, q = r % 1408, kb = q / 88, nb = q % 88;
            p0_tile<2>(sel ? ffn_u : ffn_g, FFD, 64 * kb, 32 * nb, nb >= 86, (bf16*)(F.ws + WS_WGU), DM, sel, scr, F.lane); continue; } r -= I2;
        if (r < I3) { const int kb = r / 32, nb = r % 32;
            p0_tile<1>(ffn_d, DM, 64 * kb, 32 * nb, kb >= 43, (bf16*)(F.ws + WS_WDN), FFDP, 0, scr, F.lane); continue; } r -= I3;
        if (r < I4) { const int e = r / 3584, q0 = r % 3584, sel = q0 / 1792, q = q0 % 1792, kb = q / 112, nb = q % 112;
            p0_tile<2>((sel ? moe_u : moe_g) + (size_t)e * DM * FFE, FFE, 64 * kb, 32 * nb, false, (bf16*)(F.ws + WS_WMGU) + (size_t)e * 2 * FFE * DM, DM, sel, scr, F.lane); continue; } r -= I4;
        { const int e = r / 1792, q = r % 1792, kb = q / 32, nb = q % 32;
            p0_tile<1>(moe_d + (size_t)e * FFE * DM, DM, 64 * kb, 32 * nb, false, (bf16*)(F.ws + WS_WMDN) + (size_t)e * DM * FFE, FFE, 0, scr, F.lane); }
    }
}

__device__ __forceinline__ void p1_mod0(Frame& F, const float* x, const float* adar  , bf16* abuf) {
    const int gw = F.vcu * NWAVES + F.wave, NGW = F.G * NWAVES;
    for (int m = gw; m < MT; m += NGW) {
        const int b = m >> 11; const float* ar = adar + (size_t)b * 3072;
        const f32x4* xr = (const f32x4*)(x + (size_t)m * DM) + F.lane;
        unsigned long long* o8 = (unsigned long long*)(abuf + (size_t)m * DM) + F.lane;
#pragma unroll
        for (int j = 0; j < 4; ++j) {
            const f32x4 v = xr[64 * j]; const int col = 4 * F.lane + 256 * j;
            const f32x4 sh = *(const f32x4*)(ar + col), sc = *(const f32x4*)(ar + 1024 + col);
            const f32x4 u = v * (sc + 1.0f) + sh;
            o8[64 * j] = (unsigned long long)pk2(u[0], u[1]) | ((unsigned long long)pk2(u[2], u[3]) << 32);
        }
    }
}

__device__ __forceinline__ void attn_simple(Frame& F, const bf16* proj, bf16* atto) {
    for (int gid = F.vcu * 512 + F.tid; gid < NB * NAH * SEQ; gid += F.G * 512) {
        const int i = gid & (SEQ - 1), h = (gid >> 11) & 7, b = gid >> 14;
        const size_t rowb = (size_t)b * SEQ;
        float q[64], o[64];
        { const v4u* qp = (const v4u*)(proj + (rowb + i) * INC + h * 64);
#pragma unroll
          for (int c = 0; c < 8; ++c) { const v4u w = qp[c]; q[8 * c] = bflo(w.x); q[8 * c + 1] = bfhi(w.x); q[8 * c + 2] = bflo(w.y); q[8 * c + 3] = bfhi(w.y); q[8 * c + 4] = bflo(w.z); q[8 * c + 5] = bfhi(w.z); q[8 * c + 6] = bflo(w.w); q[8 * c + 7] = bfhi(w.w); } }
#pragma unroll
        for (int d = 0; d < 64; ++d) o[d] = 0.f;
        float mx = -1e30f, l = 0.f;
        for (int p = 0; p < 3; ++p) {
            const int dl = (p == 0) ? 1 : (p == 1 ? 4 : 16);
            for (int j = -64; j <= 64; ++j) {
                const int pos = i + dl * j;
                if (pos < 0 || pos >= SEQ) continue;
                const v4u* kp = (const v4u*)(proj + (rowb + pos) * INC + 512 + h * 64);
                float s = 0.f;
#pragma unroll
                for (int c = 0; c < 8; ++c) { const v4u w = kp[c];
                    s += q[8 * c] * bflo(w.x) + q[8 * c + 1] * bfhi(w.x) + q[8 * c + 2] * bflo(w.y) + q[8 * c + 3] * bfhi(w.y) + q[8 * c + 4] * bflo(w.z) + q[8 * c + 5] * bfhi(w.z) + q[8 * c + 6] * bflo(w.w) + q[8 * c + 7] * bfhi(w.w); }
                if (s > mx) { const float r = __expf(mx - s); l *= r;
#pragma unroll
                    for (int d = 0; d < 64; ++d) o[d] *= r;
                    mx = s; }
                const float pe = __expf(s - mx); l += pe;
                const v4u* vp = (const v4u*)(proj + (rowb + pos) * INC + 1024 + h * 64);
#pragma unroll
                for (int c = 0; c < 8; ++c) { const v4u w = vp[c];
                    o[8 * c] += pe * bflo(w.x); o[8 * c + 1] += pe * bfhi(w.x); o[8 * c + 2] += pe * bflo(w.y); o[8 * c + 3] += pe * bfhi(w.y); o[8 * c + 4] += pe * bflo(w.z); o[8 * c + 5] += pe * bfhi(w.z); o[8 * c + 6] += pe * bflo(w.w); o[8 * c + 7] += pe * bfhi(w.w); }
            }
        }
        const float inv = 1.0f / l;
        v4u* op = (v4u*)(atto + (rowb + i) * 512 + h * 64);
#pragma unroll
        for (int c = 0; c < 8; ++c) { v4u w; w.x = pk2(o[8 * c] * inv, o[8 * c + 1] * inv); w.y = pk2(o[8 * c + 2] * inv, o[8 * c + 3] * inv); w.z = pk2(o[8 * c + 4] * inv, o[8 * c + 5] * inv); w.w = pk2(o[8 * c + 6] * inv, o[8 * c + 7] * inv); op[c] = w; }
    }
}

__device__ __forceinline__ void gla_simple(Frame& F, const bf16* proj, bf16* odir) {
    LAS float* red = (LAS float*)F.lds;
    const int sub = F.tid >> 7, c = F.tid & 127, wsub = (F.tid >> 6) & 1;
    for (int ug = F.vcu; ug < 256; ug += F.G) {
        const int unit = ug * 4 + sub, chain = unit >> 4, cg = unit & 15;
        const int dir = chain & 1, h = (chain >> 1) & 3, b = chain >> 3;
        const size_t rowb = (size_t)b * SEQ;
        float S[8];
#pragma unroll
        for (int j = 0; j < 8; ++j) S[j] = 0.f;
        for (int t0 = 0; t0 < SEQ; t0 += 8) {
            float pr[64];
#pragma unroll
            for (int tt = 0; tt < 8; ++tt) {
                const int t = t0 + tt, pos = dir ? (SEQ - 1 - t) : t;
                const bf16* rp = proj + (rowb + pos) * INC;
                const float g = bf1(rp[2048 + 512 * dir + h * 128 + c]);
                const float qv = bf1(rp[1536 + h * 128 + c]);
                const v4u vw = *(const v4u*)(rp + 3072 + h * 128 + cg * 8);
                const float f = __expf(g), kk = 1.0f - f;
                const float vv[8] = {bflo(vw.x), bfhi(vw.x), bflo(vw.y), bfhi(vw.y), bflo(vw.z), bfhi(vw.z), bflo(vw.w), bfhi(vw.w)};
#pragma unroll
                for (int j = 0; j < 8; ++j) { S[j] = f * S[j] + kk * vv[j]; pr[tt * 8 + j] = qv * S[j]; }
            }
#pragma unroll
            for (int step = 0; step < 6; ++step) {
                const int off = 32 >> step, half = 32 >> step;
                const bool up = (F.lane & off) != 0;
#pragma unroll
                for (int i = 0; i < half; ++i) {
                    const float keep = up ? pr[i + half] : pr[i], send = up ? pr[i] : pr[i + half];
                    pr[i] = keep + __shfl_xor(send, off);
                }
            }
            __syncthreads();
            if (wsub == 1) red[sub * 64 + F.lane] = pr[0];
            __syncthreads();
            if (wsub == 0) {
                const float tot = pr[0] + red[sub * 64 + F.lane];
                const int t = t0 + (F.lane >> 3), j = F.lane & 7, pos = dir ? (SEQ - 1 - t) : t;
                odir[((size_t)dir * MT + rowb + pos) * 512 + h * 128 + cg * 8 + j] = (bf16)f2bf(tot);
            }
        }
    }
}

typedef short s16x8 __attribute__((ext_vector_type(8)));
typedef float f32x16 __attribute__((ext_vector_type(16)));
__device__ __forceinline__ unsigned cvtpk(float lo, float hi) { unsigned r; asm volatile("v_cvt_pk_bf16_f32 %0, %1, %2" : "=v"(r) : "v"(lo), "v"(hi)); return r; }
__device__ __forceinline__ s16x8 tr_read_pair(unsigned a0, unsigned a1) {
    v2u lo, hi;
    asm volatile("ds_read_b64_tr_b16 %0, %2\n\tds_read_b64_tr_b16 %1, %3\n\ts_waitcnt lgkmcnt(0)" : "=&v"(lo), "=&v"(hi) : "v"(a0), "v"(a1) : "memory");
    v4u w; w.x = lo.x; w.y = lo.y; w.z = hi.x; w.w = hi.y;
    return __builtin_bit_cast(s16x8, w);
}
constexpr int ATT_ITEMS = NB * NAH * 96;

__device__ __forceinline__ void attn_mfma(Frame& F, const bf16* proj, bf16* atto  , float* lsep  ) {
    const int l = F.lane, r = l & 31, hh = l >> 5;
    LAS unsigned char* vt = F.lds + F.wave * 4096;
    const unsigned vtb = (unsigned)(size_t)vt;
    const int tq = (l & 15) >> 2, tp = l & 3, tblk = (l >> 4) & 1;
    const int gw = F.vcu * NWAVES + F.wave, NGW = F.G * NWAVES;
    for (int it = gw; it < ATT_ITEMS; it += NGW) {
        const int bh = it / 96, rem = it - bh * 96, p = rem >> 5, idx = rem & 31;
        const int b = bh >> 3, h = bh & 7;
        const int dl = (p == 0) ? 1 : (p == 1 ? 4 : 16), L = SEQ / dl;
        const int cls = (p == 0) ? 0 : (p == 1 ? (idx >> 3) : (idx >> 1));
        const int blk = (p == 0) ? idx : (p == 1 ? (idx & 7) : (idx & 1));
        const int m0 = blk * 64;
        const bf16* base = proj + (size_t)b * SEQ * INC + h * 64;
        s16x8 qf[2][4];
#pragma unroll
        for (int qt = 0; qt < 2; ++qt) { const bf16* qp = base + (size_t)(cls + dl * (m0 + 32 * qt + r)) * INC + 8 * hh;
#pragma unroll
            for (int ks = 0; ks < 4; ++ks) qf[qt][ks] = *(const s16x8*)(qp + 16 * ks); }
        f32x16 O[2][2];
#pragma unroll
        for (int qt = 0; qt < 2; ++qt)
#pragma unroll
            for (int dt = 0; dt < 2; ++dt)
#pragma unroll
                for (int i = 0; i < 16; ++i) O[qt][dt][i] = 0.f;
        float mrun[2] = {-1e30f, -1e30f}, lsum[2] = {0.f, 0.f};
        s16x8 kfn[4]; v4u vn[4];
        {
            const int kb = m0 - 64;
            int mk = kb + r; mk = mk < 0 ? 0 : (mk >= L ? L - 1 : mk);
            const bf16* kp = base + (size_t)(cls + dl * mk) * INC + 512 + 8 * hh;
#pragma unroll
            for (int ks = 0; ks < 4; ++ks) kfn[ks] = *(const s16x8*)(kp + 16 * ks);
#pragma unroll
            for (int i = 0; i < 4; ++i) { const int c = l + 64 * i; int mv = kb + (c >> 3); mv = mv < 0 ? 0 : (mv >= L ? L - 1 : mv);
                vn[i] = *(const v4u*)(base + (size_t)(cls + dl * mv) * INC + 1024 + 8 * (c & 7)); }
        }
        for (int kt = 0; kt < 6; ++kt) {
            const int kb = m0 - 64 + 32 * kt;
            const bool inrange = (kb >= 0) && (kb < L);
            s16x8 kf[4];
#pragma unroll
            for (int ks = 0; ks < 4; ++ks) kf[ks] = kfn[ks];
#pragma unroll
            for (int i = 0; i < 4; ++i) { const int c = l + 64 * i, vr = c >> 3, ch = c & 7;
                *(LAS v4u*)(vt + vr * 128 + ((ch * 16) ^ (((vr >> 1) & 1) << 6))) = vn[i]; }
            if (kt < 5) {
                const int kb2 = kb + 32;
                int mk = kb2 + r; mk = mk < 0 ? 0 : (mk >= L ? L - 1 : mk);
                const bf16* kp = base + (size_t)(cls + dl * mk) * INC + 512 + 8 * hh;
#pragma unroll
                for (int ks = 0; ks < 4; ++ks) kfn[ks] = *(const s16x8*)(kp + 16 * ks);
#pragma unroll
                for (int i = 0; i < 4; ++i) { const int c = l + 64 * i; int mv = kb2 + (c >> 3); mv = mv < 0 ? 0 : (mv >= L ? L - 1 : mv);
                    vn[i] = *(const v4u*)(base + (size_t)(cls + dl * mv) * INC + 1024 + 8 * (c & 7)); }
            }
            asm volatile("s_waitcnt lgkmcnt(0)" ::: "memory");
            if (inrange) {
                s16x8 vf[2][2];
#pragma unroll
                for (int dt = 0; dt < 2; ++dt)
#pragma unroll
                    for (int s = 0; s < 2; ++s) {
                        const int row0 = 16 * s + 4 * hh + tq, row1 = row0 + 8;
                        const int cb = 64 * dt + 32 * tblk + 8 * tp;
                        vf[dt][s] = tr_read_pair(vtb + row0 * 128 + (cb ^ (((row0 >> 1) & 1) << 6)), vtb + row1 * 128 + (cb ^ (((row1 >> 1) & 1) << 6)));
                    }
#pragma unroll
                for (int qt = 0; qt < 2; ++qt) {
                    const int d = kt - qt;
                    if (d >= 0 && d <= 4) {
                        f32x16 s;
#pragma unroll
                        for (int i = 0; i < 16; ++i) s[i] = 0.f;
#pragma unroll
                        for (int ks = 0; ks < 4; ++ks) s = __builtin_amdgcn_mfma_f32_32x32x16_bf16(kf[ks], qf[qt][ks], s, 0, 0, 0);
                        if (d == 0) {
#pragma unroll
                            for (int i = 0; i < 16; ++i) { const int kr = (i & 3) + 8 * (i >> 2) + 4 * hh; s[i] = (kr >= r) ? s[i] : -1e30f; }
                        } else if (d == 4) {
#pragma unroll
                            for (int i = 0; i < 16; ++i) { const int kr = (i & 3) + 8 * (i >> 2) + 4 * hh; s[i] = (kr <= r) ? s[i] : -1e30f; }
                        }
                        float tmax = s[0];
#pragma unroll
                        for (int i = 1; i < 16; ++i) tmax = fmaxf(tmax, s[i]);
                        tmax = fmaxf(tmax, __shfl_xor(tmax, 32));
                        const float mnew = fmaxf(mrun[qt], tmax);
                        const float alpha = __expf(mrun[qt] - mnew);
                        mrun[qt] = mnew;
                        float psum = 0.f;
#pragma unroll
                        for (int i = 0; i < 16; ++i) { s[i] = __expf(s[i] - mnew); psum += s[i]; }
                        lsum[qt] = lsum[qt] * alpha + psum;
#pragma unroll
                        for (int dt = 0; dt < 2; ++dt)
#pragma unroll
                            for (int i = 0; i < 16; ++i) O[qt][dt][i] *= alpha;
                        s16x8 pf[2];
#pragma unroll
                        for (int s2 = 0; s2 < 2; ++s2) { v4u w; w.x = cvtpk(s[8 * s2 + 0], s[8 * s2 + 1]); w.y = cvtpk(s[8 * s2 + 2], s[8 * s2 + 3]); w.z = cvtpk(s[8 * s2 + 4], s[8 * s2 + 5]); w.w = cvtpk(s[8 * s2 + 6], s[8 * s2 + 7]);
                            pf[s2] = __builtin_bit_cast(s16x8, w); }
#pragma unroll
                        for (int dt = 0; dt < 2; ++dt)
#pragma unroll
                            for (int s2 = 0; s2 < 2; ++s2) O[qt][dt] = __builtin_amdgcn_mfma_f32_32x32x16_bf16(vf[dt][s2], pf[s2], O[qt][dt], 0, 0, 0);
                    }
                }
            }
        }
#pragma unroll
        for (int qt = 0; qt < 2; ++qt) {
            const float ltot = lsum[qt] + __shfl_xor(lsum[qt], 32);
            const float inv = 1.0f / ltot;
            const size_t tok = (size_t)b * SEQ + cls + dl * (m0 + 32 * qt + r);
            bf16* op = atto + ((size_t)p * MT + tok) * 512 + h * 64;
#pragma unroll
            for (int dt = 0; dt < 2; ++dt)
#pragma unroll
                for (int g = 0; g < 4; ++g) {
                    v2u w; w.x = cvtpk(O[qt][dt][4 * g] * inv, O[qt][dt][4 * g + 1] * inv); w.y = cvtpk(O[qt][dt][4 * g + 2] * inv, O[qt][dt][4 * g + 3] * inv);
                    *(v2u*)(op + 32 * dt + 8 * g + 4 * hh) = w;
                }
            if (hh == 0) lsep[((size_t)p * MT + tok) * 8 + h] = mrun[qt] + __logf(ltot);
        }
    }
}

__device__ __forceinline__ void combine_phase(Frame& F, const bf16* proj, const bf16* atto, const float* lsep, const bf16* odir, const float* again, const float* rgain, bf16* abuf) {
    const int gw = F.vcu * NWAVES + F.wave, NGW = F.G * NWAVES;
    for (int m = gw; m < MT; m += NGW) {
        const int c0 = 8 * F.lane;
        { const int hd = F.lane >> 3;
          const float l0 = lsep[(size_t)m * 8 + hd], l1 = lsep[((size_t)MT + m) * 8 + hd], l2 = lsep[((size_t)2 * MT + m) * 8 + hd];
          const float lm = fmaxf(l0, fmaxf(l1, l2));
          float w0 = __expf(l0 - lm), w1 = __expf(l1 - lm), w2 = __expf(l2 - lm);
          const float wi = 1.0f / (w0 + w1 + w2); w0 *= wi; w1 *= wi; w2 *= wi;
          const v4u a0 = *(const v4u*)(atto + (size_t)m * 512 + c0), a1 = *(const v4u*)(atto + ((size_t)MT + m) * 512 + c0), a2 = *(const v4u*)(atto + ((size_t)2 * MT + m) * 512 + c0);
          float v[8] = {w0 * bflo(a0.x) + w1 * bflo(a1.x) + w2 * bflo(a2.x), w0 * bfhi(a0.x) + w1 * bfhi(a1.x) + w2 * bfhi(a2.x),
                        w0 * bflo(a0.y) + w1 * bflo(a1.y) + w2 * bflo(a2.y), w0 * bfhi(a0.y) + w1 * bfhi(a1.y) + w2 * bfhi(a2.y),
                        w0 * bflo(a0.z) + w1 * bflo(a1.z) + w2 * bflo(a2.z), w0 * bfhi(a0.z) + w1 * bfhi(a1.z) + w2 * bfhi(a2.z),
                        w0 * bflo(a0.w) + w1 * bflo(a1.w) + w2 * bflo(a2.w), w0 * bfhi(a0.w) + w1 * bfhi(a1.w) + w2 * bfhi(a2.w)};
          float ss = 0.f;
#pragma unroll
          for (int j = 0; j < 8; ++j) ss += v[j] * v[j];
          const float r = 1.0f / sqrtf(wave_sum(ss) * (1.0f / 512.0f) + RMS_EPS);
          const f32x4 g0 = *(const f32x4*)(again + c0), g1 = *(const f32x4*)(again + c0 + 4);
          v4u o; o.x = pk2(v[0] * r * g0[0], v[1] * r * g0[1]); o.y = pk2(v[2] * r * g0[2], v[3] * r * g0[3]); o.z = pk2(v[4] * r * g1[0], v[5] * r * g1[1]); o.w = pk2(v[6] * r * g1[2], v[7] * r * g1[3]);
          *(v4u*)(abuf + (size_t)m * DM + c0) = o; }
        { const v4u wf = *(const v4u*)(odir + (size_t)m * 512 + c0), wb = *(const v4u*)(odir + ((size_t)MT + m) * 512 + c0);
          const v4u wg = *(const v4u*)(proj + (size_t)m * INC + 3584 + c0);
          float v[8] = {bflo(wf.x) + bflo(wb.x), bfhi(wf.x) + bfhi(wb.x), bflo(wf.y) + bflo(wb.y), bfhi(wf.y) + bfhi(wb.y), bflo(wf.z) + bflo(wb.z), bfhi(wf.z) + bfhi(wb.z), bflo(wf.w) + bflo(wb.w), bfhi(wf.w) + bfhi(wb.w)};
          const float sg[8] = {bflo(wg.x), bfhi(wg.x), bflo(wg.y), bfhi(wg.y), bflo(wg.z), bfhi(wg.z), bflo(wg.w), bfhi(wg.w)};
          float ss = 0.f;
#pragma unroll
          for (int j = 0; j < 8; ++j) ss += v[j] * v[j];
          ss += __shfl_xor(ss, 1); ss += __shfl_xor(ss, 2); ss += __shfl_xor(ss, 4); ss += __shfl_xor(ss, 8);
          const float r = 1.0f / sqrtf(ss * (1.0f / 128.0f) + RMS_EPS);
          const f32x4 g0 = *(const f32x4*)(rgain + c0), g1 = *(const f32x4*)(rgain + c0 + 4);
          v4u o; o.x = pk2(v[0] * r * g0[0] * sg[0], v[1] * r * g0[1] * sg[1]); o.y = pk2(v[2] * r * g0[2] * sg[2], v[3] * r * g0[3] * sg[3]);
          o.z = pk2(v[4] * r * g1[0] * sg[4], v[5] * r * g1[1] * sg[5]); o.w = pk2(v[6] * r * g1[2] * sg[6], v[7] * r * g1[3] * sg[7]);
          *(v4u*)(abuf + (size_t)m * DM + 512 + c0) = o; }
    }
}

template <int MODE>
__device__ __forceinline__ void ln_phase(Frame& F, float* xs, const float* lng, const float* lnb, const float* adan  , bf16* abuf,
                                         const float* wrt  , unsigned* route) {
    const int gw = F.vcu * NWAVES + F.wave, NGW = F.G * NWAVES;
    for (int m = gw; m < MT; m += NGW) {
        f32x4* xr = (f32x4*)(xs + (size_t)m * DM) + F.lane;
        f32x4 v[4]; float s = 0.f;
#pragma unroll
        for (int j = 0; j < 4; ++j) { v[j] = xr[64 * j]; s += (v[j][0] + v[j][1]) + (v[j][2] + v[j][3]); }
        const float mean = wave_sum(s) * (1.0f / DM); float s2 = 0.f;
#pragma unroll
        for (int j = 0; j < 4; ++j) { v[j] = v[j] - mean; s2 += (v[j][0] * v[j][0] + v[j][1] * v[j][1]) + (v[j][2] * v[j][2] + v[j][3] * v[j][3]); }
        const float rstd = 1.0f / sqrtf(wave_sum(s2) * (1.0f / DM) + LN_EPS);
        const int b = m >> 11; const float* ar = adan + (size_t)b * 3072;
        float lg[8];
#pragma unroll
        for (int e = 0; e < 8; ++e) lg[e] = 0.f;
#pragma unroll
        for (int j = 0; j < 4; ++j) {
            const int col = 4 * F.lane + 256 * j;
            const f32x4 xn = v[j] * rstd * *(const f32x4*)(lng + col) + *(const f32x4*)(lnb + col);
            xr[64 * j] = xn;
            const f32x4 u = xn * (*(const f32x4*)(ar + 1024 + col) + 1.0f) + *(const f32x4*)(ar + col);
            if (MODE == 0) ((unsigned long long*)(abuf + (size_t)m * DM) + F.lane)[64 * j] = (unsigned long long)pk2(u[0], u[1]) | ((unsigned long long)pk2(u[2], u[3]) << 32);
            if (MODE == 1) {
#pragma unroll
                for (int i = 0; i < 4; ++i) { const f32x4 w0 = *(const f32x4*)(wrt + (size_t)(col + i) * 8), w1 = *(const f32x4*)(wrt + (size_t)(col + i) * 8 + 4);
                    lg[0] += u[i] * w0[0]; lg[1] += u[i] * w0[1]; lg[2] += u[i] * w0[2]; lg[3] += u[i] * w0[3]; lg[4] += u[i] * w1[0]; lg[5] += u[i] * w1[1]; lg[6] += u[i] * w1[2]; lg[7] += u[i] * w1[3]; }
            }
        }
        if (MODE == 1) {
#pragma unroll
            for (int e = 0; e < 8; ++e) lg[e] = wave_sum(lg[e]);
            int e1 = 0; float l1 = lg[0];
#pragma unroll
            for (int e = 1; e < 8; ++e) if (lg[e] > l1) { l1 = lg[e]; e1 = e; }
            int e2 = -1; float l2 = -3.0e38f;
#pragma unroll
            for (int e = 0; e < 8; ++e) if (e != e1 && lg[e] > l2) { l2 = lg[e]; e2 = e; }
            if (F.lane == 0) {
                const float w1 = 1.0f / (1.0f + __expf(l2 - l1)), w2 = 1.0f - w1;
                const unsigned p1 = __hip_atomic_fetch_add((unsigned*)(F.ctl + CW_CNT + 64 * e1), 1u, RLX_AGENT);
                const unsigned p2 = __hip_atomic_fetch_add((unsigned*)(F.ctl + CW_CNT + 64 * e2), 1u, RLX_AGENT);
                unsigned* rt = route + (size_t)m * 8;
                rt[0] = (unsigned)e1; rt[1] = p1; rt[2] = __float_as_uint(w1); rt[3] = (unsigned)e2; rt[4] = p2; rt[5] = __float_as_uint(w2);
            }
        }
    }
}

struct MoeOff { int off[9]; int cnt[8]; };
__device__ __forceinline__ void moe_offsets(Frame& F, int (&off)[9], int (&cnt)[8]) {
    off[0] = 0;
#pragma unroll
    for (int e = 0; e < 8; ++e) { cnt[e] = (int)__hip_atomic_load((unsigned*)(F.ctl + CW_CNT + 64 * e), RLX_AGENT); off[e + 1] = off[e] + ((cnt[e] + 255) & ~255); }
}

__device__ __forceinline__ void gather_phase(Frame& F, const float* xs, const float* adan, const unsigned* route, bf16* gath, unsigned* rowinfo) {
    int off[9], cnt[8]; moe_offsets(F, off, cnt);
    const int gw = F.vcu * NWAVES + F.wave, NGW = F.G * NWAVES;
    for (int m = gw; m < MT; m += NGW) {
        const unsigned* rt = route + (size_t)m * 8;
        const int e1 = (int)rt[0], p1 = (int)rt[1], e2 = (int)rt[3], p2 = (int)rt[4]; const unsigned w1 = rt[2], w2 = rt[5];
        int o1 = 0, o2 = 0;
#pragma unroll
        for (int e = 0; e < 8; ++e) { o1 = (e1 == e) ? off[e] : o1; o2 = (e2 == e) ? off[e] : o2; }
        const int r1 = o1 + p1, r2 = o2 + p2;
        const int b = m >> 11; const float* ar = adan + (size_t)b * 3072;
        const f32x4* xr = (const f32x4*)(xs + (size_t)m * DM) + F.lane;
        unsigned long long* d1 = (unsigned long long*)(gath + (size_t)r1 * DM) + F.lane; unsigned long long* d2 = (unsigned long long*)(gath + (size_t)r2 * DM) + F.lane;
#pragma unroll
        for (int j = 0; j < 4; ++j) {
            const int col = 4 * F.lane + 256 * j;
            const f32x4 u = xr[64 * j] * (*(const f32x4*)(ar + 1024 + col) + 1.0f) + *(const f32x4*)(ar + col);
            const unsigned long long w = (unsigned long long)pk2(u[0], u[1]) | ((unsigned long long)pk2(u[2], u[3]) << 32);
            d1[64 * j] = w; d2[64 * j] = w;
        }
        if (F.lane == 0) { rowinfo[2 * (size_t)r1] = (unsigned)m; rowinfo[2 * (size_t)r1 + 1] = w1; rowinfo[2 * (size_t)r2] = (unsigned)m | (1u << 16); rowinfo[2 * (size_t)r2 + 1] = w2; }
    }
    for (int it = gw; it < 8 * 256; it += NGW) {
        const int e = it >> 8, i = it & 255; int oe = 0, ce = 0;
#pragma unroll
        for (int k = 0; k < 8; ++k) { oe = (e == k) ? off[k] : oe; ce = (e == k) ? cnt[k] : ce; }
        const int npad = ((ce + 255) & ~255) - ce;
        if (i < npad) { const int row = oe + ce + i;
            v4u* d = (v4u*)(gath + (size_t)row * DM) + F.lane; d[0] = (v4u){0u, 0u, 0u, 0u}; d[64] = (v4u){0u, 0u, 0u, 0u};
            if (F.lane == 0) { rowinfo[2 * (size_t)row] = 0xffffffffu; rowinfo[2 * (size_t)row + 1] = 0u; } }
    }
}

__device__ __forceinline__ void final_phase(Frame& F, float* xs, const bf16* yslot, const float* adar  , const float* lng, const float* lnb) {
    const int gw = F.vcu * NWAVES + F.wave, NGW = F.G * NWAVES;
    for (int m = gw; m < MT; m += NGW) {
        f32x4* xr = (f32x4*)(xs + (size_t)m * DM) + F.lane;
        const v2u* y0 = (const v2u*)(yslot + (size_t)m * DM) + F.lane; const v2u* y1 = (const v2u*)(yslot + ((size_t)MT + m) * DM) + F.lane;
        const int b = m >> 11; const float* ar = adar + (size_t)b * 3072 + 2048;
        f32x4 v[4]; float s = 0.f;
#pragma unroll
        for (int j = 0; j < 4; ++j) {
            const int col = 4 * F.lane + 256 * j;
            const v2u a = y0[64 * j], c = y1[64 * j];
            const f32x4 y = (f32x4){bflo(a.x) + bflo(c.x), bfhi(a.x) + bfhi(c.x), bflo(a.y) + bflo(c.y), bfhi(a.y) + bfhi(c.y)};
            v[j] = xr[64 * j] * DN_ALPHA + (*(const f32x4*)(ar + col) + 1.0f) * y;
            s += (v[j][0] + v[j][1]) + (v[j][2] + v[j][3]);
        }
        const float mean = wave_sum(s) * (1.0f / DM); float s2 = 0.f;
#pragma unroll
        for (int j = 0; j < 4; ++j) { v[j] = v[j] - mean; s2 += (v[j][0] * v[j][0] + v[j][1] * v[j][1]) + (v[j][2] * v[j][2] + v[j][3] * v[j][3]); }
        const float rstd = 1.0f / sqrtf(wave_sum(s2) * (1.0f / DM) + LN_EPS);
#pragma unroll
        for (int j = 0; j < 4; ++j) { const int col = 4 * F.lane + 256 * j; xr[64 * j] = v[j] * rstd * *(const f32x4*)(lng + col) + *(const f32x4*)(lnb + col); }
    }
}

constexpr int NPH = 20;
#define IN(k) (lo <= (k) && (k) < hi)
#define SEAM(k) do { if (IN(k) && IN((k) + 1)) xcd_barrier(bar); } while (0)
template <int L>
__device__ __forceinline__ void layer_phases(Frame& F, const Args& args, const XcdBarrier& bar, const int lo, const int hi) {
    constexpr int pb = 2 + 9 * L;
    unsigned char* const ws = args.ws;
    float* const xs = args.out;
    if (IN(pb + 0)) {
        pg8::Gemm g{(const bf16*)(ws + WS_ABUF), (const bf16*)(ws + WS_WIN) + (size_t)L * INC * DM, MT, INC, DM}; pg8::StaticOrder S; S.init(MT, INC, F.G, (int)blockIdx.x);
        pg8::EpiIn E{(bf16*)(ws + WS_PROJ), (const float*)(ws + WS_ROPE), (const float*)(ws + WS_LB) + (size_t)L * 1024};
        pg8::gemm_phase<pg8::EpiIn, pg8::StaticOrder, PG8_ALIGN, PG8_SP2>(F.lds, g, S, E);
        SEAM(pb + 0);
    }
    if (IN(pb + 1)) { attn_mfma(F, (const bf16*)(ws + WS_PROJ), (bf16*)(ws + WS_ATTO), (float*)(ws + WS_LSE)); gla_simple(F, (const bf16*)(ws + WS_PROJ), (bf16*)(ws + WS_ODIR)); SEAM(pb + 1); }
    if (IN(pb + 2)) { combine_phase(F, (const bf16*)(ws + WS_PROJ), (const bf16*)(ws + WS_ATTO), (const float*)(ws + WS_LSE), (const bf16*)(ws + WS_ODIR), (const float*)args.in[5] + (size_t)L * 512, (const float*)args.in[6] + (size_t)L * 512, (bf16*)(ws + WS_ABUF)); SEAM(pb + 2); }
    if (IN(pb + 3)) {
        pg8::Gemm g{(const bf16*)(ws + WS_ABUF), (const bf16*)(ws + WS_WOUT) + (size_t)L * DM * DM, MT, DM, DM}; pg8::StaticOrder S; S.init(MT, DM, F.G, (int)blockIdx.x);
        pg8::EpiRes E{L == 0 ? (const float*)args.in[0] : (const float*)xs, xs, (const float*)(ws + WS_ADA) + (size_t)(L * 2 + 0) * 8 * 3072, DN_ALPHA};
        pg8::gemm_phase<pg8::EpiRes, pg8::StaticOrder, PG8_ALIGN, PG8_SP2>(F.lds, g, S, E);
        SEAM(pb + 3);
    }
    const float* const ada1 = (const float*)(ws + WS_ADA) + (size_t)(L * 2 + 1) * 8 * 3072;
    const float* const lng = (const float*)args.in[10] + (size_t)L * 2 * DM; const float* const lnb = (const float*)args.in[11] + (size_t)L * 2 * DM;
    if constexpr (L == 0) {
        if (IN(pb + 4)) { ln_phase<0>(F, xs, lng, lnb, ada1, (bf16*)(ws + WS_ABUF), nullptr, nullptr); if (IN(pb + 6)) xcd_barrier(bar); }
        if (IN(pb + 6)) {
            pg8::Gemm g{(const bf16*)(ws + WS_ABUF), (const bf16*)(ws + WS_WGU), MT, 2 * FFDP, DM}; pg8::StaticOrder S; S.init(MT, 2 * FFDP, F.G, (int)blockIdx.x);
            pg8::EpiGU<FFDP, 22> E{(bf16*)(ws + WS_HID)};
            pg8::gemm_phase<pg8::EpiGU<FFDP, 22>, pg8::StaticOrder, PG8_ALIGN, PG8_SP2>(F.lds, g, S, E);
            SEAM(pb + 6);
        }
        if (IN(pb + 7)) {
            pg8::Gemm g{(const bf16*)(ws + WS_HID), (const bf16*)(ws + WS_WDN), MT, DM, FFDP}; pg8::StaticOrder S; S.init(MT, DM, F.G, (int)blockIdx.x);
            pg8::EpiRes E{(const float*)xs, xs, ada1, DN_ALPHA};
            pg8::gemm_phase<pg8::EpiRes, pg8::StaticOrder, PG8_ALIGN, PG8_SP2>(F.lds, g, S, E);
            SEAM(pb + 7);
        }
        if (IN(pb + 8)) { ln_phase<0>(F, xs, lng + DM, lnb + DM, (const float*)(ws + WS_ADA) + (size_t)2 * 8 * 3072, (bf16*)(ws + WS_ABUF), nullptr, nullptr); SEAM(pb + 8); }
    } else {
        unsigned* const route = (unsigned*)(ws + WS_ROUTE); unsigned* const rowinfo = (unsigned*)(ws + WS_ROWINFO);
        if (IN(pb + 4)) { ln_phase<1>(F, xs, lng, lnb, ada1, nullptr, (const float*)args.in[15], route); SEAM(pb + 4); }
        if (IN(pb + 5)) { gather_phase(F, xs, ada1, route, (bf16*)(ws + WS_GATH), rowinfo); SEAM(pb + 5); }
        if (IN(pb + 6)) {
            int off[9], cnt[8]; moe_offsets(F, off, cnt);
            const int nT = off[8] >> 8;
            pg8::Gemm g{(const bf16*)(ws + WS_GATH), (const bf16*)(ws + WS_WMGU), nT * 256, 2 * FFE, DM};
            pg8::MoeOrder S; S.init(nT * 256, 2 * FFE, F.G, (int)blockIdx.x);
            S.ts1 = off[1] >> 8; S.ts2 = off[2] >> 8; S.ts3 = off[3] >> 8; S.ts4 = off[4] >> 8; S.ts5 = off[5] >> 8; S.ts6 = off[6] >> 8; S.ts7 = off[7] >> 8; S.nNloc = 28;
            pg8::EpiGU<FFE, 28> E{(bf16*)(ws + WS_HID)};
            pg8::gemm_phase<pg8::EpiGU<FFE, 28>, pg8::MoeOrder, PG8_ALIGN, PG8_SP2>(F.lds, g, S, E);
            SEAM(pb + 6);
        }
        if (IN(pb + 7)) {
            int off[9], cnt[8]; moe_offsets(F, off, cnt);
            const int nT = off[8] >> 8;
            pg8::Gemm g{(const bf16*)(ws + WS_HID), (const bf16*)(ws + WS_WMDN), nT * 256, DM, FFE};
            pg8::MoeOrder S; S.init(nT * 256, DM, F.G, (int)blockIdx.x);
            S.ts1 = off[1] >> 8; S.ts2 = off[2] >> 8; S.ts3 = off[3] >> 8; S.ts4 = off[4] >> 8; S.ts5 = off[5] >> 8; S.ts6 = off[6] >> 8; S.ts7 = off[7] >> 8; S.nNloc = 4;
            pg8::EpiMoeDn E{rowinfo, (bf16*)(ws + WS_YSLOT)};
            pg8::gemm_phase<pg8::EpiMoeDn, pg8::MoeOrder, PG8_ALIGN, PG8_SP2>(F.lds, g, S, E);
            SEAM(pb + 7);
        }
        if (IN(pb + 8)) { final_phase(F, xs, (const bf16*)(ws + WS_YSLOT), ada1, lng + DM, lnb + DM); }
    }
}

__global__ void __launch_bounds__(NWAVES * 64, 2) fwd_kernel(Args args) {
    extern __shared__ __attribute__((aligned(16))) unsigned char lds[];
    Frame F;
    F.lds = (LAS unsigned char*)lds; F.ws = args.ws; F.ctl = (gu32*)(args.ws + WS_CTL);
    F.tid = threadIdx.x; F.lane = F.tid & 63; F.wave = __builtin_amdgcn_readfirstlane(F.tid >> 6);
    F.G = gridDim.x; { const int bx = blockIdx.x; F.vcu = (F.G % 8 == 0) ? (bx % 8) * (F.G / 8) + bx / 8 : bx; }
    volatile LAS unsigned* MISC = (volatile LAS unsigned*)(F.lds + MISC_OFF);
    for (int u = F.tid; u < (LDS_BYTES - 131072) / 4; u += NWAVES * 64) ((LAS unsigned*)(F.lds + 131072))[u] = 0u;
    __syncthreads();
    XcdBarrier bar; bar.bar = (unsigned*)(F.ctl + CW_BAR); bar.x = 0; bar.st = nullptr;
    const int lo = args.ph_lo, hi = args.ph_hi;
    if (hi - lo > 1) bar = xcd_barrier_post((unsigned*)(F.ctl + CW_BAR), MISC + 8);
    if (IN(0)) { p0_prologue(F, args); SEAM(0); }
    if (IN(1)) { p1_mod0(F, (const float*)args.in[0], (const float*)(args.ws + WS_ADA), (bf16*)(args.ws + WS_ABUF)); SEAM(1); }
    layer_phases<0>(F, args, bar, lo, hi);
    layer_phases<1>(F, args, bar, lo, hi);
}
#undef IN
#undef SEAM

extern "C" void kernel_launch(void* const* d_in, const int* in_sizes, int n_in, void* d_out, int out_size, void* d_ws, size_t ws_size, hipStream_t stream) {
    static int grid = 0;
    if (grid == 0) {
        int dev = 0, cus = 0, per_cu = 0;
        if (n_in != 19 || ws_size < WS_END) { fprintf(stderr, "kernel_launch: unexpected n_in %d / ws_size %zu\n", n_in, ws_size); }
        if (hipGetDevice(&dev) != hipSuccess || hipDeviceGetAttribute(&cus, hipDeviceAttributeMultiprocessorCount, dev) != hipSuccess) { grid = -1; return; }
        if (hipFuncSetAttribute((const void*)fwd_kernel, hipFuncAttributeMaxDynamicSharedMemorySize, LDS_BYTES) != hipSuccess) { grid = -1; return; }
        if (hipOccupancyMaxActiveBlocksPerMultiprocessor(&per_cu, (const void*)fwd_kernel, NWAVES * 64, LDS_BYTES) != hipSuccess || per_cu < 1) fprintf(stderr, "kernel_launch: occupancy query says %d\n", per_cu);
        (void)hipGetLastError();
        grid = cus;
    }
    if (grid < 0) return;
    (void)hipMemsetAsync((char*)d_ws + WS_CTL, 0, CTL_ZERO_BYTES, stream);
    Args a{};
    for (int i = 0; i < 19; ++i) a.in[i] = d_in[i];
    a.out = (float*)d_out; a.ws = (unsigned char*)d_ws;
#if MK_N_LAUNCHES == 1
    a.ph_lo = 0; a.ph_hi = NPH;
    hipLaunchKernelGGL(fwd_kernel, dim3(grid), dim3(NWAVES * 64), LDS_BYTES, stream, a);
#else
    for (int p = 0; p < NPH; ++p) {
        if (p == 2 + 5) continue;
        a.ph_lo = p; a.ph_hi = p + 1;
        hipLaunchKernelGGL(fwd_kernel, dim3(grid), dim3(NWAVES * 64), LDS_BYTES, stream, a);
    }
#endif
}
```

```cpp
#include <hip/hip_runtime.h>
#include <cstdio>
#include <cstdint>
#include <cmath>
#define MK_N_LAUNCHES 1
namespace pg8 {
#define PG8_LAS __attribute__((address_space(3)))
typedef unsigned short bf16_t;
typedef short bf16x8 __attribute__((ext_vector_type(8)));
typedef float f32x4 __attribute__((ext_vector_type(4)));
typedef unsigned u32x4 __attribute__((ext_vector_type(4)));
constexpr int BM = 256, BK = 64, HALF = 128, HTB = HALF * BK * 2  , STAGE_BYTES = 8 * HTB, NXCD = 8, WGM = 8;

__host__ __device__ __forceinline__ int lds_byte(int r, int c) { const int st = (r >> 4) * 2 + (c >> 5), rr = r & 15, cc = c & 31, ob = rr * 64 + cc * 2; return st * 1024 + (ob ^ (((ob >> 9) & 1) << 5)); }
__host__ __device__ __forceinline__ void stage_rc(int b, int& R, int& C) { const int st = b / 1024, sb = b % 1024, swz = sb ^ (((sb >> 9) & 1) << 5); R = (st >> 1) * 16 + swz / 64; C = (st & 1) * 32 + (swz % 64) / 2; }
__host__ __device__ __forceinline__ int perm32(int rho) { const int n = rho >> 4, i = rho & 15; return 8 * (i >> 2) + 4 * n + (i & 3); }

struct Unit { int pm, pn; };
struct Gemm { const bf16_t* A; const bf16_t* Bt; int M, N, K; };

struct StaticOrder {
    int nM, nN, nwg, G, c;
    __host__ __device__ void init(int M, int N, int G_, int c_) { nM = M / BM; nN = N / BM; nwg = nM * nN; G = G_; c = c_; }
    __host__ __device__ bool next(int i, Unit& u) const {
        const long L = (long)i * G + c; if (L >= nwg) return false;
        int wgid = (int)L; { const int q = nwg / NXCD, r = nwg % NXCD, xcd = wgid % NXCD, off = wgid / NXCD; wgid = (xcd < r ? xcd * (q + 1) : r * (q + 1) + (xcd - r) * q) + off; }
        const int nig = WGM * nN, gid = wgid / nig, fm = gid * WGM, gsz = (nM - fm) < WGM ? (nM - fm) : WGM;
        u.pm = fm + ((wgid % nig) % gsz); u.pn = (wgid % nig) / gsz; return true;
    }
    __device__ __forceinline__ void a_ready(const Unit&) const {}
    __device__ __forceinline__ void done(const Unit&) const {}
};
__device__ __forceinline__ unsigned cvt_pk_bf16(float lo, float hi) { unsigned r; asm volatile("v_cvt_pk_bf16_f32 %0, %1, %2" : "=v"(r) : "v"(lo), "v"(hi)); return r; }

typedef float f32x2 __attribute__((ext_vector_type(2)));
typedef unsigned u32x2 __attribute__((ext_vector_type(2)));
__device__ __forceinline__ float fast_sigmoid(float x) { return __builtin_amdgcn_rcpf(1.0f + __expf(-x)); }
__device__ __forceinline__ float fast_silu(float x) { return x * fast_sigmoid(x); }

struct EpiIn {
    static constexpr bool PERM = false, AFTER_DRAIN = false;
    bf16_t* proj; const float* rope; const float* lb;
    __device__ __forceinline__ void operator()(const f32x4 (&acc)[2][2][4][2], const Unit& u, int wr, int wc, int fr, int fq) const {
        const int row0 = u.pm * BM + wr * 64 + fr;
        const int type = u.pn >> 1;
        if (type < 2) {
            const float sc = (type == 0) ? 0.125f : 1.0f;
            const int g = wc & 1;
#pragma unroll
            for (int ai = 0; ai < 2; ++ai)
#pragma unroll
                for (int m = 0; m < 4; ++m) {
                    const int row = row0 + ai * HALF + m * 16;
                    const f32x4* rp = (const f32x4*)(rope + ((size_t)row * 32 + 16 * g + 4 * fq) * 2);
                    const f32x4 cs0 = rp[0], cs1 = rp[1];
                    const float cc[4] = {cs0[0], cs0[2], cs1[0], cs1[2]}, ss[4] = {cs0[1], cs0[3], cs1[1], cs1[3]};
#pragma unroll
                    for (int bj = 0; bj < 2; ++bj) {
                        const int col = u.pn * BM + (2 * bj + (wc >> 1)) * 64 + 16 * g + 4 * fq;
                        const f32x4 x1 = acc[ai][bj][m][0], x2 = acc[ai][bj][m][1];
                        float o1[4], o2[4];
#pragma unroll
                        for (int j = 0; j < 4; ++j) { o1[j] = (x1[j] * cc[j] - x2[j] * ss[j]) * sc; o2[j] = (x2[j] * cc[j] + x1[j] * ss[j]) * sc; }
                        u32x2 w1, w2; w1.x = cvt_pk_bf16(o1[0], o1[1]); w1.y = cvt_pk_bf16(o1[2], o1[3]); w2.x = cvt_pk_bf16(o2[0], o2[1]); w2.y = cvt_pk_bf16(o2[2], o2[3]);
                        bf16_t* dst = proj + (size_t)row * 4096 + col;
                        *(u32x2*)dst = w1; *(u32x2*)(dst + 32) = w2;
                    }
                }
        } else {
            const int lc0 = u.pn * BM + wc * 32 + 8 * fq;
            f32x4 lbv[2][2];
            if (type == 4 || type == 5) {
#pragma unroll
                for (int bj = 0; bj < 2; ++bj)
#pragma unroll
                    for (int n = 0; n < 2; ++n) lbv[bj][n] = *(const f32x4*)(lb + (lc0 + bj * HALF - 2048) + 4 * n);
            }
#pragma unroll
            for (int ai = 0; ai < 2; ++ai)
#pragma unroll
                for (int m = 0; m < 4; ++m) {
                    const int row = row0 + ai * HALF + m * 16;
#pragma unroll
                    for (int bj = 0; bj < 2; ++bj) {
                        f32x4 v0 = acc[ai][bj][m][0], v1 = acc[ai][bj][m][1];
                        if (type == 3) {
#pragma unroll
                            for (int j = 0; j < 4; ++j) { v0[j] = fast_silu(v0[j]); v1[j] = fast_silu(v1[j]); }
                        } else if (type == 7) {
#pragma unroll
                            for (int j = 0; j < 4; ++j) { v0[j] = fast_sigmoid(v0[j]); v1[j] = fast_sigmoid(v1[j]); }
                        } else if (type == 4 || type == 5) {
#pragma unroll
                            for (int j = 0; j < 4; ++j) {
                                const float l0 = lbv[bj][0][j], l1 = lbv[bj][1][j];
                                v0[j] = __logf(l0 + (1.0f - l0) * fast_sigmoid(v0[j]));
                                v1[j] = __logf(l1 + (1.0f - l1) * fast_sigmoid(v1[j]));
                            }
                        }
                        u32x4 w; w.x = cvt_pk_bf16(v0[0], v0[1]); w.y = cvt_pk_bf16(v0[2], v0[3]); w.z = cvt_pk_bf16(v1[0], v1[1]); w.w = cvt_pk_bf16(v1[2], v1[3]);
                        *(u32x4*)(proj + (size_t)row * 4096 + lc0 + bj * HALF) = w;
                    }
                }
        }
    }
};

struct EpiRes {
    static constexpr bool PERM = false, AFTER_DRAIN = false;
    const float* xres; float* t; const float* gate; float alpha;
    __device__ __forceinline__ void operator()(const f32x4 (&acc)[2][2][4][2], const Unit& u, int wr, int wc, int fr, int fq) const {
        const int row0 = u.pm * BM + wr * 64 + fr, col0 = u.pn * BM + wc * 32 + 4 * fq;
        const int b = u.pm >> 3;
        f32x4 gv[2][2];
#pragma unroll
        for (int bj = 0; bj < 2; ++bj)
#pragma unroll
            for (int n = 0; n < 2; ++n) gv[bj][n] = *(const f32x4*)(gate + (size_t)b * 3072 + 2048 + col0 + bj * HALF + n * 16) + 1.0f;
#pragma unroll
        for (int ai = 0; ai < 2; ++ai)
#pragma unroll
            for (int m = 0; m < 4; ++m) {
                const size_t off = (size_t)(row0 + ai * HALF + m * 16) * 1024 + col0;
#pragma unroll
                for (int bj = 0; bj < 2; ++bj)
#pragma unroll
                    for (int n = 0; n < 2; ++n) {
                        const f32x4 xr = *(const f32x4*)(xres + off + bj * HALF + n * 16);
                        *(f32x4*)(t + off + bj * HALF + n * 16) = xr * alpha + gv[bj][n] * acc[ai][bj][m][n];
                    }
            }
    }
};

template <int ldh, int nNloc> struct EpiGU {
    static constexpr bool PERM = false, AFTER_DRAIN = false;
    bf16_t* hid;
    __device__ __forceinline__ void operator()(const f32x4 (&acc)[2][2][4][2], const Unit& u, int wr, int wc, int fr, int fq) const {
        const int row0 = u.pm * BM + wr * 64 + fr, col0 = (u.pn % nNloc) * HALF + wc * 32 + 8 * fq;
#pragma unroll
        for (int ai = 0; ai < 2; ++ai)
#pragma unroll
            for (int m = 0; m < 4; ++m) {
                const f32x4 g0 = acc[ai][0][m][0], g1 = acc[ai][0][m][1], u0 = acc[ai][1][m][0], u1 = acc[ai][1][m][1];
                f32x4 h0, h1;
#pragma unroll
                for (int j = 0; j < 4; ++j) { h0[j] = fast_silu(g0[j]) * u0[j]; h1[j] = fast_silu(g1[j]) * u1[j]; }
                u32x4 w; w.x = cvt_pk_bf16(h0[0], h0[1]); w.y = cvt_pk_bf16(h0[2], h0[3]); w.z = cvt_pk_bf16(h1[0], h1[1]); w.w = cvt_pk_bf16(h1[2], h1[3]);
                *(u32x4*)(hid + (size_t)(row0 + ai * HALF + m * 16) * ldh + col0) = w;
            }
    }
};

struct EpiMoeDn {
    static constexpr bool PERM = false, AFTER_DRAIN = false;
    const unsigned* rowinfo; bf16_t* yslot;
    __device__ __forceinline__ void operator()(const f32x4 (&acc)[2][2][4][2], const Unit& u, int wr, int wc, int fr, int fq) const {
        const int row0 = u.pm * BM + wr * 64 + fr, col0 = (u.pn & 3) * BM + wc * 32 + 4 * fq;
#pragma unroll
        for (int ai = 0; ai < 2; ++ai)
#pragma unroll
            for (int m = 0; m < 4; ++m) {
                const int row = row0 + ai * HALF + m * 16;
                const u32x2 inf = *(const u32x2*)(rowinfo + 2 * (size_t)row);
                if (inf.x != 0xffffffffu) {
                    const float w = __uint_as_float(inf.y);
                    bf16_t* dst = yslot + ((size_t)(inf.x >> 16) * 16384 + (inf.x & 0xffffu)) * 1024 + col0;
#pragma unroll
                    for (int bj = 0; bj < 2; ++bj)
#pragma unroll
                        for (int n = 0; n < 2; ++n) {
                            const f32x4 v = acc[ai][bj][m][n] * w;
                            u32x2 o; o.x = cvt_pk_bf16(v[0], v[1]); o.y = cvt_pk_bf16(v[2], v[3]);
                            *(u32x2*)(dst + bj * HALF + n * 16) = o;
                        }
                }
            }
    }
};

struct MoeOrder : StaticOrder {
    int ts1, ts2, ts3, ts4, ts5, ts6, ts7, nNloc;
    __device__ __forceinline__ bool next(int i, Unit& u) const {
        if (!StaticOrder::next(i, u)) return false;
        const int e = (u.pm >= ts1) + (u.pm >= ts2) + (u.pm >= ts3) + (u.pm >= ts4) + (u.pm >= ts5) + (u.pm >= ts6) + (u.pm >= ts7);
        u.pn += e * nNloc; return true;
    }
};

template <class Epi, class Sched, bool ALIGN_EPI = false, bool SP2 = false>
__device__ __forceinline__ void gemm_phase(PG8_LAS unsigned char* lds, const Gemm g, const Sched& S, const Epi& E) {
    const int tid = threadIdx.x, wid = __builtin_amdgcn_readfirstlane(tid >> 6), lane = tid & 63, wr = wid >> 2, wc = wid & 3, fr = lane & 15, fq = lane >> 4;
    const int K = g.K, nt = K / BK;
    unsigned voffA[2], voffB[2];
#pragma unroll
    for (int i = 0; i < 2; ++i) { int R, C; stage_rc(tid * 16 + i * 8192, R, C); const int Rb = Epi::PERM ? ((R & ~31) + perm32(R & 31)) : R;
        voffA[i] = (unsigned)(R * K + C) * 2u; voffB[i] = (unsigned)(Rb * K + C) * 2u; }
    const size_t kstep = (size_t)(BK * 2);
    const size_t hstep = (size_t)HALF * K * 2;
    const size_t tstep = 2 * hstep;
    const unsigned ldsw = (unsigned)wid * 1024u;
    const int aoff = lds_byte(wr * 64 + fr, fq * 8), boff = lds_byte(wc * 32 + fr, fq * 8);
#define PG8_SA(b, h) (((b) * 2 + (h)) * HTB)
#define PG8_SB(b, h) ((4 + (b) * 2 + (h)) * HTB)
#define PG8_STAGE(bufoff, gbase, voff) do { _Pragma("unroll") for (int _i = 0; _i < 2; ++_i) \
        __builtin_amdgcn_global_load_lds((const unsigned*)((const char*)(gbase) + (voff)[_i]), (PG8_LAS unsigned*)(lds + (bufoff) + ldsw + _i * 8192), 16, 0, 0); } while (0)
#define PG8_LDA(dst, b, h) do { _Pragma("unroll") for (int m = 0; m < 4; ++m) _Pragma("unroll") for (int k = 0; k < 2; ++k) dst[m][k] = *(const PG8_LAS bf16x8*)(lds + PG8_SA(b, h) + aoff + m * 2048 + k * 1024); } while (0)
#define PG8_LDB(dst, b, h) do { _Pragma("unroll") for (int n = 0; n < 2; ++n) _Pragma("unroll") for (int k = 0; k < 2; ++k) dst[n][k] = *(const PG8_LAS bf16x8*)(lds + PG8_SB(b, h) + boff + n * 2048 + k * 1024); } while (0)
#define PG8_MMA(ai, bj, At, Bt) do { __builtin_amdgcn_s_setprio(1); _Pragma("unroll") for (int m = 0; m < 4; ++m) _Pragma("unroll") for (int n = 0; n < 2; ++n) _Pragma("unroll") for (int k = 0; k < 2; ++k) \
        acc[ai][bj][m][n] = __builtin_amdgcn_mfma_f32_16x16x32_bf16(Bt[n][k], At[m][k], acc[ai][bj][m][n], 0, 0, 0); __builtin_amdgcn_s_setprio(0); } while (0)
#define PG8_WAIT_V(n) asm volatile("s_waitcnt vmcnt(" #n ")" ::: "memory")
#define PG8_WAIT_L(n) asm volatile("s_waitcnt lgkmcnt(" #n ")" ::: "memory")
#define PG8_BAR __builtin_amdgcn_s_barrier()
#define PG8_SCHED __builtin_amdgcn_sched_barrier(0)
    Unit cur, nxt; int ui = 0;
    if (!S.next(0, cur)) return;
    f32x4 acc[2][2][4][2];
#pragma unroll
    for (int a = 0; a < 2; ++a)
#pragma unroll
        for (int b = 0; b < 2; ++b)
#pragma unroll
            for (int m = 0; m < 4; ++m)
#pragma unroll
                for (int n = 0; n < 2; ++n) acc[a][b][m][n] = (f32x4){0.f, 0.f, 0.f, 0.f};
    bf16x8 At[4][2], B0[2][2], B1[2][2];
    const char* cA = (const char*)g.A + (size_t)cur.pm * tstep; const char* cB = (const char*)g.Bt + (size_t)cur.pn * tstep;
    S.a_ready(cur);
    if constexpr (SP2) {
        PG8_STAGE(PG8_SB(0, 0), cB, voffB); PG8_STAGE(PG8_SB(0, 1), cB + hstep, voffB); PG8_STAGE(PG8_SA(0, 0), cA, voffA); PG8_STAGE(PG8_SA(0, 1), cA + hstep, voffA);
        if (wr == 1) PG8_BAR;
        PG8_WAIT_V(2); PG8_BAR;
        PG8_STAGE(PG8_SB(1, 0), cB + kstep, voffB); PG8_STAGE(PG8_SA(1, 0), cA + kstep, voffA); PG8_STAGE(PG8_SB(1, 1), cB + hstep + kstep, voffB);
        PG8_WAIT_V(6); PG8_BAR;
    } else {
        PG8_STAGE(PG8_SB(0, 0), cB, voffB); PG8_STAGE(PG8_SA(0, 0), cA, voffA); PG8_STAGE(PG8_SB(0, 1), cB + hstep, voffB); PG8_STAGE(PG8_SA(0, 1), cA + hstep, voffA);
        if (wr == 1) PG8_BAR;
        PG8_WAIT_V(4); PG8_BAR;
        PG8_STAGE(PG8_SB(1, 0), cB + kstep, voffB); PG8_STAGE(PG8_SA(1, 0), cA + kstep, voffA); PG8_STAGE(PG8_SB(1, 1), cB + hstep + kstep, voffB);
        PG8_WAIT_V(6); PG8_BAR;
    }
    for (;;) {
        const bool has_next = S.next(ui + 1, nxt);
        const char* nA = has_next ? (const char*)g.A + (size_t)nxt.pm * tstep : cA; const char* nB = has_next ? (const char*)g.Bt + (size_t)nxt.pn * tstep : cB;
        for (int t = 0; t < nt; t += 2) {
            const bool last = (t == nt - 2);
            const char* a1 = cA + (size_t)(t + 1) * kstep;
            const char* a2 = last ? nA : cA + (size_t)(t + 2) * kstep; const char* b2 = last ? nB : cB + (size_t)(t + 2) * kstep;
            const char* a3 = a2 + kstep; const char* b3 = b2 + kstep;
            if (last && has_next) S.a_ready(nxt);
            if constexpr (SP2) {
            PG8_LDB(B0, 0, 0); PG8_LDB(B1, 0, 1); PG8_SCHED; PG8_LDA(At, 0, 0); PG8_STAGE(PG8_SA(1, 1), a1 + hstep, voffA);
            PG8_WAIT_V(8); PG8_WAIT_L(0); PG8_BAR; PG8_MMA(0, 0, At, B0); PG8_MMA(0, 1, At, B1); PG8_BAR; PG8_SCHED;
            PG8_LDA(At, 0, 1); PG8_STAGE(PG8_SB(0, 0), b2, voffB); PG8_STAGE(PG8_SB(0, 1), b2 + hstep, voffB); PG8_STAGE(PG8_SA(0, 0), a2, voffA);
            PG8_WAIT_V(8); PG8_WAIT_L(0); PG8_BAR; PG8_MMA(1, 0, At, B0); PG8_MMA(1, 1, At, B1); PG8_BAR; PG8_SCHED;
            PG8_LDB(B0, 1, 0); PG8_LDB(B1, 1, 1); PG8_SCHED; PG8_LDA(At, 1, 0); PG8_STAGE(PG8_SA(0, 1), a2 + hstep, voffA);
            PG8_WAIT_V(8); PG8_WAIT_L(0); PG8_BAR; PG8_MMA(0, 0, At, B0); PG8_MMA(0, 1, At, B1); PG8_BAR; PG8_SCHED;
            PG8_LDA(At, 1, 1); PG8_STAGE(PG8_SB(1, 0), b3, voffB); PG8_STAGE(PG8_SB(1, 1), b3 + hstep, voffB); PG8_STAGE(PG8_SA(1, 0), a3, voffA);
            PG8_WAIT_V(8); PG8_WAIT_L(0); PG8_BAR; PG8_MMA(1, 0, At, B0); PG8_MMA(1, 1, At, B1); PG8_BAR; PG8_SCHED;
            } else {
            PG8_LDB(B0, 0, 0); PG8_SCHED; PG8_LDA(At, 0, 0); PG8_STAGE(PG8_SA(1, 1), a1 + hstep, voffA);
            PG8_WAIT_L(8); PG8_BAR; PG8_WAIT_L(0); PG8_MMA(0, 0, At, B0); PG8_BAR; PG8_SCHED;
            PG8_LDB(B1, 0, 1); PG8_STAGE(PG8_SB(0, 0), b2, voffB);
            PG8_BAR; PG8_WAIT_L(0); PG8_MMA(0, 1, At, B1); PG8_BAR;
            PG8_LDA(At, 0, 1); PG8_STAGE(PG8_SA(0, 0), a2, voffA);
            PG8_BAR; PG8_WAIT_L(0); PG8_MMA(1, 0, At, B0); PG8_BAR; PG8_SCHED;
            PG8_STAGE(PG8_SB(0, 1), b2 + hstep, voffB);
            PG8_WAIT_V(6); PG8_BAR; PG8_MMA(1, 1, At, B1); PG8_BAR;
            PG8_LDB(B0, 1, 0); PG8_SCHED; PG8_LDA(At, 1, 0); PG8_STAGE(PG8_SA(0, 1), a2 + hstep, voffA);
            PG8_WAIT_L(8); PG8_BAR; PG8_WAIT_L(0); PG8_MMA(0, 0, At, B0); PG8_BAR; PG8_SCHED;
            PG8_LDB(B1, 1, 1); PG8_STAGE(PG8_SB(1, 0), b3, voffB);
            PG8_BAR; PG8_WAIT_L(0); PG8_MMA(0, 1, At, B1); PG8_BAR;
            PG8_LDA(At, 1, 1); PG8_STAGE(PG8_SA(1, 0), a3, voffA);
            PG8_BAR; PG8_WAIT_L(0); PG8_MMA(1, 0, At, B0); PG8_BAR; PG8_SCHED;
            PG8_STAGE(PG8_SB(1, 1), b3 + hstep, voffB);
            PG8_WAIT_V(6); PG8_BAR; PG8_MMA(1, 1, At, B1); PG8_BAR;
            }
        }
        if constexpr (ALIGN_EPI) { if (wr == 0) PG8_BAR; }
        if constexpr (!Epi::AFTER_DRAIN) { E(acc, cur, wr, wc, fr, fq); S.done(cur); }
        if (!has_next) break;
#pragma unroll
        for (int a = 0; a < 2; ++a)
#pragma unroll
            for (int b = 0; b < 2; ++b)
#pragma unroll
                for (int m = 0; m < 4; ++m)
#pragma unroll
                    for (int n = 0; n < 2; ++n) acc[a][b][m][n] = (f32x4){0.f, 0.f, 0.f, 0.f};
        cur = nxt; cA = nA; cB = nB; ++ui;
        if constexpr (ALIGN_EPI) { if (wr == 1) PG8_BAR; }
    }
    PG8_WAIT_V(0);
    if constexpr (!ALIGN_EPI) { if (wr == 0) PG8_BAR; }
    PG8_BAR;
    if constexpr (Epi::AFTER_DRAIN) { E.fused(acc, cur, wr, wc, fr, fq, lds, wid, lane); S.done(cur); }
#undef PG8_SA
#undef PG8_SB
#undef PG8_STAGE
#undef PG8_LDA
#undef PG8_LDB
#undef PG8_MMA
#undef PG8_WAIT_V
#undef PG8_WAIT_L
#undef PG8_BAR
#undef PG8_SCHED
}
}


#ifndef PG8_SP2
#define PG8_SP2 true
#endif
#ifndef PG8_ALIGN
#define PG8_ALIGN true
#endif
#ifndef MK_N_LAUNCHES
#define MK_N_LAUNCHES 1
#endif

constexpr int NB = 8, SEQ = 2048, DM = 1024, MT = NB * SEQ;
constexpr int INC = 4096, NAH = 8;
constexpr int FFD = 2752, FFDP = 2816, NEX = 8, FFE = 3584;
constexpr int MOE_ROWS = 2 * MT + NEX * 256;
constexpr float DN_ALPHA = 1.41421356237309515f;
constexpr float LN_EPS = 1e-5f, RMS_EPS = 1e-6f;
constexpr int NWAVES = 8;

constexpr size_t MiB = 1u << 20;
constexpr size_t WS_CTL = 0, CTL_ZERO_BYTES = 1 * MiB;
constexpr size_t WS_ADA = 1 * MiB;
constexpr size_t WS_LB = 1 * MiB + 512 * 1024;
constexpr size_t WS_ROPE = 2 * MiB;
constexpr size_t WS_ROUTE = 6 * MiB;
constexpr size_t WS_ROWINFO = 6 * MiB + 512 * 1024;
constexpr size_t WS_WMGU = 8 * MiB;
constexpr size_t WS_WMDN = 120 * MiB;
constexpr size_t WS_WIN = 176 * MiB;
constexpr size_t WS_WOUT = 192 * MiB;
constexpr size_t WS_WGU = 196 * MiB;
constexpr size_t WS_WDN = 207 * MiB;
constexpr size_t WS_ABUF = 213 * MiB;
constexpr size_t WS_GATH = 176 * MiB;
constexpr size_t WS_YSLOT = 176 * MiB;
constexpr size_t WS_BIG = 245 * MiB;
constexpr size_t WS_PROJ = WS_BIG;
constexpr size_t WS_ATTO = WS_BIG + 128 * MiB;
constexpr size_t WS_LSE = WS_BIG + 176 * MiB;
constexpr size_t WS_ODIR = WS_BIG + 178 * MiB;
constexpr size_t WS_HID = WS_BIG;
constexpr size_t WS_END = 483 * MiB;
static_assert(WS_GATH + (size_t)MOE_ROWS * 1024 * 2 <= WS_BIG && WS_HID + (size_t)MOE_ROWS * FFE * 2 <= WS_END && WS_WDN + (size_t)1024 * FFDP * 2 <= WS_ABUF, "d_ws map");
constexpr int CW_TMO = 0, CW_BAR = 4096, CW_CNT = 16384;

constexpr int LDS_BYTES = 147456;
constexpr int MISC_OFF = 131072 + 320;

#define GAS __attribute__((address_space(1)))
#define LAS __attribute__((address_space(3)))
typedef unsigned short bf16;
typedef unsigned v4u __attribute__((ext_vector_type(4)));
typedef unsigned v2u __attribute__((ext_vector_type(2)));
typedef float f32x4 __attribute__((ext_vector_type(4)));
typedef GAS unsigned gu32;
#define RLX_AGENT __ATOMIC_RELAXED, __HIP_MEMORY_SCOPE_AGENT
#define LDS_WAIT() asm volatile("s_waitcnt lgkmcnt(0)" ::: "memory")
__device__ __forceinline__ unsigned f2bf(float f) { unsigned u = __builtin_bit_cast(unsigned, f); return (u + 0x7fffu + ((u >> 16) & 1u)) >> 16; }
__device__ __forceinline__ unsigned pk2(float lo, float hi) { return f2bf(lo) | (f2bf(hi) << 16); }
__device__ __forceinline__ float bflo(unsigned w) { return __uint_as_float(w << 16); }
__device__ __forceinline__ float bfhi(unsigned w) { return __uint_as_float(w & 0xffff0000u); }
__device__ __forceinline__ float bf1(bf16 h) { return __uint_as_float(((unsigned)h) << 16); }

#define XB_TMO      128
#define XB_XCNT(j)  (256  + 64 * (j))
#define XB_XSUB(j)  (1280 + 64 * (j))
#define XB_XGEN(j)  (2304 + 64 * (j))
#define XB_TOP      3328
#define XB_TOPGEN   3392
#define XCD_BAR_WORDS 3456
#define XB_SPIN_CAP (1u << 18)

__device__ __forceinline__ unsigned xb_ld(unsigned* p)              { return __hip_atomic_load(p, __ATOMIC_RELAXED, __HIP_MEMORY_SCOPE_AGENT); }
__device__ __forceinline__ unsigned xb_add(unsigned* p, unsigned v) { return __hip_atomic_fetch_add(p, v, __ATOMIC_RELAXED, __HIP_MEMORY_SCOPE_AGENT); }
__device__ __forceinline__ unsigned xb_xcc_id() { return (unsigned)__builtin_amdgcn_s_getreg((3 << 11) | 20) & 0xFu; }
#define XB_SPIN(cond, bar) do { unsigned _sp = 0; while (cond) { __builtin_amdgcn_s_sleep(1); \
    if ((++_sp & 255u) == 0u) { if (xb_ld(&(bar)[XB_TMO])) break; if (_sp > XB_SPIN_CAP) { atomicAdd(&(bar)[XB_TMO], 1u); break; } } } } while (0)

struct XcdBarrier {
    unsigned* bar; unsigned x;
    volatile LAS unsigned* st;
};

__device__ __forceinline__ XcdBarrier xcd_barrier_post(unsigned* bar, volatile LAS unsigned* st) {
    XcdBarrier b; b.bar = bar; b.x = xb_xcc_id(); b.st = st;
    if (threadIdx.x == 0) (void)xb_add(&bar[XB_XCNT(b.x)], 1u);
    return b;
}
__device__ __forceinline__ void xcd_barrier_complete(unsigned* bar, unsigned x, unsigned& nloc, unsigned& nx) {
    const unsigned G = gridDim.x * gridDim.y * gridDim.z;
    unsigned sum, cnt, mine, sp = 0u;
    for (;;) {
        sum = 0u; cnt = 0u; mine = 0u;
#pragma unroll
        for (unsigned j = 0; j < 16; ++j) { const unsigned c = xb_ld(&bar[XB_XCNT(j)]); sum += c; cnt += (c > 0u) ? 1u : 0u; mine = (j == x) ? c : mine; }
        if (sum == G) break;
        __builtin_amdgcn_s_sleep(1);
        if ((++sp & 255u) == 0u) { if (xb_ld(&bar[XB_TMO])) break; if (sp > XB_SPIN_CAP) { atomicAdd(&bar[XB_TMO], 1u); break; } }
    }
    nloc = mine > 0u ? mine : 1u; nx = cnt > 0u ? cnt : 1u;
}

__device__ __forceinline__ void xcd_barrier(const XcdBarrier& b) {
    asm volatile("s_waitcnt vmcnt(0)" ::: "memory");
    __syncthreads();
    if (threadIdx.x == 0) {
        unsigned* bar = b.bar;
        __builtin_amdgcn_s_waitcnt(0);
        unsigned nloc = b.st[0], nx = b.st[1];
        if (nloc == 0u) { xcd_barrier_complete(bar, b.x, nloc, nx); b.st[0] = nloc; b.st[1] = nx; }
        const unsigned old = xb_add(&bar[XB_XSUB(b.x)], 1u);
        const unsigned gen = old / nloc;
        if (old + 1u == (gen + 1u) * nloc) {
            __builtin_amdgcn_fence(__ATOMIC_RELEASE, "agent");
            asm volatile("s_waitcnt vmcnt(0)" ::: "memory");
            const unsigned og = xb_add(&bar[XB_TOP], 1u);
            const unsigned tg = og / nx;
            if (og + 1u == (tg + 1u) * nx) xb_add(&bar[XB_TOPGEN], 1u);
            else XB_SPIN(xb_ld(&bar[XB_TOPGEN]) == tg, bar);
            __builtin_amdgcn_fence(__ATOMIC_ACQUIRE, "agent");
            xb_add(&bar[XB_XGEN(b.x)], 1u);
            asm volatile("s_waitcnt vmcnt(0)" ::: "memory");
        } else {
            XB_SPIN(xb_ld(&bar[XB_XGEN(b.x)]) == gen, bar);
            __builtin_amdgcn_fence(__ATOMIC_ACQUIRE, "agent");
            asm volatile("s_waitcnt vmcnt(0)" ::: "memory");
        }
    }
    __syncthreads();
}


struct Args { const void* in[19]; float* out; unsigned char* ws; int ph_lo, ph_hi; };

struct Frame {
    LAS unsigned char* lds; unsigned char* ws; gu32* ctl;
    int tid, lane, wave, G, vcu;
};

__device__ __forceinline__ float wave_sum(float v) {
#pragma unroll
    for (int o = 1; o < 64; o <<= 1) v += __shfl_xor(v, o);
    return v;
}

template <int KIND>
__device__ __forceinline__ void p0_tile(const float* W, int ldn, int k0, int n0, bool zero, bf16* dst, int ldk, int sel, LAS float* scr, int lane) {
    if (!zero) {
#pragma unroll 8
        for (int i = 0; i < 32; ++i) { const int kk = 2 * i + (lane >> 5); scr[kk * 33 + (lane & 31)] = W[(size_t)(k0 + kk) * ldn + n0 + (lane & 31)]; }
    }
    LDS_WAIT(); asm volatile("" ::: "memory");
    const int c = lane & 7;
#pragma unroll
    for (int j = 0; j < 4; ++j) {
        const int n = (lane >> 3) + 8 * j, lc = n0 + n; int prow;
        if (KIND == 0) {
            if (lc < 1024) { const int d = lc & 63; prow = (lc & ~63) + 32 * ((d >> 4) & 1) + 16 * (d >> 5) + (d & 15); }
            else { const int x = lc & 31; prow = (lc & ~31) + 16 * ((x >> 2) & 1) + 4 * (x >> 3) + (x & 3); }
        } else if (KIND == 1) prow = lc;
        else { const int x = lc & 31; prow = 256 * (lc >> 7) + 128 * sel + 32 * ((lc >> 5) & 3) + 16 * ((x >> 2) & 1) + 4 * (x >> 3) + (x & 3); }
        v4u o;
        if (zero) { o = (v4u){0u, 0u, 0u, 0u}; }
        else { const LAS float* s = scr + (8 * c) * 33 + n;
            o.x = pk2(s[0 * 33], s[1 * 33]); o.y = pk2(s[2 * 33], s[3 * 33]); o.z = pk2(s[4 * 33], s[5 * 33]); o.w = pk2(s[6 * 33], s[7 * 33]); }
        *(v4u*)(dst + (size_t)prow * ldk + k0 + 8 * c) = o;
    }
    LDS_WAIT(); asm volatile("" ::: "memory");
}

__device__ __forceinline__ void p0_prologue(Frame& F, const Args& a) {
    const float* c_in = (const float*)a.in[1]; const int* positions = (const int*)a.in[2];
    const float* w_in = (const float*)a.in[3]; const float* w_out = (const float*)a.in[4];
    const float* lb_logits = (const float*)a.in[7]; const float* ada_w = (const float*)a.in[8]; const float* ada_b = (const float*)a.in[9];
    const float* ffn_g = (const float*)a.in[12]; const float* ffn_u = (const float*)a.in[13]; const float* ffn_d = (const float*)a.in[14];
    const float* moe_g = (const float*)a.in[16]; const float* moe_u = (const float*)a.in[17]; const float* moe_d = (const float*)a.in[18];
    float* ada = (float*)(F.ws + WS_ADA); float* lbt = (float*)(F.ws + WS_LB); float* rope = (float*)(F.ws + WS_ROPE);
    if (F.vcu < 24) {
        LAS float* cact = (LAS float*)F.lds;
        for (int i = F.tid; i < NB * DM; i += 512) { const float v = c_in[i]; cact[i] = v / (1.0f + __expf(-v)); }
        __syncthreads();
        const int ls = F.vcu / 6, n = (F.vcu % 6) * 512 + F.tid;
        const float* w = ada_w + (size_t)ls * DM * 3072 + n;
        float acc[8];
#pragma unroll
        for (int b = 0; b < 8; ++b) acc[b] = 0.f;
#pragma unroll 4
        for (int k = 0; k < DM; ++k) { const float wv = w[(size_t)k * 3072];
#pragma unroll
            for (int b = 0; b < 8; ++b) acc[b] += cact[b * DM + k] * wv; }
        const float bias = ada_b[ls * 3072 + n];
#pragma unroll
        for (int b = 0; b < 8; ++b) ada[(size_t)(ls * 8 + b) * 3072 + n] = acc[b] + bias;
        __syncthreads();
    }
    const int gt = F.vcu * 512 + F.tid, GT = F.G * 512;
    for (int i = gt; i < MT * 32; i += GT) {
        const int m = i >> 5, d = i & 31;
        const float ang = (float)positions[m] * exp2f(-(float)d * 0.41524101186092029f);
        const double rev = (double)ang * 0.15915494309189533577;
        const float fr = (float)(rev - __builtin_rint(rev));
        rope[2 * (size_t)i] = __builtin_amdgcn_cosf(fr); rope[2 * (size_t)i + 1] = __builtin_amdgcn_sinf(fr);
    }
    for (int i = gt; i < 2 * 512; i += GT) {
        const float a0 = lb_logits[i], a1 = lb_logits[1024 + i];
        lbt[i] = 0.f; lbt[1024 + i] = 1.0f / (1.0f + __expf(a0 - a1));
    }
    LAS float* scr = (LAS float*)(F.lds + 32768 + F.wave * 8704);
    const int gw = F.vcu * NWAVES + F.wave, NGW = F.G * NWAVES;
    constexpr int I0 = 2 * 16 * 128, I1 = 2 * 16 * 32, I2 = 2 * 16 * 88, I3 = 44 * 32, I4 = 8 * 2 * 16 * 112, I5 = 8 * 56 * 32;
    constexpr int NITEMS = I0 + I1 + I2 + I3 + I4 + I5;
    for (int it = gw; it < NITEMS; it += NGW) {
        int r = it;
        if (r < I0) { const int l = r / 2048, q = r % 2048, kb = q / 128, nb = q % 128;
            p0_tile<0>(w_in + (size_t)l * DM * INC, INC, 64 * kb, 32 * nb, false, (bf16*)(F.ws + WS_WIN) + (size_t)l * INC * DM, DM, 0, scr, F.lane); continue; } r -= I0;
        if (r < I1) { const int l = r / 512, q = r % 512, kb = q / 32, nb = q % 32;
            p0_tile<1>(w_out + (size_t)l * DM * DM, DM, 64 * kb, 32 * nb, false, (bf16*)(F.ws + WS_WOUT) + (size_t)l * DM * DM, DM, 0, scr, F.lane); continue; } r -= I1;
        if (r < I2) { const int sel = r / 1408, q = r % 1408, kb = q / 88, nb = q % 88;
            p0_tile<2>(sel ? ffn_u : ffn_g, FFD, 64 * kb, 32 * nb, nb >= 86, (bf16*)(F.ws + WS_WGU), DM, sel, scr, F.lane); continue; } r -= I2;
        if (r < I3) { const int kb = r / 32, nb = r % 32;
            p0_tile<1>(ffn_d, DM, 64 * kb, 32 * nb, kb >= 43, (bf16*)(F.ws + WS_WDN), FFDP, 0, scr, F.lane); continue; } r -= I3;
        if (r < I4) { const int e = r / 3584, q0 = r % 3584, sel = q0 / 1792, q = q0 % 1792, kb = q / 112, nb = q % 112;
            p0_tile<2>((sel ? moe_u : moe_g) + (size_t)e * DM * FFE, FFE, 64 * kb, 32 * nb, false, (bf16*)(F.ws + WS_WMGU) + (size_t)e * 2 * FFE * DM, DM, sel, scr, F.lane); continue; } r -= I4;
        { const int e = r / 1792, q = r % 1792, kb = q / 32, nb = q % 32;
            p0_tile<1>(moe_d + (size_t)e * FFE * DM, DM, 64 * kb, 32 * nb, false, (bf16*)(F.ws + WS_WMDN) + (size_t)e * DM * FFE, FFE, 0, scr, F.lane); }
    }
}

__device__ __forceinline__ void p1_mod0(Frame& F, const float* x, const float* adar  , bf16* abuf) {
    const int gw = F.vcu * NWAVES + F.wave, NGW = F.G * NWAVES;
    for (int m = gw; m < MT; m += NGW) {
        const int b = m >> 11; const float* ar = adar + (size_t)b * 3072;
        const f32x4* xr = (const f32x4*)(x + (size_t)m * DM) + F.lane;
        unsigned long long* o8 = (unsigned long long*)(abuf + (size_t)m * DM) + F.lane;
#pragma unroll
        for (int j = 0; j < 4; ++j) {
            const f32x4 v = xr[64 * j]; const int col = 4 * F.lane + 256 * j;
            const f32x4 sh = *(const f32x4*)(ar + col), sc = *(const f32x4*)(ar + 1024 + col);
            const f32x4 u = v * (sc + 1.0f) + sh;
            o8[64 * j] = (unsigned long long)pk2(u[0], u[1]) | ((unsigned long long)pk2(u[2], u[3]) << 32);
        }
    }
}

__device__ __forceinline__ void attn_simple(Frame& F, const bf16* proj, bf16* atto) {
    for (int gid = F.vcu * 512 + F.tid; gid < NB * NAH * SEQ; gid += F.G * 512) {
        const int i = gid & (SEQ - 1), h = (gid >> 11) & 7, b = gid >> 14;
        const size_t rowb = (size_t)b * SEQ;
        float q[64], o[64];
        { const v4u* qp = (const v4u*)(proj + (rowb + i) * INC + h * 64);
#pragma unroll
          for (int c = 0; c < 8; ++c) { const v4u w = qp[c]; q[8 * c] = bflo(w.x); q[8 * c + 1] = bfhi(w.x); q[8 * c + 2] = bflo(w.y); q[8 * c + 3] = bfhi(w.y); q[8 * c + 4] = bflo(w.z); q[8 * c + 5] = bfhi(w.z); q[8 * c + 6] = bflo(w.w); q[8 * c + 7] = bfhi(w.w); } }
#pragma unroll
        for (int d = 0; d < 64; ++d) o[d] = 0.f;
        float mx = -1e30f, l = 0.f;
        for (int p = 0; p < 3; ++p) {
            const int dl = (p == 0) ? 1 : (p == 1 ? 4 : 16);
            for (int j = -64; j <= 64; ++j) {
                const int pos = i + dl * j;
                if (pos < 0 || pos >= SEQ) continue;
                const v4u* kp = (const v4u*)(proj + (rowb + pos) * INC + 512 + h * 64);
                float s = 0.f;
#pragma unroll
                for (int c = 0; c < 8; ++c) { const v4u w = kp[c];
                    s += q[8 * c] * bflo(w.x) + q[8 * c + 1] * bfhi(w.x) + q[8 * c + 2] * bflo(w.y) + q[8 * c + 3] * bfhi(w.y) + q[8 * c + 4] * bflo(w.z) + q[8 * c + 5] * bfhi(w.z) + q[8 * c + 6] * bflo(w.w) + q[8 * c + 7] * bfhi(w.w); }
                if (s > mx) { const float r = __expf(mx - s); l *= r;
#pragma unroll
                    for (int d = 0; d < 64; ++d) o[d] *= r;
                    mx = s; }
                const float pe = __expf(s - mx); l += pe;
                const v4u* vp = (const v4u*)(proj + (rowb + pos) * INC + 1024 + h * 64);
#pragma unroll
                for (int c = 0; c < 8; ++c) { const v4u w = vp[c];
                    o[8 * c] += pe * bflo(w.x); o[8 * c + 1] += pe * bfhi(w.x); o[8 * c + 2] += pe * bflo(w.y); o[8 * c + 3] += pe * bfhi(w.y); o[8 * c + 4] += pe * bflo(w.z); o[8 * c + 5] += pe * bfhi(w.z); o[8 * c + 6] += pe * bflo(w.w); o[8 * c + 7] += pe * bfhi(w.w); }
            }
        }
        const float inv = 1.0f / l;
        v4u* op = (v4u*)(atto + (rowb + i) * 512 + h * 64);
#pragma unroll
        for (int c = 0; c < 8; ++c) { v4u w; w.x = pk2(o[8 * c] * inv, o[8 * c + 1] * inv); w.y = pk2(o[8 * c + 2] * inv, o[8 * c + 3] * inv); w.z = pk2(o[8 * c + 4] * inv, o[8 * c + 5] * inv); w.w = pk2(o[8 * c + 6] * inv, o[8 * c + 7] * inv); op[c] = w; }
    }
}

__device__ __forceinline__ void gla_simple(Frame& F, const bf16* proj, bf16* odir) {
    LAS float* red = (LAS float*)F.lds;
    const int sub = F.tid >> 7, c = F.tid & 127, wsub = (F.tid >> 6) & 1;
    for (int ug = F.vcu; ug < 256; ug += F.G) {
        const int unit = ug * 4 + sub, chain = unit >> 4, cg = unit & 15;
        const int dir = chain & 1, h = (chain >> 1) & 3, b = chain >> 3;
        const size_t rowb = (size_t)b * SEQ;
        float S[8];
#pragma unroll
        for (int j = 0; j < 8; ++j) S[j] = 0.f;
        for (int t0 = 0; t0 < SEQ; t0 += 8) {
            float pr[64];
#pragma unroll
            for (int tt = 0; tt < 8; ++tt) {
                const int t = t0 + tt, pos = dir ? (SEQ - 1 - t) : t;
                const bf16* rp = proj + (rowb + pos) * INC;
                const float g = bf1(rp[2048 + 512 * dir + h * 128 + c]);
                const float qv = bf1(rp[1536 + h * 128 + c]);
                const v4u vw = *(const v4u*)(rp + 3072 + h * 128 + cg * 8);
                const float f = __expf(g), kk = 1.0f - f;
                const float vv[8] = {bflo(vw.x), bfhi(vw.x), bflo(vw.y), bfhi(vw.y), bflo(vw.z), bfhi(vw.z), bflo(vw.w), bfhi(vw.w)};
#pragma unroll
                for (int j = 0; j < 8; ++j) { S[j] = f * S[j] + kk * vv[j]; pr[tt * 8 + j] = qv * S[j]; }
            }
#pragma unroll
            for (int step = 0; step < 6; ++step) {
                const int off = 32 >> step, half = 32 >> step;
                const bool up = (F.lane & off) != 0;
#pragma unroll
                for (int i = 0; i < half; ++i) {
                    const float keep = up ? pr[i + half] : pr[i], send = up ? pr[i] : pr[i + half];
                    pr[i] = keep + __shfl_xor(send, off);
                }
            }
            __syncthreads();
            if (wsub == 1) red[sub * 64 + F.lane] = pr[0];
            __syncthreads();
            if (wsub == 0) {
                const float tot = pr[0] + red[sub * 64 + F.lane];
                const int t = t0 + (F.lane >> 3), j = F.lane & 7, pos = dir ? (SEQ - 1 - t) : t;
                odir[((size_t)dir * MT + rowb + pos) * 512 + h * 128 + cg * 8 + j] = (bf16)f2bf(tot);
            }
        }
    }
}

typedef short s16x8 __attribute__((ext_vector_type(8)));
typedef float f32x16 __attribute__((ext_vector_type(16)));
__device__ __forceinline__ unsigned cvtpk(float lo, float hi) { unsigned r; asm volatile("v_cvt_pk_bf16_f32 %0, %1, %2" : "=v"(r) : "v"(lo), "v"(hi)); return r; }
__device__ __forceinline__ s16x8 tr_read_pair(unsigned a0, unsigned a1) {
    v2u lo, hi;
    asm volatile("ds_read_b64_tr_b16 %0, %2\n\tds_read_b64_tr_b16 %1, %3\n\ts_waitcnt lgkmcnt(0)" : "=&v"(lo), "=&v"(hi) : "v"(a0), "v"(a1) : "memory");
    v4u w; w.x = lo.x; w.y = lo.y; w.z = hi.x; w.w = hi.y;
    return __builtin_bit_cast(s16x8, w);
}
constexpr int ATT_ITEMS = NB * NAH * 96;

__device__ __forceinline__ void attn_mfma(Frame& F, const bf16* proj, bf16* atto  , float* lsep  , const int gw, const int NGW) {
    const int l = F.lane, r = l & 31, hh = l >> 5;
    LAS unsigned char* vt = F.lds + F.wave * 4096;
    const unsigned vtb = (unsigned)(size_t)vt;
    const int tq = (l & 15) >> 2, tp = l & 3, tblk = (l >> 4) & 1;
    for (int it = gw; it < ATT_ITEMS; it += NGW) {
        const int bh = it / 96, rem = it - bh * 96, p = rem >> 5, idx = rem & 31;
        const int b = bh >> 3, h = bh & 7;
        const int dl = (p == 0) ? 1 : (p == 1 ? 4 : 16), L = SEQ / dl;
        const int cls = (p == 0) ? 0 : (p == 1 ? (idx >> 3) : (idx >> 1));
        const int blk = (p == 0) ? idx : (p == 1 ? (idx & 7) : (idx & 1));
        const int m0 = blk * 64;
        const bf16* base = proj + (size_t)b * SEQ * INC + h * 64;
        s16x8 qf[2][4];
#pragma unroll
        for (int qt = 0; qt < 2; ++qt) { const bf16* qp = base + (size_t)(cls + dl * (m0 + 32 * qt + r)) * INC + 8 * hh;
#pragma unroll
            for (int ks = 0; ks < 4; ++ks) qf[qt][ks] = *(const s16x8*)(qp + 16 * ks); }
        f32x16 O[2][2];
#pragma unroll
        for (int qt = 0; qt < 2; ++qt)
#pragma unroll
            for (int dt = 0; dt < 2; ++dt)
#pragma unroll
                for (int i = 0; i < 16; ++i) O[qt][dt][i] = 0.f;
        float mrun[2] = {-1e30f, -1e30f}, lsum[2] = {0.f, 0.f};
        s16x8 kfn[4]; v4u vn[4];
        {
            const int kb = m0 - 64;
            int mk = kb + r; mk = mk < 0 ? 0 : (mk >= L ? L - 1 : mk);
            const bf16* kp = base + (size_t)(cls + dl * mk) * INC + 512 + 8 * hh;
#pragma unroll
            for (int ks = 0; ks < 4; ++ks) kfn[ks] = *(const s16x8*)(kp + 16 * ks);
#pragma unroll
            for (int i = 0; i < 4; ++i) { const int c = l + 64 * i; int mv = kb + (c >> 3); mv = mv < 0 ? 0 : (mv >= L ? L - 1 : mv);
                vn[i] = *(const v4u*)(base + (size_t)(cls + dl * mv) * INC + 1024 + 8 * (c & 7)); }
        }
        for (int kt = 0; kt < 6; ++kt) {
            const int kb = m0 - 64 + 32 * kt;
            const bool inrange = (kb >= 0) && (kb < L);
            s16x8 kf[4];
#pragma unroll
            for (int ks = 0; ks < 4; ++ks) kf[ks] = kfn[ks];
#pragma unroll
            for (int i = 0; i < 4; ++i) { const int c = l + 64 * i, vr = c >> 3, ch = c & 7;
                *(LAS v4u*)(vt + vr * 128 + ((ch * 16) ^ (((vr >> 1) & 1) << 6))) = vn[i]; }
            if (kt < 5) {
                const int kb2 = kb + 32;
                int mk = kb2 + r; mk = mk < 0 ? 0 : (mk >= L ? L - 1 : mk);
                const bf16* kp = base + (size_t)(cls + dl * mk) * INC + 512 + 8 * hh;
#pragma unroll
                for (int ks = 0; ks < 4; ++ks) kfn[ks] = *(const s16x8*)(kp + 16 * ks);
#pragma unroll
                for (int i = 0; i < 4; ++i) { const int c = l + 64 * i; int mv = kb2 + (c >> 3); mv = mv < 0 ? 0 : (mv >= L ? L - 1 : mv);
                    vn[i] = *(const v4u*)(base + (size_t)(cls + dl * mv) * INC + 1024 + 8 * (c & 7)); }
            }
            asm volatile("s_waitcnt lgkmcnt(0)" ::: "memory");
            if (inrange) {
                s16x8 vf[2][2];
#pragma unroll
                for (int dt = 0; dt < 2; ++dt)
#pragma unroll
                    for (int s = 0; s < 2; ++s) {
                        const int row0 = 16 * s + 4 * hh + tq, row1 = row0 + 8;
                        const int cb = 64 * dt + 32 * tblk + 8 * tp;
                        vf[dt][s] = tr_read_pair(vtb + row0 * 128 + (cb ^ (((row0 >> 1) & 1) << 6)), vtb + row1 * 128 + (cb ^ (((row1 >> 1) & 1) << 6)));
                    }
#pragma unroll
                for (int qt = 0; qt < 2; ++qt) {
                    const int d = kt - qt;
                    if (d >= 0 && d <= 4) {
                        f32x16 s;
#pragma unroll
                        for (int i = 0; i < 16; ++i) s[i] = 0.f;
#pragma unroll
                        for (int ks = 0; ks < 4; ++ks) s = __builtin_amdgcn_mfma_f32_32x32x16_bf16(kf[ks], qf[qt][ks], s, 0, 0, 0);
                        if (d == 0) {
#pragma unroll
                            for (int i = 0; i < 16; ++i) { const int kr = (i & 3) + 8 * (i >> 2) + 4 * hh; s[i] = (kr >= r) ? s[i] : -1e30f; }
                        } else if (d == 4) {
#pragma unroll
                            for (int i = 0; i < 16; ++i) { const int kr = (i & 3) + 8 * (i >> 2) + 4 * hh; s[i] = (kr <= r) ? s[i] : -1e30f; }
                        }
                        float tmax = s[0];
#pragma unroll
                        for (int i = 1; i < 16; ++i) tmax = fmaxf(tmax, s[i]);
                        tmax = fmaxf(tmax, __shfl_xor(tmax, 32));
                        const float mnew = fmaxf(mrun[qt], tmax);
                        const float alpha = __expf(mrun[qt] - mnew);
                        mrun[qt] = mnew;
                        float psum = 0.f;
#pragma unroll
                        for (int i = 0; i < 16; ++i) { s[i] = __expf(s[i] - mnew); psum += s[i]; }
                        lsum[qt] = lsum[qt] * alpha + psum;
#pragma unroll
                        for (int dt = 0; dt < 2; ++dt)
#pragma unroll
                            for (int i = 0; i < 16; ++i) O[qt][dt][i] *= alpha;
                        s16x8 pf[2];
#pragma unroll
                        for (int s2 = 0; s2 < 2; ++s2) { v4u w; w.x = cvtpk(s[8 * s2 + 0], s[8 * s2 + 1]); w.y = cvtpk(s[8 * s2 + 2], s[8 * s2 + 3]); w.z = cvtpk(s[8 * s2 + 4], s[8 * s2 + 5]); w.w = cvtpk(s[8 * s2 + 6], s[8 * s2 + 7]);
                            pf[s2] = __builtin_bit_cast(s16x8, w); }
#pragma unroll
                        for (int dt = 0; dt < 2; ++dt)
#pragma unroll
                            for (int s2 = 0; s2 < 2; ++s2) O[qt][dt] = __builtin_amdgcn_mfma_f32_32x32x16_bf16(vf[dt][s2], pf[s2], O[qt][dt], 0, 0, 0);
                    }
                }
            }
        }
#pragma unroll
        for (int qt = 0; qt < 2; ++qt) {
            const float ltot = lsum[qt] + __shfl_xor(lsum[qt], 32);
            const float inv = 1.0f / ltot;
            const size_t tok = (size_t)b * SEQ + cls + dl * (m0 + 32 * qt + r);
            bf16* op = atto + ((size_t)p * MT + tok) * 512 + h * 64;
#pragma unroll
            for (int dt = 0; dt < 2; ++dt)
#pragma unroll
                for (int g = 0; g < 4; ++g) {
                    v2u w; w.x = cvtpk(O[qt][dt][4 * g] * inv, O[qt][dt][4 * g + 1] * inv); w.y = cvtpk(O[qt][dt][4 * g + 2] * inv, O[qt][dt][4 * g + 3] * inv);
                    *(v2u*)(op + 32 * dt + 8 * g + 4 * hh) = w;
                }
            if (hh == 0) lsep[((size_t)p * MT + tok) * 8 + h] = mrun[qt] + __logf(ltot);
        }
    }
}
typedef float f32x4v __attribute__((ext_vector_type(4)));
constexpr int GL_GQV = 272, GL_T = 144;
constexpr int GL_G = 0, GL_Q = 17408, GL_V0 = 34816, GL_V1 = 52224, GL_QAT = 69632, GL_KAT = 88064, GL_P = 106496, GL_TI = 115712, GL_EBR = 124928, GL_EBL = 125440;
__device__ __forceinline__ v2u tr_read1(unsigned a) { v2u r; asm volatile("ds_read_b64_tr_b16 %0, %1\n\ts_waitcnt lgkmcnt(0)" : "=&v"(r) : "v"(a) : "memory"); return r; }
#define GL_BAR() do { asm volatile("s_waitcnt vmcnt(0) lgkmcnt(0)" ::: "memory"); __builtin_amdgcn_s_barrier(); asm volatile("" ::: "memory"); } while (0)
#define GL_MFMA(a, b, c) __builtin_amdgcn_mfma_f32_16x16x32_bf16(a, b, c, 0, 0, 0)

__device__ __forceinline__ void gla_chain(Frame& F, const bf16* proj, bf16* odir, const int chain) {
    const int dir = chain & 1, h = (chain >> 1) & 3, b = chain >> 3;
    const int l = F.lane, li = l & 15, kq = l >> 4, w = F.wave, tid = F.tid;
    const int tq = li >> 2, tp = li & 3;
    LAS unsigned char* L = F.lds;
    const unsigned Lb = (unsigned)(size_t)L;
    const bf16* pb = proj + (size_t)b * SEQ * INC;
    for (int i = tid; i < 64 * 64; i += 512) { const int t = i >> 6, s = i & 63; const int v = (s <= t ? 1 : 0) - (s <= 31 ? 1 : 0);
        *(LAS bf16*)(L + GL_TI + t * GL_T + s * 2) = (bf16)(v == 0 ? 0 : (v > 0 ? 0x3F80 : 0xBF80)); }
    for (int i = tid; i < 64 * GL_T / 4; i += 512) *(LAS unsigned*)(L + GL_P + i * 4) = 0u;
    v4u sg[2], sq[2], sv[2];
#define GL_LOAD(n) do { _Pragma("unroll") for (int i = 0; i < 2; ++i) { const int ci = tid + 512 * i, row = ci >> 4, c16 = ci & 15; const int t = 64 * (n) + row; const int pos = dir ? (SEQ - 1 - t) : t; \
        const bf16* rp = pb + (size_t)pos * INC + 128 * h + 8 * c16; sg[i] = *(const v4u*)(rp + 2048 + 512 * dir); sq[i] = *(const v4u*)(rp + 1536); sv[i] = *(const v4u*)(rp + 3072); } } while (0)
#define GL_STORE_GQ() do { _Pragma("unroll") for (int i = 0; i < 2; ++i) { const int ci = tid + 512 * i, row = ci >> 4, c16 = ci & 15; \
        *(LAS v4u*)(L + GL_G + row * GL_GQV + c16 * 16) = sg[i]; *(LAS v4u*)(L + GL_Q + row * GL_GQV + c16 * 16) = sq[i]; } } while (0)
#define GL_STORE_V(buf) do { _Pragma("unroll") for (int i = 0; i < 2; ++i) { const int ci = tid + 512 * i, row = ci >> 4, c16 = ci & 15; \
        *(LAS v4u*)(L + ((buf) ? GL_V1 : GL_V0) + row * GL_GQV + c16 * 16) = sv[i]; } } while (0)
    GL_LOAD(0); GL_STORE_GQ(); GL_STORE_V(0);
    f32x4v S[8];
#pragma unroll
    for (int ct = 0; ct < 8; ++ct) S[ct] = (f32x4v){0.f, 0.f, 0.f, 0.f};
    for (int n = 0; n < 32; ++n) {
        const int vbuf = n & 1;
        GL_BAR();
        if (n + 1 < 32) GL_LOAD(n + 1);
        f32x4v bp[4];
        {
            s16x8 gB[2];
#pragma unroll
            for (int ks = 0; ks < 2; ++ks) {
                const v2u lo = tr_read1(Lb + GL_G + (32 * ks + 8 * kq + tq) * GL_GQV + (16 * w + 4 * tp) * 2), hi = tr_read1(Lb + GL_G + (32 * ks + 8 * kq + 4 + tq) * GL_GQV + (16 * w + 4 * tp) * 2);
                v4u t4; t4.x = lo.x; t4.y = lo.y; t4.z = hi.x; t4.w = hi.y; gB[ks] = __builtin_bit_cast(s16x8, t4);
            }
#pragma unroll
            for (int tt = 0; tt < 4; ++tt) {
                bp[tt] = (f32x4v){0.f, 0.f, 0.f, 0.f};
#pragma unroll
                for (int ks = 0; ks < 2; ++ks) { const s16x8 a = *(const LAS s16x8*)(L + GL_TI + (16 * tt + li) * GL_T + (32 * ks + 8 * kq) * 2); bp[tt] = GL_MFMA(a, gB[ks], bp[tt]); }
            }
        }
        {
            const int c = 16 * w + li;
#pragma unroll
            for (int tt = 0; tt < 4; ++tt) {
                const int t0 = 16 * tt + 4 * kq;
                const v2u gw2 = tr_read1(Lb + GL_G + (t0 + tq) * GL_GQV + (16 * w + 4 * tp) * 2), qw2 = tr_read1(Lb + GL_Q + (t0 + tq) * GL_GQV + (16 * w + 4 * tp) * 2);
                const float g4[4] = {bflo(gw2.x), bfhi(gw2.x), bflo(gw2.y), bfhi(gw2.y)}, q4[4] = {bflo(qw2.x), bfhi(qw2.x), bflo(qw2.y), bfhi(qw2.y)};
                float qa[4], ka[4];
#pragma unroll
                for (int r = 0; r < 4; ++r) { const float x = fminf(fmaxf(bp[tt][r], -60.f), 60.f); const float ex = __expf(x); qa[r] = q4[r] * ex; ka[r] = (1.0f - __expf(g4[r])) * __builtin_amdgcn_rcpf(ex); }
                v2u o; o.x = cvtpk(qa[0], qa[1]); o.y = cvtpk(qa[2], qa[3]); *(LAS v2u*)(L + GL_QAT + c * GL_T + t0 * 2) = o;
                o.x = cvtpk(ka[0], ka[1]); o.y = cvtpk(ka[2], ka[3]); *(LAS v2u*)(L + GL_KAT + c * GL_T + t0 * 2) = o;
                if (tt == 0 && kq == 0) *(LAS float*)(L + GL_EBR + c * 4) = __expf(g4[0] - bp[0][0]);
                if (tt == 3 && kq == 3) *(LAS float*)(L + GL_EBL + c * 4) = __expf(bp[3][3]);
            }
        }
        GL_BAR();
        if (n + 1 < 32) { GL_STORE_GQ(); GL_STORE_V(vbuf ^ 1); }
        for (int ti = w; ti < 10; ti += 8) {
            const int taut = (int)((0x3333222110ull >> (4 * ti)) & 15), sigt = (int)((0x3210210100ull >> (4 * ti)) & 15);
            f32x4v pt = (f32x4v){0.f, 0.f, 0.f, 0.f};
#pragma unroll
            for (int ks = 0; ks < 4; ++ks) {
                const int c0 = 32 * ks + 8 * kq + tq;
                const v2u al = tr_read1(Lb + GL_KAT + c0 * GL_T + (16 * sigt + 4 * tp) * 2), ah = tr_read1(Lb + GL_KAT + (c0 + 4) * GL_T + (16 * sigt + 4 * tp) * 2);
                const v2u bl = tr_read1(Lb + GL_QAT + c0 * GL_T + (16 * taut + 4 * tp) * 2), bh = tr_read1(Lb + GL_QAT + (c0 + 4) * GL_T + (16 * taut + 4 * tp) * 2);
                v4u a4; a4.x = al.x; a4.y = al.y; a4.z = ah.x; a4.w = ah.y; v4u b4; b4.x = bl.x; b4.y = bl.y; b4.z = bh.x; b4.w = bh.y;
                pt = GL_MFMA(__builtin_bit_cast(s16x8, a4), __builtin_bit_cast(s16x8, b4), pt);
            }
            if (taut == sigt) {
#pragma unroll
                for (int r = 0; r < 4; ++r) pt[r] = (4 * kq + r <= li) ? pt[r] : 0.f;
            }
            v2u o; o.x = cvtpk(pt[0], pt[1]); o.y = cvtpk(pt[2], pt[3]);
            *(LAS v2u*)(L + GL_P + (16 * taut + li) * GL_T + (16 * sigt + 4 * kq) * 2) = o;
        }
        GL_BAR();
        {
            const int voff = vbuf ? GL_V1 : GL_V0;
            s16x8 vB[2];
#pragma unroll
            for (int ks = 0; ks < 2; ++ks) {
                const v2u lo = tr_read1(Lb + voff + (32 * ks + 8 * kq + tq) * GL_GQV + (16 * w + 4 * tp) * 2), hi = tr_read1(Lb + voff + (32 * ks + 8 * kq + 4 + tq) * GL_GQV + (16 * w + 4 * tp) * 2);
                v4u t4; t4.x = lo.x; t4.y = lo.y; t4.z = hi.x; t4.w = hi.y; vB[ks] = __builtin_bit_cast(s16x8, t4);
            }
            s16x8 Sb[4];
#pragma unroll
            for (int ct = 0; ct < 8; ++ct) { const f32x4v e = *(const LAS f32x4v*)(L + GL_EBR + (16 * ct + 4 * kq) * 4); S[ct] = S[ct] * e; }
#pragma unroll
            for (int kc = 0; kc < 4; ++kc) { v4u t4; t4.x = cvtpk(S[2 * kc][0], S[2 * kc][1]); t4.y = cvtpk(S[2 * kc][2], S[2 * kc][3]); t4.z = cvtpk(S[2 * kc + 1][0], S[2 * kc + 1][1]); t4.w = cvtpk(S[2 * kc + 1][2], S[2 * kc + 1][3]);
                Sb[kc] = __builtin_bit_cast(s16x8, t4); }
#pragma unroll
            for (int tt = 0; tt < 4; ++tt) {
                f32x4v o = (f32x4v){0.f, 0.f, 0.f, 0.f};
#pragma unroll
                for (int ks = 0; ks < 2; ++ks) if (ks <= (tt >> 1)) { const s16x8 a = *(const LAS s16x8*)(L + GL_P + (16 * tt + li) * GL_T + (32 * ks + 8 * kq) * 2); o = GL_MFMA(a, vB[ks], o); }
#pragma unroll
                for (int kc = 0; kc < 4; ++kc) {
                    const int c0 = 32 * kc + 4 * kq + tq;
                    const v2u lo = tr_read1(Lb + GL_QAT + c0 * GL_T + (16 * tt + 4 * tp) * 2), hi = tr_read1(Lb + GL_QAT + (c0 + 16) * GL_T + (16 * tt + 4 * tp) * 2);
                    v4u a4; a4.x = lo.x; a4.y = lo.y; a4.z = hi.x; a4.w = hi.y;
                    o = GL_MFMA(__builtin_bit_cast(s16x8, a4), Sb[kc], o);
                }
#pragma unroll
                for (int r = 0; r < 4; ++r) { const int t = 64 * n + 16 * tt + 4 * kq + r; const int pos = dir ? (SEQ - 1 - t) : t;
                    odir[((size_t)dir * MT + (size_t)b * SEQ + pos) * 512 + 128 * h + 16 * w + li] = (bf16)f2bf(o[r]); }
            }
#pragma unroll
            for (int ct = 0; ct < 8; ++ct) {
#pragma unroll
                for (int ks = 0; ks < 2; ++ks) { const s16x8 a = *(const LAS s16x8*)(L + GL_KAT + (16 * ct + li) * GL_T + (32 * ks + 8 * kq) * 2); S[ct] = GL_MFMA(a, vB[ks], S[ct]); }
                const f32x4v e = *(const LAS f32x4v*)(L + GL_EBL + (16 * ct + 4 * kq) * 4); S[ct] = S[ct] * e;
            }
        }
    }
    GL_BAR();
#undef GL_LOAD
#undef GL_STORE_GQ
#undef GL_STORE_V
}

__device__ __forceinline__ void combine_phase(Frame& F, const bf16* proj, const bf16* atto, const float* lsep, const bf16* odir, const float* again, const float* rgain, bf16* abuf) {
    const int gw = F.vcu * NWAVES + F.wave, NGW = F.G * NWAVES;
    for (int m = gw; m < MT; m += NGW) {
        const int c0 = 8 * F.lane;
        { const int hd = F.lane >> 3;
          const float l0 = lsep[(size_t)m * 8 + hd], l1 = lsep[((size_t)MT + m) * 8 + hd], l2 = lsep[((size_t)2 * MT + m) * 8 + hd];
          const float lm = fmaxf(l0, fmaxf(l1, l2));
          float w0 = __expf(l0 - lm), w1 = __expf(l1 - lm), w2 = __expf(l2 - lm);
          const float wi = 1.0f / (w0 + w1 + w2); w0 *= wi; w1 *= wi; w2 *= wi;
          const v4u a0 = *(const v4u*)(atto + (size_t)m * 512 + c0), a1 = *(const v4u*)(atto + ((size_t)MT + m) * 512 + c0), a2 = *(const v4u*)(atto + ((size_t)2 * MT + m) * 512 + c0);
          float v[8] = {w0 * bflo(a0.x) + w1 * bflo(a1.x) + w2 * bflo(a2.x), w0 * bfhi(a0.x) + w1 * bfhi(a1.x) + w2 * bfhi(a2.x),
                        w0 * bflo(a0.y) + w1 * bflo(a1.y) + w2 * bflo(a2.y), w0 * bfhi(a0.y) + w1 * bfhi(a1.y) + w2 * bfhi(a2.y),
                        w0 * bflo(a0.z) + w1 * bflo(a1.z) + w2 * bflo(a2.z), w0 * bfhi(a0.z) + w1 * bfhi(a1.z) + w2 * bfhi(a2.z),
                        w0 * bflo(a0.w) + w1 * bflo(a1.w) + w2 * bflo(a2.w), w0 * bfhi(a0.w) + w1 * bfhi(a1.w) + w2 * bfhi(a2.w)};
          float ss = 0.f;
#pragma unroll
          for (int j = 0; j < 8; ++j) ss += v[j] * v[j];
          const float r = 1.0f / sqrtf(wave_sum(ss) * (1.0f / 512.0f) + RMS_EPS);
          const f32x4 g0 = *(const f32x4*)(again + c0), g1 = *(const f32x4*)(again + c0 + 4);
          v4u o; o.x = pk2(v[0] * r * g0[0], v[1] * r * g0[1]); o.y = pk2(v[2] * r * g0[2], v[3] * r * g0[3]); o.z = pk2(v[4] * r * g1[0], v[5] * r * g1[1]); o.w = pk2(v[6] * r * g1[2], v[7] * r * g1[3]);
          *(v4u*)(abuf + (size_t)m * DM + c0) = o; }
        { const v4u wf = *(const v4u*)(odir + (size_t)m * 512 + c0), wb = *(const v4u*)(odir + ((size_t)MT + m) * 512 + c0);
          const v4u wg = *(const v4u*)(proj + (size_t)m * INC + 3584 + c0);
          float v[8] = {bflo(wf.x) + bflo(wb.x), bfhi(wf.x) + bfhi(wb.x), bflo(wf.y) + bflo(wb.y), bfhi(wf.y) + bfhi(wb.y), bflo(wf.z) + bflo(wb.z), bfhi(wf.z) + bfhi(wb.z), bflo(wf.w) + bflo(wb.w), bfhi(wf.w) + bfhi(wb.w)};
          const float sg[8] = {bflo(wg.x), bfhi(wg.x), bflo(wg.y), bfhi(wg.y), bflo(wg.z), bfhi(wg.z), bflo(wg.w), bfhi(wg.w)};
          float ss = 0.f;
#pragma unroll
          for (int j = 0; j < 8; ++j) ss += v[j] * v[j];
          ss += __shfl_xor(ss, 1); ss += __shfl_xor(ss, 2); ss += __shfl_xor(ss, 4); ss += __shfl_xor(ss, 8);
          const float r = 1.0f / sqrtf(ss * (1.0f / 128.0f) + RMS_EPS);
          const f32x4 g0 = *(const f32x4*)(rgain + c0), g1 = *(const f32x4*)(rgain + c0 + 4);
          v4u o; o.x = pk2(v[0] * r * g0[0] * sg[0], v[1] * r * g0[1] * sg[1]); o.y = pk2(v[2] * r * g0[2] * sg[2], v[3] * r * g0[3] * sg[3]);
          o.z = pk2(v[4] * r * g1[0] * sg[4], v[5] * r * g1[1] * sg[5]); o.w = pk2(v[6] * r * g1[2] * sg[6], v[7] * r * g1[3] * sg[7]);
          *(v4u*)(abuf + (size_t)m * DM + 512 + c0) = o; }
    }
}

template <int MODE>
__device__ __forceinline__ void ln_phase(Frame& F, float* xs, const float* lng, const float* lnb, const float* adan  , bf16* abuf,
                                         const float* wrt  , unsigned* route) {
    const int gw = F.vcu * NWAVES + F.wave, NGW = F.G * NWAVES;
    for (int m = gw; m < MT; m += NGW) {
        f32x4* xr = (f32x4*)(xs + (size_t)m * DM) + F.lane;
        f32x4 v[4]; float s = 0.f;
#pragma unroll
        for (int j = 0; j < 4; ++j) { v[j] = xr[64 * j]; s += (v[j][0] + v[j][1]) + (v[j][2] + v[j][3]); }
        const float mean = wave_sum(s) * (1.0f / DM); float s2 = 0.f;
#pragma unroll
        for (int j = 0; j < 4; ++j) { v[j] = v[j] - mean; s2 += (v[j][0] * v[j][0] + v[j][1] * v[j][1]) + (v[j][2] * v[j][2] + v[j][3] * v[j][3]); }
        const float rstd = 1.0f / sqrtf(wave_sum(s2) * (1.0f / DM) + LN_EPS);
        const int b = m >> 11; const float* ar = adan + (size_t)b * 3072;
        float lg[8];
#pragma unroll
        for (int e = 0; e < 8; ++e) lg[e] = 0.f;
#pragma unroll
        for (int j = 0; j < 4; ++j) {
            const int col = 4 * F.lane + 256 * j;
            const f32x4 xn = v[j] * rstd * *(const f32x4*)(lng + col) + *(const f32x4*)(lnb + col);
            xr[64 * j] = xn;
            const f32x4 u = xn * (*(const f32x4*)(ar + 1024 + col) + 1.0f) + *(const f32x4*)(ar + col);
            if (MODE == 0) ((unsigned long long*)(abuf + (size_t)m * DM) + F.lane)[64 * j] = (unsigned long long)pk2(u[0], u[1]) | ((unsigned long long)pk2(u[2], u[3]) << 32);
            if (MODE == 1) {
#pragma unroll
                for (int i = 0; i < 4; ++i) { const f32x4 w0 = *(const f32x4*)(wrt + (size_t)(col + i) * 8), w1 = *(const f32x4*)(wrt + (size_t)(col + i) * 8 + 4);
                    lg[0] += u[i] * w0[0]; lg[1] += u[i] * w0[1]; lg[2] += u[i] * w0[2]; lg[3] += u[i] * w0[3]; lg[4] += u[i] * w1[0]; lg[5] += u[i] * w1[1]; lg[6] += u[i] * w1[2]; lg[7] += u[i] * w1[3]; }
            }
        }
        if (MODE == 1) {
#pragma unroll
            for (int e = 0; e < 8; ++e) lg[e] = wave_sum(lg[e]);
            int e1 = 0; float l1 = lg[0];
#pragma unroll
            for (int e = 1; e < 8; ++e) if (lg[e] > l1) { l1 = lg[e]; e1 = e; }
            int e2 = -1; float l2 = -3.0e38f;
#pragma unroll
            for (int e = 0; e < 8; ++e) if (e != e1 && lg[e] > l2) { l2 = lg[e]; e2 = e; }
            if (F.lane == 0) {
                const float w1 = 1.0f / (1.0f + __expf(l2 - l1)), w2 = 1.0f - w1;
                const unsigned p1 = __hip_atomic_fetch_add((unsigned*)(F.ctl + CW_CNT + 64 * e1), 1u, RLX_AGENT);
                const unsigned p2 = __hip_atomic_fetch_add((unsigned*)(F.ctl + CW_CNT + 64 * e2), 1u, RLX_AGENT);
                unsigned* rt = route + (size_t)m * 8;
                rt[0] = (unsigned)e1; rt[1] = p1; rt[2] = __float_as_uint(w1); rt[3] = (unsigned)e2; rt[4] = p2; rt[5] = __float_as_uint(w2);
            }
        }
    }
}

struct MoeOff { int off[9]; int cnt[8]; };
__device__ __forceinline__ void moe_offsets(Frame& F, int (&off)[9], int (&cnt)[8]) {
    off[0] = 0;
#pragma unroll
    for (int e = 0; e < 8; ++e) { cnt[e] = (int)__hip_atomic_load((unsigned*)(F.ctl + CW_CNT + 64 * e), RLX_AGENT); off[e + 1] = off[e] + ((cnt[e] + 255) & ~255); }
}

__device__ __forceinline__ void gather_phase(Frame& F, const float* xs, const float* adan, const unsigned* route, bf16* gath, unsigned* rowinfo) {
    int off[9], cnt[8]; moe_offsets(F, off, cnt);
    const int gw = F.vcu * NWAVES + F.wave, NGW = F.G * NWAVES;
    for (int m = gw; m < MT; m += NGW) {
        const unsigned* rt = route + (size_t)m * 8;
        const int e1 = (int)rt[0], p1 = (int)rt[1], e2 = (int)rt[3], p2 = (int)rt[4]; const unsigned w1 = rt[2], w2 = rt[5];
        int o1 = 0, o2 = 0;
#pragma unroll
        for (int e = 0; e < 8; ++e) { o1 = (e1 == e) ? off[e] : o1; o2 = (e2 == e) ? off[e] : o2; }
        const int r1 = o1 + p1, r2 = o2 + p2;
        const int b = m >> 11; const float* ar = adan + (size_t)b * 3072;
        const f32x4* xr = (const f32x4*)(xs + (size_t)m * DM) + F.lane;
        unsigned long long* d1 = (unsigned long long*)(gath + (size_t)r1 * DM) + F.lane; unsigned long long* d2 = (unsigned long long*)(gath + (size_t)r2 * DM) + F.lane;
#pragma unroll
        for (int j = 0; j < 4; ++j) {
            const int col = 4 * F.lane + 256 * j;
            const f32x4 u = xr[64 * j] * (*(const f32x4*)(ar + 1024 + col) + 1.0f) + *(const f32x4*)(ar + col);
            const unsigned long long w = (unsigned long long)pk2(u[0], u[1]) | ((unsigned long long)pk2(u[2], u[3]) << 32);
            d1[64 * j] = w; d2[64 * j] = w;
        }
        if (F.lane == 0) { rowinfo[2 * (size_t)r1] = (unsigned)m; rowinfo[2 * (size_t)r1 + 1] = w1; rowinfo[2 * (size_t)r2] = (unsigned)m | (1u << 16); rowinfo[2 * (size_t)r2 + 1] = w2; }
    }
    for (int it = gw; it < 8 * 256; it += NGW) {
        const int e = it >> 8, i = it & 255; int oe = 0, ce = 0;
#pragma unroll
        for (int k = 0; k < 8; ++k) { oe = (e == k) ? off[k] : oe; ce = (e == k) ? cnt[k] : ce; }
        const int npad = ((ce + 255) & ~255) - ce;
        if (i < npad) { const int row = oe + ce + i;
            v4u* d = (v4u*)(gath + (size_t)row * DM) + F.lane; d[0] = (v4u){0u, 0u, 0u, 0u}; d[64] = (v4u){0u, 0u, 0u, 0u};
            if (F.lane == 0) { rowinfo[2 * (size_t)row] = 0xffffffffu; rowinfo[2 * (size_t)row + 1] = 0u; } }
    }
}

__device__ __forceinline__ void final_phase(Frame& F, float* xs, const bf16* yslot, const float* adar  , const float* lng, const float* lnb) {
    const int gw = F.vcu * NWAVES + F.wave, NGW = F.G * NWAVES;
    for (int m = gw; m < MT; m += NGW) {
        f32x4* xr = (f32x4*)(xs + (size_t)m * DM) + F.lane;
        const v2u* y0 = (const v2u*)(yslot + (size_t)m * DM) + F.lane; const v2u* y1 = (const v2u*)(yslot + ((size_t)MT + m) * DM) + F.lane;
        const int b = m >> 11; const float* ar = adar + (size_t)b * 3072 + 2048;
        f32x4 v[4]; float s = 0.f;
#pragma unroll
        for (int j = 0; j < 4; ++j) {
            const int col = 4 * F.lane + 256 * j;
            const v2u a = y0[64 * j], c = y1[64 * j];
            const f32x4 y = (f32x4){bflo(a.x) + bflo(c.x), bfhi(a.x) + bfhi(c.x), bflo(a.y) + bflo(c.y), bfhi(a.y) + bfhi(c.y)};
            v[j] = xr[64 * j] * DN_ALPHA + (*(const f32x4*)(ar + col) + 1.0f) * y;
            s += (v[j][0] + v[j][1]) + (v[j][2] + v[j][3]);
        }
        const float mean = wave_sum(s) * (1.0f / DM); float s2 = 0.f;
#pragma unroll
        for (int j = 0; j < 4; ++j) { v[j] = v[j] - mean; s2 += (v[j][0] * v[j][0] + v[j][1] * v[j][1]) + (v[j][2] * v[j][2] + v[j][3] * v[j][3]); }
        const float rstd = 1.0f / sqrtf(wave_sum(s2) * (1.0f / DM) + LN_EPS);
#pragma unroll
        for (int j = 0; j < 4; ++j) { const int col = 4 * F.lane + 256 * j; xr[64 * j] = v[j] * rstd * *(const f32x4*)(lng + col) + *(const f32x4*)(lnb + col); }
    }
}

constexpr int NPH = 20;
#define IN(k) (lo <= (k) && (k) < hi)
#define SEAM(k) do { if (IN(k) && IN((k) + 1)) xcd_barrier(bar); } while (0)
template <int L>
__device__ __forceinline__ void layer_phases(Frame& F, const Args& args, const XcdBarrier& bar, const int lo, const int hi) {
    constexpr int pb = 2 + 9 * L;
    unsigned char* const ws = args.ws;
    float* const xs = args.out;
    if (IN(pb + 0)) {
        pg8::Gemm g{(const bf16*)(ws + WS_ABUF), (const bf16*)(ws + WS_WIN) + (size_t)L * INC * DM, MT, INC, DM}; pg8::StaticOrder S; S.init(MT, INC, F.G, (int)blockIdx.x);
        pg8::EpiIn E{(bf16*)(ws + WS_PROJ), (const float*)(ws + WS_ROPE), (const float*)(ws + WS_LB) + (size_t)L * 1024};
        pg8::gemm_phase<pg8::EpiIn, pg8::StaticOrder, PG8_ALIGN, PG8_SP2>(F.lds, g, S, E);
        SEAM(pb + 0);
    }
    if (IN(pb + 1)) { if (F.G >= 128) { if (F.vcu < 64) gla_chain(F, (const bf16*)(ws + WS_PROJ), (bf16*)(ws + WS_ODIR), F.vcu);
                               else attn_mfma(F, (const bf16*)(ws + WS_PROJ), (bf16*)(ws + WS_ATTO), (float*)(ws + WS_LSE), (F.vcu - 64) * NWAVES + F.wave, (F.G - 64) * NWAVES); }
          else { attn_mfma(F, (const bf16*)(ws + WS_PROJ), (bf16*)(ws + WS_ATTO), (float*)(ws + WS_LSE), F.vcu * NWAVES + F.wave, F.G * NWAVES); gla_simple(F, (const bf16*)(ws + WS_PROJ), (bf16*)(ws + WS_ODIR)); } SEAM(pb + 1); }
    if (IN(pb + 2)) { combine_phase(F, (const bf16*)(ws + WS_PROJ), (const bf16*)(ws + WS_ATTO), (const float*)(ws + WS_LSE), (const bf16*)(ws + WS_ODIR), (const float*)args.in[5] + (size_t)L * 512, (const float*)args.in[6] + (size_t)L * 512, (bf16*)(ws + WS_ABUF)); SEAM(pb + 2); }
    if (IN(pb + 3)) {
        pg8::Gemm g{(const bf16*)(ws + WS_ABUF), (const bf16*)(ws + WS_WOUT) + (size_t)L * DM * DM, MT, DM, DM}; pg8::StaticOrder S; S.init(MT, DM, F.G, (int)blockIdx.x);
        pg8::EpiRes E{L == 0 ? (const float*)args.in[0] : (const float*)xs, xs, (const float*)(ws + WS_ADA) + (size_t)(L * 2 + 0) * 8 * 3072, DN_ALPHA};
        pg8::gemm_phase<pg8::EpiRes, pg8::StaticOrder, PG8_ALIGN, PG8_SP2>(F.lds, g, S, E);
        SEAM(pb + 3);
    }
    const float* const ada1 = (const float*)(ws + WS_ADA) + (size_t)(L * 2 + 1) * 8 * 3072;
    const float* const lng = (const float*)args.in[10] + (size_t)L * 2 * DM; const float* const lnb = (const float*)args.in[11] + (size_t)L * 2 * DM;
    if constexpr (L == 0) {
        if (IN(pb + 4)) { ln_phase<0>(F, xs, lng, lnb, ada1, (bf16*)(ws + WS_ABUF), nullptr, nullptr); if (IN(pb + 6)) xcd_barrier(bar); }
        if (IN(pb + 6)) {
            pg8::Gemm g{(const bf16*)(ws + WS_ABUF), (const bf16*)(ws + WS_WGU), MT, 2 * FFDP, DM}; pg8::StaticOrder S; S.init(MT, 2 * FFDP, F.G, (int)blockIdx.x);
            pg8::EpiGU<FFDP, 22> E{(bf16*)(ws + WS_HID)};
            pg8::gemm_phase<pg8::EpiGU<FFDP, 22>, pg8::StaticOrder, PG8_ALIGN, PG8_SP2>(F.lds, g, S, E);
            SEAM(pb + 6);
        }
        if (IN(pb + 7)) {
            pg8::Gemm g{(const bf16*)(ws + WS_HID), (const bf16*)(ws + WS_WDN), MT, DM, FFDP}; pg8::StaticOrder S; S.init(MT, DM, F.G, (int)blockIdx.x);
            pg8::EpiRes E{(const float*)xs, xs, ada1, DN_ALPHA};
            pg8::gemm_phase<pg8::EpiRes, pg8::StaticOrder, PG8_ALIGN, PG8_SP2>(F.lds, g, S, E);
            SEAM(pb + 7);
        }
        if (IN(pb + 8)) { ln_phase<0>(F, xs, lng + DM, lnb + DM, (const float*)(ws + WS_ADA) + (size_t)2 * 8 * 3072, (bf16*)(ws + WS_ABUF), nullptr, nullptr); SEAM(pb + 8); }
    } else {
        unsigned* const route = (unsigned*)(ws + WS_ROUTE); unsigned* const rowinfo = (unsigned*)(ws + WS_ROWINFO);
        if (IN(pb + 4)) { ln_phase<1>(F, xs, lng, lnb, ada1, nullptr, (const float*)args.in[15], route); SEAM(pb + 4); }
        if (IN(pb + 5)) { gather_phase(F, xs, ada1, route, (bf16*)(ws + WS_GATH), rowinfo); SEAM(pb + 5); }
        if (IN(pb + 6)) {
            int off[9], cnt[8]; moe_offsets(F, off, cnt);
            const int nT = off[8] >> 8;
            pg8::Gemm g{(const bf16*)(ws + WS_GATH), (const bf16*)(ws + WS_WMGU), nT * 256, 2 * FFE, DM};
            pg8::MoeOrder S; S.init(nT * 256, 2 * FFE, F.G, (int)blockIdx.x);
            S.ts1 = off[1] >> 8; S.ts2 = off[2] >> 8; S.ts3 = off[3] >> 8; S.ts4 = off[4] >> 8; S.ts5 = off[5] >> 8; S.ts6 = off[6] >> 8; S.ts7 = off[7] >> 8; S.nNloc = 28;
            pg8::EpiGU<FFE, 28> E{(bf16*)(ws + WS_HID)};
            pg8::gemm_phase<pg8::EpiGU<FFE, 28>, pg8::MoeOrder, PG8_ALIGN, PG8_SP2>(F.lds, g, S, E);
            SEAM(pb + 6);
        }
        if (IN(pb + 7)) {
            int off[9], cnt[8]; moe_offsets(F, off, cnt);
            const int nT = off[8] >> 8;
            pg8::Gemm g{(const bf16*)(ws + WS_HID), (const bf16*)(ws + WS_WMDN), nT * 256, DM, FFE};
            pg8::MoeOrder S; S.init(nT * 256, DM, F.G, (int)blockIdx.x);
            S.ts1 = off[1] >> 8; S.ts2 = off[2] >> 8; S.ts3 = off[3] >> 8; S.ts4 = off[4] >> 8; S.ts5 = off[5] >> 8; S.ts6 = off[6] >> 8; S.ts7 = off[7] >> 8; S.nNloc = 4;
            pg8::EpiMoeDn E{rowinfo, (bf16*)(ws + WS_YSLOT)};
            pg8::gemm_phase<pg8::EpiMoeDn, pg8::MoeOrder, PG8_ALIGN, PG8_SP2>(F.lds, g, S, E);
            SEAM(pb + 7);
        }
        if (IN(pb + 8)) { final_phase(F, xs, (const bf16*)(ws + WS_YSLOT), ada1, lng + DM, lnb + DM); }
    }
}

__global__ void __launch_bounds__(NWAVES * 64, 2) fwd_kernel(Args args) {
    extern __shared__ __attribute__((aligned(16))) unsigned char lds[];
    Frame F;
    F.lds = (LAS unsigned char*)lds; F.ws = args.ws; F.ctl = (gu32*)(args.ws + WS_CTL);
    F.tid = threadIdx.x; F.lane = F.tid & 63; F.wave = __builtin_amdgcn_readfirstlane(F.tid >> 6);
    F.G = gridDim.x; { const int bx = blockIdx.x; F.vcu = (F.G % 8 == 0) ? (bx % 8) * (F.G / 8) + bx / 8 : bx; }
    volatile LAS unsigned* MISC = (volatile LAS unsigned*)(F.lds + MISC_OFF);
    for (int u = F.tid; u < (LDS_BYTES - 131072) / 4; u += NWAVES * 64) ((LAS unsigned*)(F.lds + 131072))[u] = 0u;
    __syncthreads();
    XcdBarrier bar; bar.bar = (unsigned*)(F.ctl + CW_BAR); bar.x = 0; bar.st = nullptr;
    const int lo = args.ph_lo, hi = args.ph_hi;
    if (hi - lo > 1) bar = xcd_barrier_post((unsigned*)(F.ctl + CW_BAR), MISC + 8);
    if (IN(0)) { p0_prologue(F, args); SEAM(0); }
    if (IN(1)) { p1_mod0(F, (const float*)args.in[0], (const float*)(args.ws + WS_ADA), (bf16*)(args.ws + WS_ABUF)); SEAM(1); }
    layer_phases<0>(F, args, bar, lo, hi);
    layer_phases<1>(F, args, bar, lo, hi);
}
#undef IN
#undef SEAM

extern "C" void kernel_launch(void* const* d_in, const int* in_sizes, int n_in, void* d_out, int out_size, void* d_ws, size_t ws_size, hipStream_t stream) {
    static int grid = 0;
    if (grid == 0) {
        int dev = 0, cus = 0, per_cu = 0;
        if (n_in != 19 || ws_size < WS_END) { fprintf(stderr, "kernel_launch: unexpected n_in %d / ws_size %zu\n", n_in, ws_size); }
        if (hipGetDevice(&dev) != hipSuccess || hipDeviceGetAttribute(&cus, hipDeviceAttributeMultiprocessorCount, dev) != hipSuccess) { grid = -1; return; }
        if (hipFuncSetAttribute((const void*)fwd_kernel, hipFuncAttributeMaxDynamicSharedMemorySize, LDS_BYTES) != hipSuccess) { grid = -1; return; }
        if (hipOccupancyMaxActiveBlocksPerMultiprocessor(&per_cu, (const void*)fwd_kernel, NWAVES * 64, LDS_BYTES) != hipSuccess || per_cu < 1) fprintf(stderr, "kernel_launch: occupancy query says %d\n", per_cu);
        (void)hipGetLastError();
        grid = cus;
    }
    if (grid < 0) return;
    (void)hipMemsetAsync((char*)d_ws + WS_CTL, 0, CTL_ZERO_BYTES, stream);
    Args a{};
    for (int i = 0; i < 19; ++i) a.in[i] = d_in[i];
    a.out = (float*)d_out; a.ws = (unsigned char*)d_ws;
#if MK_N_LAUNCHES == 1
    a.ph_lo = 0; a.ph_hi = NPH;
    hipLaunchKernelGGL(fwd_kernel, dim3(grid), dim3(NWAVES * 64), LDS_BYTES, stream, a);
#else
    for (int p = 0; p < NPH; ++p) {
        if (p == 2 + 5) continue;
        a.ph_lo = p; a.ph_hi = p + 1;
        hipLaunchKernelGGL(fwd_kernel, dim3(grid), dim3(NWAVES * 64), LDS_BYTES, stream, a);
    }
#endif
}
```

```cpp
#include <hip/hip_runtime.h>
#include <cstdio>
#include <cstdint>
#include <cmath>
#define MK_N_LAUNCHES 1
namespace pg8 {
#define PG8_LAS __attribute__((address_space(3)))
typedef unsigned short bf16_t;
typedef short bf16x8 __attribute__((ext_vector_type(8)));
typedef float f32x4 __attribute__((ext_vector_type(4)));
typedef unsigned u32x4 __attribute__((ext_vector_type(4)));
constexpr int BM = 256, BK = 64, HALF = 128, HTB = HALF * BK * 2  , STAGE_BYTES = 8 * HTB, NXCD = 8, WGM = 8;

__host__ __device__ __forceinline__ int lds_byte(int r, int c) { const int st = (r >> 4) * 2 + (c >> 5), rr = r & 15, cc = c & 31, ob = rr * 64 + cc * 2; return st * 1024 + (ob ^ (((ob >> 9) & 1) << 5)); }
__host__ __device__ __forceinline__ void stage_rc(int b, int& R, int& C) { const int st = b / 1024, sb = b % 1024, swz = sb ^ (((sb >> 9) & 1) << 5); R = (st >> 1) * 16 + swz / 64; C = (st & 1) * 32 + (swz % 64) / 2; }
__host__ __device__ __forceinline__ int perm32(int rho) { const int n = rho >> 4, i = rho & 15; return 8 * (i >> 2) + 4 * n + (i & 3); }

struct Unit { int pm, pn; };
struct Gemm { const bf16_t* A; const bf16_t* Bt; int M, N, K; };

struct StaticOrder {
    int nM, nN, nwg, G, c;
    __host__ __device__ void init(int M, int N, int G_, int c_) { nM = M / BM; nN = N / BM; nwg = nM * nN; G = G_; c = c_; }
    __host__ __device__ bool next(int i, Unit& u) const {
        const long L = (long)i * G + c; if (L >= nwg) return false;
        int wgid = (int)L; { const int q = nwg / NXCD, r = nwg % NXCD, xcd = wgid % NXCD, off = wgid / NXCD; wgid = (xcd < r ? xcd * (q + 1) : r * (q + 1) + (xcd - r) * q) + off; }
        const int nig = WGM * nN, gid = wgid / nig, fm = gid * WGM, gsz = (nM - fm) < WGM ? (nM - fm) : WGM;
        u.pm = fm + ((wgid % nig) % gsz); u.pn = (wgid % nig) / gsz; return true;
    }
    __device__ __forceinline__ void a_ready(const Unit&) const {}
    __device__ __forceinline__ void done(const Unit&) const {}
};
__device__ __forceinline__ unsigned cvt_pk_bf16(float lo, float hi) { unsigned r; asm volatile("v_cvt_pk_bf16_f32 %0, %1, %2" : "=v"(r) : "v"(lo), "v"(hi)); return r; }

typedef float f32x2 __attribute__((ext_vector_type(2)));
typedef unsigned u32x2 __attribute__((ext_vector_type(2)));
__device__ __forceinline__ float fast_sigmoid(float x) { return __builtin_amdgcn_rcpf(1.0f + __expf(-x)); }
__device__ __forceinline__ float fast_silu(float x) { return x * fast_sigmoid(x); }

struct EpiIn {
    static constexpr bool PERM = false, AFTER_DRAIN = false;
    bf16_t* proj; const float* rope; const float* lb;
    __device__ __forceinline__ void operator()(const f32x4 (&acc)[2][2][4][2], const Unit& u, int wr, int wc, int fr, int fq) const {
        const int row0 = u.pm * BM + wr * 64 + fr;
        const int type = u.pn >> 1;
        if (type < 2) {
            const float sc = (type == 0) ? 0.125f : 1.0f;
            const int g = wc & 1;
#pragma unroll
            for (int ai = 0; ai < 2; ++ai)
#pragma unroll
                for (int m = 0; m < 4; ++m) {
                    const int row = row0 + ai * HALF + m * 16;
                    const f32x4* rp = (const f32x4*)(rope + ((size_t)row * 32 + 16 * g + 4 * fq) * 2);
                    const f32x4 cs0 = rp[0], cs1 = rp[1];
                    const float cc[4] = {cs0[0], cs0[2], cs1[0], cs1[2]}, ss[4] = {cs0[1], cs0[3], cs1[1], cs1[3]};
#pragma unroll
                    for (int bj = 0; bj < 2; ++bj) {
                        const int col = u.pn * BM + (2 * bj + (wc >> 1)) * 64 + 16 * g + 4 * fq;
                        const f32x4 x1 = acc[ai][bj][m][0], x2 = acc[ai][bj][m][1];
                        float o1[4], o2[4];
#pragma unroll
                        for (int j = 0; j < 4; ++j) { o1[j] = (x1[j] * cc[j] - x2[j] * ss[j]) * sc; o2[j] = (x2[j] * cc[j] + x1[j] * ss[j]) * sc; }
                        u32x2 w1, w2; w1.x = cvt_pk_bf16(o1[0], o1[1]); w1.y = cvt_pk_bf16(o1[2], o1[3]); w2.x = cvt_pk_bf16(o2[0], o2[1]); w2.y = cvt_pk_bf16(o2[2], o2[3]);
                        bf16_t* dst = proj + (size_t)row * 4096 + col;
                        *(u32x2*)dst = w1; *(u32x2*)(dst + 32) = w2;
                    }
                }
        } else {
            const int lc0 = u.pn * BM + wc * 32 + 8 * fq;
            f32x4 lbv[2][2];
            if (type == 4 || type == 5) {
#pragma unroll
                for (int bj = 0; bj < 2; ++bj)
#pragma unroll
                    for (int n = 0; n < 2; ++n) lbv[bj][n] = *(const f32x4*)(lb + (lc0 + bj * HALF - 2048) + 4 * n);
            }
#pragma unroll
            for (int ai = 0; ai < 2; ++ai)
#pragma unroll
                for (int m = 0; m < 4; ++m) {
                    const int row = row0 + ai * HALF + m * 16;
#pragma unroll
                    for (int bj = 0; bj < 2; ++bj) {
                        f32x4 v0 = acc[ai][bj][m][0], v1 = acc[ai][bj][m][1];
                        if (type == 3) {
#pragma unroll
                            for (int j = 0; j < 4; ++j) { v0[j] = fast_silu(v0[j]); v1[j] = fast_silu(v1[j]); }
                        } else if (type == 7) {
#pragma unroll
                            for (int j = 0; j < 4; ++j) { v0[j] = fast_sigmoid(v0[j]); v1[j] = fast_sigmoid(v1[j]); }
                        } else if (type == 4 || type == 5) {
#pragma unroll
                            for (int j = 0; j < 4; ++j) {
                                const float l0 = lbv[bj][0][j], l1 = lbv[bj][1][j];
                                v0[j] = __logf(l0 + (1.0f - l0) * fast_sigmoid(v0[j]));
                                v1[j] = __logf(l1 + (1.0f - l1) * fast_sigmoid(v1[j]));
                            }
                        }
                        u32x4 w; w.x = cvt_pk_bf16(v0[0], v0[1]); w.y = cvt_pk_bf16(v0[2], v0[3]); w.z = cvt_pk_bf16(v1[0], v1[1]); w.w = cvt_pk_bf16(v1[2], v1[3]);
                        *(u32x4*)(proj + (size_t)row * 4096 + lc0 + bj * HALF) = w;
                    }
                }
        }
    }
};

struct EpiRes {
    static constexpr bool PERM = false, AFTER_DRAIN = false;
    const float* xres; float* t; const float* gate; float alpha;
    __device__ __forceinline__ void operator()(const f32x4 (&acc)[2][2][4][2], const Unit& u, int wr, int wc, int fr, int fq) const {
        const int row0 = u.pm * BM + wr * 64 + fr, col0 = u.pn * BM + wc * 32 + 4 * fq;
        const int b = u.pm >> 3;
        f32x4 gv[2][2];
#pragma unroll
        for (int bj = 0; bj < 2; ++bj)
#pragma unroll
            for (int n = 0; n < 2; ++n) gv[bj][n] = *(const f32x4*)(gate + (size_t)b * 3072 + 2048 + col0 + bj * HALF + n * 16) + 1.0f;
#pragma unroll
        for (int ai = 0; ai < 2; ++ai)
#pragma unroll
            for (int m = 0; m < 4; ++m) {
                const size_t off = (size_t)(row0 + ai * HALF + m * 16) * 1024 + col0;
#pragma unroll
                for (int bj = 0; bj < 2; ++bj)
#pragma unroll
                    for (int n = 0; n < 2; ++n) {
                        const f32x4 xr = *(const f32x4*)(xres + off + bj * HALF + n * 16);
                        *(f32x4*)(t + off + bj * HALF + n * 16) = xr * alpha + gv[bj][n] * acc[ai][bj][m][n];
                    }
            }
    }
};

template <int ldh, int nNloc> struct EpiGU {
    static constexpr bool PERM = false, AFTER_DRAIN = false;
    bf16_t* hid;
    __device__ __forceinline__ void operator()(const f32x4 (&acc)[2][2][4][2], const Unit& u, int wr, int wc, int fr, int fq) const {
        const int row0 = u.pm * BM + wr * 64 + fr, col0 = (u.pn % nNloc) * HALF + wc * 32 + 8 * fq;
#pragma unroll
        for (int ai = 0; ai < 2; ++ai)
#pragma unroll
            for (int m = 0; m < 4; ++m) {
                const f32x4 g0 = acc[ai][0][m][0], g1 = acc[ai][0][m][1], u0 = acc[ai][1][m][0], u1 = acc[ai][1][m][1];
                f32x4 h0, h1;
#pragma unroll
                for (int j = 0; j < 4; ++j) { h0[j] = fast_silu(g0[j]) * u0[j]; h1[j] = fast_silu(g1[j]) * u1[j]; }
                u32x4 w; w.x = cvt_pk_bf16(h0[0], h0[1]); w.y = cvt_pk_bf16(h0[2], h0[3]); w.z = cvt_pk_bf16(h1[0], h1[1]); w.w = cvt_pk_bf16(h1[2], h1[3]);
                *(u32x4*)(hid + (size_t)(row0 + ai * HALF + m * 16) * ldh + col0) = w;
            }
    }
};


struct EpiGU8 {
    static constexpr bool PERM = false, AFTER_DRAIN = false;
    unsigned char* hid;
    __device__ __forceinline__ void operator()(const f32x4 (&acc)[2][2][4][2], const Unit& u, int wr, int wc, int fr, int fq) const {
        const int row0 = u.pm * BM + wr * 64 + fr, col0 = (u.pn % 28) * HALF + wc * 32 + 8 * fq;
        const float inv = 1.0f / 256.0f;
#pragma unroll
        for (int ai = 0; ai < 2; ++ai)
#pragma unroll
            for (int m = 0; m < 4; ++m) {
                const f32x4 g0 = acc[ai][0][m][0] * inv, g1 = acc[ai][0][m][1] * inv, u0 = acc[ai][1][m][0] * inv, u1 = acc[ai][1][m][1] * inv;
                f32x4 h0, h1;
#pragma unroll
                for (int j = 0; j < 4; ++j) { h0[j] = fminf(fmaxf(fast_silu(g0[j]) * u0[j] * 8.0f, -448.f), 448.f); h1[j] = fminf(fmaxf(fast_silu(g1[j]) * u1[j] * 8.0f, -448.f), 448.f); }
                int w0 = 0, w1 = 0;
                w0 = __builtin_amdgcn_cvt_pk_fp8_f32(h0[0], h0[1], w0, false); w0 = __builtin_amdgcn_cvt_pk_fp8_f32(h0[2], h0[3], w0, true);
                w1 = __builtin_amdgcn_cvt_pk_fp8_f32(h1[0], h1[1], w1, false); w1 = __builtin_amdgcn_cvt_pk_fp8_f32(h1[2], h1[3], w1, true);
                u32x2 w; w.x = (unsigned)w0; w.y = (unsigned)w1;
                *(u32x2*)(hid + (size_t)(row0 + ai * HALF + m * 16) * 3584 + col0) = w;
            }
    }
};

struct EpiMoeDn {
    static constexpr bool PERM = false, AFTER_DRAIN = false;
    const unsigned* rowinfo; bf16_t* yslot;
    __device__ __forceinline__ void operator()(const f32x4 (&acc)[2][2][4][2], const Unit& u, int wr, int wc, int fr, int fq) const {
        const int row0 = u.pm * BM + wr * 64 + fr, col0 = (u.pn & 3) * BM + wc * 32 + 4 * fq;
#pragma unroll
        for (int ai = 0; ai < 2; ++ai)
#pragma unroll
            for (int m = 0; m < 4; ++m) {
                const int row = row0 + ai * HALF + m * 16;
                const u32x2 inf = *(const u32x2*)(rowinfo + 2 * (size_t)row);
                if (inf.x != 0xffffffffu) {
                    const float w = __uint_as_float(inf.y) * (1.0f / 2048.0f);
                    bf16_t* dst = yslot + ((size_t)(inf.x >> 16) * 16384 + (inf.x & 0xffffu)) * 1024 + col0;
#pragma unroll
                    for (int bj = 0; bj < 2; ++bj)
#pragma unroll
                        for (int n = 0; n < 2; ++n) {
                            const f32x4 v = acc[ai][bj][m][n] * w;
                            u32x2 o; o.x = cvt_pk_bf16(v[0], v[1]); o.y = cvt_pk_bf16(v[2], v[3]);
                            *(u32x2*)(dst + bj * HALF + n * 16) = o;
                        }
                }
            }
    }
};

struct MoeOrder : StaticOrder {
    int ts1, ts2, ts3, ts4, ts5, ts6, ts7, nNloc;
    __device__ __forceinline__ bool next(int i, Unit& u) const {
        if (!StaticOrder::next(i, u)) return false;
        const int e = (u.pm >= ts1) + (u.pm >= ts2) + (u.pm >= ts3) + (u.pm >= ts4) + (u.pm >= ts5) + (u.pm >= ts6) + (u.pm >= ts7);
        u.pn += e * nNloc; return true;
    }
};

typedef int i32x8 __attribute__((ext_vector_type(8)));
__device__ __forceinline__ i32x8 cat8(bf16x8 a, bf16x8 b) { typedef int i32x4 __attribute__((ext_vector_type(4))); const i32x4 x = __builtin_bit_cast(i32x4, a), y = __builtin_bit_cast(i32x4, b); return (i32x8){x[0], x[1], x[2], x[3], y[0], y[1], y[2], y[3]}; }
template <class Epi, class Sched, bool ALIGN_EPI = false, bool SP2 = false, bool F8 = false>
__device__ __forceinline__ void gemm_phase(PG8_LAS unsigned char* lds, const Gemm g, const Sched& S, const Epi& E) {
    const int tid = threadIdx.x, wid = __builtin_amdgcn_readfirstlane(tid >> 6), lane = tid & 63, wr = wid >> 2, wc = wid & 3, fr = lane & 15, fq = lane >> 4;
    const int K = g.K, nt = K / BK;
    unsigned voffA[2], voffB[2];
#pragma unroll
    for (int i = 0; i < 2; ++i) { int R, C; stage_rc(tid * 16 + i * 8192, R, C); const int Rb = Epi::PERM ? ((R & ~31) + perm32(R & 31)) : R;
        voffA[i] = (unsigned)(R * K + C) * 2u; voffB[i] = (unsigned)(Rb * K + C) * 2u; }
    const size_t kstep = (size_t)(BK * 2);
    const size_t hstep = (size_t)HALF * K * 2;
    const size_t tstep = 2 * hstep;
    const unsigned ldsw = (unsigned)wid * 1024u;
    const int aoff = lds_byte(wr * 64 + fr, fq * 8), boff = lds_byte(wc * 32 + fr, fq * 8);
#define PG8_SA(b, h) (((b) * 2 + (h)) * HTB)
#define PG8_SB(b, h) ((4 + (b) * 2 + (h)) * HTB)
#define PG8_STAGE(bufoff, gbase, voff) do { _Pragma("unroll") for (int _i = 0; _i < 2; ++_i) \
        __builtin_amdgcn_global_load_lds((const unsigned*)((const char*)(gbase) + (voff)[_i]), (PG8_LAS unsigned*)(lds + (bufoff) + ldsw + _i * 8192), 16, 0, 0); } while (0)
#define PG8_LDA(dst, b, h) do { _Pragma("unroll") for (int m = 0; m < 4; ++m) _Pragma("unroll") for (int k = 0; k < 2; ++k) dst[m][k] = *(const PG8_LAS bf16x8*)(lds + PG8_SA(b, h) + aoff + m * 2048 + k * 1024); } while (0)
#define PG8_LDB(dst, b, h) do { _Pragma("unroll") for (int n = 0; n < 2; ++n) _Pragma("unroll") for (int k = 0; k < 2; ++k) dst[n][k] = *(const PG8_LAS bf16x8*)(lds + PG8_SB(b, h) + boff + n * 2048 + k * 1024); } while (0)
#define PG8_MMA(ai, bj, At, Bt) do { __builtin_amdgcn_s_setprio(1); _Pragma("unroll") for (int m = 0; m < 4; ++m) _Pragma("unroll") for (int n = 0; n < 2; ++n) { \
        if constexpr (F8) { asm volatile("s_nop 1\n\tv_mfma_scale_f32_16x16x128_f8f6f4 %0, %1, %2, %0, %3, %3 op_sel_hi:[0,0,0]" : "+v"(acc[ai][bj][m][n]) : "v"(cat8(Bt[n][0], Bt[n][1])), "v"(cat8(At[m][0], At[m][1])), "v"(f8one)); } \
        else { _Pragma("unroll") for (int k = 0; k < 2; ++k) acc[ai][bj][m][n] = __builtin_amdgcn_mfma_f32_16x16x32_bf16(Bt[n][k], At[m][k], acc[ai][bj][m][n], 0, 0, 0); } } \
        __builtin_amdgcn_s_setprio(0); } while (0)
#define PG8_WAIT_V(n) asm volatile("s_waitcnt vmcnt(" #n ")" ::: "memory")
#define PG8_WAIT_L(n) asm volatile("s_waitcnt lgkmcnt(" #n ")" ::: "memory")
#define PG8_BAR __builtin_amdgcn_s_barrier()
#define PG8_SCHED __builtin_amdgcn_sched_barrier(0)
    Unit cur, nxt; int ui = 0;
    if (!S.next(0, cur)) return;
    f32x4 acc[2][2][4][2];
#pragma unroll
    for (int a = 0; a < 2; ++a)
#pragma unroll
        for (int b = 0; b < 2; ++b)
#pragma unroll
            for (int m = 0; m < 4; ++m)
#pragma unroll
                for (int n = 0; n < 2; ++n) acc[a][b][m][n] = (f32x4){0.f, 0.f, 0.f, 0.f};
    bf16x8 At[4][2], B0[2][2], B1[2][2];
    const int f8one = 0x7F7F7F7F;
    const char* cA = (const char*)g.A + (size_t)cur.pm * tstep; const char* cB = (const char*)g.Bt + (size_t)cur.pn * tstep;
    S.a_ready(cur);
    if constexpr (SP2) {
        PG8_STAGE(PG8_SB(0, 0), cB, voffB); PG8_STAGE(PG8_SB(0, 1), cB + hstep, voffB); PG8_STAGE(PG8_SA(0, 0), cA, voffA); PG8_STAGE(PG8_SA(0, 1), cA + hstep, voffA);
        if (wr == 1) PG8_BAR;
        PG8_WAIT_V(2); PG8_BAR;
        PG8_STAGE(PG8_SB(1, 0), cB + kstep, voffB); PG8_STAGE(PG8_SA(1, 0), cA + kstep, voffA); PG8_STAGE(PG8_SB(1, 1), cB + hstep + kstep, voffB);
        PG8_WAIT_V(6); PG8_BAR;
    } else {
        PG8_STAGE(PG8_SB(0, 0), cB, voffB); PG8_STAGE(PG8_SA(0, 0), cA, voffA); PG8_STAGE(PG8_SB(0, 1), cB + hstep, voffB); PG8_STAGE(PG8_SA(0, 1), cA + hstep, voffA);
        if (wr == 1) PG8_BAR;
        PG8_WAIT_V(4); PG8_BAR;
        PG8_STAGE(PG8_SB(1, 0), cB + kstep, voffB); PG8_STAGE(PG8_SA(1, 0), cA + kstep, voffA); PG8_STAGE(PG8_SB(1, 1), cB + hstep + kstep, voffB);
        PG8_WAIT_V(6); PG8_BAR;
    }
    for (;;) {
        const bool has_next = S.next(ui + 1, nxt);
        const char* nA = has_next ? (const char*)g.A + (size_t)nxt.pm * tstep : cA; const char* nB = has_next ? (const char*)g.Bt + (size_t)nxt.pn * tstep : cB;
#pragma unroll 1
        for (int t = 0; t < nt; t += 2) {
            const bool last = (t == nt - 2);
            const char* a1 = cA + (size_t)(t + 1) * kstep;
            const char* a2 = last ? nA : cA + (size_t)(t + 2) * kstep; const char* b2 = last ? nB : cB + (size_t)(t + 2) * kstep;
            const char* a3 = a2 + kstep; const char* b3 = b2 + kstep;
            if (last && has_next) S.a_ready(nxt);
            if constexpr (SP2) {
            PG8_LDB(B0, 0, 0); PG8_LDB(B1, 0, 1); PG8_SCHED; PG8_LDA(At, 0, 0); PG8_STAGE(PG8_SA(1, 1), a1 + hstep, voffA);
            PG8_WAIT_V(8); PG8_WAIT_L(0); PG8_BAR; PG8_MMA(0, 0, At, B0); PG8_MMA(0, 1, At, B1); PG8_BAR; PG8_SCHED;
            PG8_LDA(At, 0, 1); PG8_STAGE(PG8_SB(0, 0), b2, voffB); PG8_STAGE(PG8_SB(0, 1), b2 + hstep, voffB); PG8_STAGE(PG8_SA(0, 0), a2, voffA);
            PG8_WAIT_V(8); PG8_WAIT_L(0); PG8_BAR; PG8_MMA(1, 0, At, B0); PG8_MMA(1, 1, At, B1); PG8_BAR; PG8_SCHED;
            PG8_LDB(B0, 1, 0); PG8_LDB(B1, 1, 1); PG8_SCHED; PG8_LDA(At, 1, 0); PG8_STAGE(PG8_SA(0, 1), a2 + hstep, voffA);
            PG8_WAIT_V(8); PG8_WAIT_L(0); PG8_BAR; PG8_MMA(0, 0, At, B0); PG8_MMA(0, 1, At, B1); PG8_BAR; PG8_SCHED;
            PG8_LDA(At, 1, 1); PG8_STAGE(PG8_SB(1, 0), b3, voffB); PG8_STAGE(PG8_SB(1, 1), b3 + hstep, voffB); PG8_STAGE(PG8_SA(1, 0), a3, voffA);
            PG8_WAIT_V(8); PG8_WAIT_L(0); PG8_BAR; PG8_MMA(1, 0, At, B0); PG8_MMA(1, 1, At, B1); PG8_BAR; PG8_SCHED;
            } else {
            PG8_LDB(B0, 0, 0); PG8_SCHED; PG8_LDA(At, 0, 0); PG8_STAGE(PG8_SA(1, 1), a1 + hstep, voffA);
            PG8_WAIT_L(8); PG8_BAR; PG8_WAIT_L(0); PG8_MMA(0, 0, At, B0); PG8_BAR; PG8_SCHED;
            PG8_LDB(B1, 0, 1); PG8_STAGE(PG8_SB(0, 0), b2, voffB);
            PG8_BAR; PG8_WAIT_L(0); PG8_MMA(0, 1, At, B1); PG8_BAR;
            PG8_LDA(At, 0, 1); PG8_STAGE(PG8_SA(0, 0), a2, voffA);
            PG8_BAR; PG8_WAIT_L(0); PG8_MMA(1, 0, At, B0); PG8_BAR; PG8_SCHED;
            PG8_STAGE(PG8_SB(0, 1), b2 + hstep, voffB);
            PG8_WAIT_V(6); PG8_BAR; PG8_MMA(1, 1, At, B1); PG8_BAR;
            PG8_LDB(B0, 1, 0); PG8_SCHED; PG8_LDA(At, 1, 0); PG8_STAGE(PG8_SA(0, 1), a2 + hstep, voffA);
            PG8_WAIT_L(8); PG8_BAR; PG8_WAIT_L(0); PG8_MMA(0, 0, At, B0); PG8_BAR; PG8_SCHED;
            PG8_LDB(B1, 1, 1); PG8_STAGE(PG8_SB(1, 0), b3, voffB);
            PG8_BAR; PG8_WAIT_L(0); PG8_MMA(0, 1, At, B1); PG8_BAR;
            PG8_LDA(At, 1, 1); PG8_STAGE(PG8_SA(1, 0), a3, voffA);
            PG8_BAR; PG8_WAIT_L(0); PG8_MMA(1, 0, At, B0); PG8_BAR; PG8_SCHED;
            PG8_STAGE(PG8_SB(1, 1), b3 + hstep, voffB);
            PG8_WAIT_V(6); PG8_BAR; PG8_MMA(1, 1, At, B1); PG8_BAR;
            }
        }
        if constexpr (F8) asm volatile("s_nop 15\n\ts_nop 15" ::: "memory");
        if constexpr (ALIGN_EPI) { if (wr == 0) PG8_BAR; }
        if constexpr (!Epi::AFTER_DRAIN) { E(acc, cur, wr, wc, fr, fq); S.done(cur); }
        if (!has_next) break;
#pragma unroll
        for (int a = 0; a < 2; ++a)
#pragma unroll
            for (int b = 0; b < 2; ++b)
#pragma unroll
                for (int m = 0; m < 4; ++m)
#pragma unroll
                    for (int n = 0; n < 2; ++n) acc[a][b][m][n] = (f32x4){0.f, 0.f, 0.f, 0.f};
        cur = nxt; cA = nA; cB = nB; ++ui;
        if constexpr (ALIGN_EPI) { if (wr == 1) PG8_BAR; }
    }
    PG8_WAIT_V(0);
    if constexpr (!ALIGN_EPI) { if (wr == 0) PG8_BAR; }
    PG8_BAR;
    if constexpr (Epi::AFTER_DRAIN) { E.fused(acc, cur, wr, wc, fr, fq, lds, wid, lane); S.done(cur); }
#undef PG8_SA
#undef PG8_SB
#undef PG8_STAGE
#undef PG8_LDA
#undef PG8_LDB
#undef PG8_MMA
#undef PG8_WAIT_V
#undef PG8_WAIT_L
#undef PG8_BAR
#undef PG8_SCHED
}
}


#ifndef PG8_SP2
#define PG8_SP2 true
#endif
#ifndef PG8_ALIGN
#define PG8_ALIGN true
#endif
#ifndef MK_N_LAUNCHES
#define MK_N_LAUNCHES 1
#endif

constexpr int NB = 8, SEQ = 2048, DM = 1024, MT = NB * SEQ;
constexpr int INC = 4096, NAH = 8;
constexpr int FFD = 2752, FFDP = 2816, NEX = 8, FFE = 3584;
constexpr int MOE_ROWS = 2 * MT + NEX * 256;
constexpr float DN_ALPHA = 1.41421356237309515f;
constexpr float LN_EPS = 1e-5f, RMS_EPS = 1e-6f;
constexpr int NWAVES = 8;

constexpr size_t MiB = 1u << 20;
constexpr size_t WS_CTL = 0, CTL_ZERO_BYTES = 1 * MiB;
constexpr size_t WS_ADA = 1 * MiB;
constexpr size_t WS_LB = 1 * MiB + 512 * 1024;
constexpr size_t WS_ROPE = 2 * MiB;
constexpr size_t WS_ROUTE = 6 * MiB;
constexpr size_t WS_ROWINFO = 6 * MiB + 512 * 1024;
constexpr size_t WS_WMGU = 8 * MiB;
constexpr size_t WS_WMDN = 120 * MiB;
constexpr size_t WS_WIN = 176 * MiB;
constexpr size_t WS_WOUT = 192 * MiB;
constexpr size_t WS_WGU = 196 * MiB;
constexpr size_t WS_WDN = 207 * MiB;
constexpr size_t WS_ABUF = 213 * MiB;
constexpr size_t WS_GATH = 176 * MiB;
constexpr size_t WS_YSLOT = 176 * MiB;
constexpr size_t WS_BIG = 245 * MiB;
constexpr size_t WS_PROJ = WS_BIG;
constexpr size_t WS_ATTO = WS_BIG + 128 * MiB;
constexpr size_t WS_LSE = WS_BIG + 176 * MiB;
constexpr size_t WS_ODIR = WS_BIG + 178 * MiB;
constexpr size_t WS_HID = WS_BIG;
constexpr size_t WS_END = 483 * MiB;
static_assert(WS_GATH + (size_t)MOE_ROWS * 1024 * 2 <= WS_BIG && WS_HID + (size_t)MOE_ROWS * FFE * 2 <= WS_END && WS_WDN + (size_t)1024 * FFDP * 2 <= WS_ABUF, "d_ws map");
constexpr int CW_TMO = 0, CW_BAR = 4096, CW_CNT = 16384;

constexpr int LDS_BYTES = 147456;
constexpr int MISC_OFF = 131072 + 320;

#define GAS __attribute__((address_space(1)))
#define LAS __attribute__((address_space(3)))
typedef unsigned short bf16;
typedef unsigned v4u __attribute__((ext_vector_type(4)));
typedef unsigned v2u __attribute__((ext_vector_type(2)));
typedef float f32x4 __attribute__((ext_vector_type(4)));
typedef GAS unsigned gu32;
#define RLX_AGENT __ATOMIC_RELAXED, __HIP_MEMORY_SCOPE_AGENT
#define LDS_WAIT() asm volatile("s_waitcnt lgkmcnt(0)" ::: "memory")
__device__ __forceinline__ unsigned f2bf(float f) { unsigned u = __builtin_bit_cast(unsigned, f); return (u + 0x7fffu + ((u >> 16) & 1u)) >> 16; }
__device__ __forceinline__ unsigned pk2(float lo, float hi) { return f2bf(lo) | (f2bf(hi) << 16); }
__device__ __forceinline__ float bflo(unsigned w) { return __uint_as_float(w << 16); }
__device__ __forceinline__ float bfhi(unsigned w) { return __uint_as_float(w & 0xffff0000u); }
__device__ __forceinline__ float bf1(bf16 h) { return __uint_as_float(((unsigned)h) << 16); }

#define XB_TMO      128
#define XB_XCNT(j)  (256  + 64 * (j))
#define XB_XSUB(j)  (1280 + 64 * (j))
#define XB_XGEN(j)  (2304 + 64 * (j))
#define XB_TOP      3328
#define XB_TOPGEN   3392
#define XCD_BAR_WORDS 3456
#define XB_SPIN_CAP (1u << 18)

__device__ __forceinline__ unsigned xb_ld(unsigned* p)              { return __hip_atomic_load(p, __ATOMIC_RELAXED, __HIP_MEMORY_SCOPE_AGENT); }
__device__ __forceinline__ unsigned xb_add(unsigned* p, unsigned v) { return __hip_atomic_fetch_add(p, v, __ATOMIC_RELAXED, __HIP_MEMORY_SCOPE_AGENT); }
__device__ __forceinline__ unsigned xb_xcc_id() { return (unsigned)__builtin_amdgcn_s_getreg((3 << 11) | 20) & 0xFu; }
#define XB_SPIN(cond, bar) do { unsigned _sp = 0; while (cond) { __builtin_amdgcn_s_sleep(1); \
    if ((++_sp & 255u) == 0u) { if (xb_ld(&(bar)[XB_TMO])) break; if (_sp > XB_SPIN_CAP) { atomicAdd(&(bar)[XB_TMO], 1u); break; } } } } while (0)

struct XcdBarrier {
    unsigned* bar; unsigned x;
    volatile LAS unsigned* st;
};

__device__ __forceinline__ XcdBarrier xcd_barrier_post(unsigned* bar, volatile LAS unsigned* st) {
    XcdBarrier b; b.bar = bar; b.x = xb_xcc_id(); b.st = st;
    if (threadIdx.x == 0) (void)xb_add(&bar[XB_XCNT(b.x)], 1u);
    return b;
}
__device__ __forceinline__ void xcd_barrier_complete(unsigned* bar, unsigned x, unsigned& nloc, unsigned& nx) {
    const unsigned G = gridDim.x * gridDim.y * gridDim.z;
    unsigned sum, cnt, mine, sp = 0u;
    for (;;) {
        sum = 0u; cnt = 0u; mine = 0u;
#pragma unroll
        for (unsigned j = 0; j < 16; ++j) { const unsigned c = xb_ld(&bar[XB_XCNT(j)]); sum += c; cnt += (c > 0u) ? 1u : 0u; mine = (j == x) ? c : mine; }
        if (sum == G) break;
        __builtin_amdgcn_s_sleep(1);
        if ((++sp & 255u) == 0u) { if (xb_ld(&bar[XB_TMO])) break; if (sp > XB_SPIN_CAP) { atomicAdd(&bar[XB_TMO], 1u); break; } }
    }
    nloc = mine > 0u ? mine : 1u; nx = cnt > 0u ? cnt : 1u;
}

__device__ __forceinline__ void xcd_barrier(const XcdBarrier& b) {
    asm volatile("s_waitcnt vmcnt(0)" ::: "memory");
    __syncthreads();
    if (threadIdx.x == 0) {
        unsigned* bar = b.bar;
        __builtin_amdgcn_s_waitcnt(0);
        unsigned nloc = b.st[0], nx = b.st[1];
        if (nloc == 0u) { xcd_barrier_complete(bar, b.x, nloc, nx); b.st[0] = nloc; b.st[1] = nx; }
        const unsigned old = xb_add(&bar[XB_XSUB(b.x)], 1u);
        const unsigned gen = old / nloc;
        if (old + 1u == (gen + 1u) * nloc) {
            __builtin_amdgcn_fence(__ATOMIC_RELEASE, "agent");
            asm volatile("s_waitcnt vmcnt(0)" ::: "memory");
            const unsigned og = xb_add(&bar[XB_TOP], 1u);
            const unsigned tg = og / nx;
            if (og + 1u == (tg + 1u) * nx) xb_add(&bar[XB_TOPGEN], 1u);
            else XB_SPIN(xb_ld(&bar[XB_TOPGEN]) == tg, bar);
            __builtin_amdgcn_fence(__ATOMIC_ACQUIRE, "agent");
            xb_add(&bar[XB_XGEN(b.x)], 1u);
            asm volatile("s_waitcnt vmcnt(0)" ::: "memory");
        } else {
            XB_SPIN(xb_ld(&bar[XB_XGEN(b.x)]) == gen, bar);
            __builtin_amdgcn_fence(__ATOMIC_ACQUIRE, "agent");
            asm volatile("s_waitcnt vmcnt(0)" ::: "memory");
        }
    }
    __syncthreads();
}


struct Args { const void* in[19]; float* out; unsigned char* ws; int ph_lo, ph_hi; };

struct Frame {
    LAS unsigned char* lds; unsigned char* ws; gu32* ctl;
    int tid, lane, wave, G, vcu;
};

__device__ __forceinline__ float wave_sum(float v) {
#pragma unroll
    for (int o = 1; o < 64; o <<= 1) v += __shfl_xor(v, o);
    return v;
}

typedef short s16x4p __attribute__((ext_vector_type(4)));
constexpr int P0_STR = 192, P0_STR2 = 144;
__device__ __forceinline__ unsigned cvtpk2(float lo, float hi) { unsigned r; asm("v_cvt_pk_bf16_f32 %0, %1, %2" : "=v"(r) : "v"(lo), "v"(hi)); return r; }
template <int KIND>
__device__ __forceinline__ int p0_rowmap(int lc, int sel) {
    if (KIND == 0) {
        if (lc < 1024) { const int d = lc & 63; return (lc & ~63) + 32 * ((d >> 4) & 1) + 16 * (d >> 5) + (d & 15); }
        const int x = lc & 31; return (lc & ~31) + 16 * ((x >> 2) & 1) + 4 * (x >> 3) + (x & 3);
    } else if (KIND == 1) return lc;
    const int x = lc & 31; return 256 * (lc >> 7) + 128 * sel + 32 * ((lc >> 5) & 3) + 16 * ((x >> 2) & 1) + 4 * (x >> 3) + (x & 3);
}
template <int KIND>
__device__ __forceinline__ void p0_tile(const float* W, int ldn, int k0, int n0, bool zero, bf16* dst, int ldk, int sel, LAS unsigned char* scr, int lane) {
    const int g = lane >> 4, i = lane & 15;
    if (zero) {
#pragma unroll
        for (int r = 0; r < 8; ++r) { const int n = 8 * r + (lane >> 3); *(v4u*)(dst + (size_t)p0_rowmap<KIND>(n0 + n, sel) * ldk + k0 + 8 * (lane & 7)) = (v4u){0u, 0u, 0u, 0u}; }
        return;
    }
    f32x4 v[16];
    const float* src = W + (size_t)(k0 + g) * ldn + n0 + 4 * i;
#pragma unroll
    for (int j = 0; j < 16; ++j) v[j] = *(const f32x4*)(src + (size_t)(4 * j) * ldn);
#pragma unroll
    for (int j = 0; j < 16; ++j) { v2u w; w.x = cvtpk2(v[j][0], v[j][1]); w.y = cvtpk2(v[j][2], v[j][3]); *(LAS v2u*)(scr + (4 * j + g) * P0_STR + 8 * i) = w; }
    const unsigned sb = (unsigned)(size_t)scr + (unsigned)((i >> 2) * P0_STR + 32 * g + 8 * (i & 3));
    v4u t[8];
#pragma unroll
    for (int r = 0; r < 8; ++r) {
        const v2u lo = __builtin_bit_cast(v2u, __builtin_amdgcn_ds_read_tr16_b64_v4i16((LAS s16x4p*)(sb + (8 * r) * P0_STR)));
        const v2u hi = __builtin_bit_cast(v2u, __builtin_amdgcn_ds_read_tr16_b64_v4i16((LAS s16x4p*)(sb + (8 * r + 4) * P0_STR)));
        t[r].x = lo.x; t[r].y = lo.y; t[r].z = hi.x; t[r].w = hi.y;
    }
    asm volatile("s_waitcnt lgkmcnt(0)" ::: "memory");
#pragma unroll
    for (int r = 0; r < 8; ++r) *(LAS v4u*)(scr + (16 * g + i) * P0_STR2 + 16 * r) = t[r];
#pragma unroll
    for (int r = 0; r < 8; ++r) {
        const int n = 8 * r + (lane >> 3);
        const v4u o = *(const LAS v4u*)(scr + n * P0_STR2 + 16 * (lane & 7));
        *(v4u*)(dst + (size_t)p0_rowmap<KIND>(n0 + n, sel) * ldk + k0 + 8 * (lane & 7)) = o;
    }
}

template <int KIND>
__device__ __forceinline__ void p0_tile8(const float* W, int ldn, int k0, int n0, unsigned char* dst, int ldk, int sel, float scale, LAS unsigned char* scr, int lane) {
    const int g = lane >> 4, i = lane & 15;
    const float* src = W + (size_t)(k0 + 2 * g) * ldn + n0 + 4 * i;
#pragma unroll
    for (int hf = 0; hf < 2; ++hf) {
        f32x4 ve[8], vo[8];
#pragma unroll
        for (int j = 0; j < 8; ++j) { ve[j] = *(const f32x4*)(src + (size_t)(8 * (8 * hf + j)) * ldn); vo[j] = *(const f32x4*)(src + (size_t)(8 * (8 * hf + j) + 1) * ldn); }
#pragma unroll
        for (int j = 0; j < 8; ++j) {
            const f32x4 a = ve[j] * scale, b = vo[j] * scale; int w0 = 0, w1 = 0;
            w0 = __builtin_amdgcn_cvt_pk_fp8_f32(a[0], b[0], w0, false); w0 = __builtin_amdgcn_cvt_pk_fp8_f32(a[1], b[1], w0, true);
            w1 = __builtin_amdgcn_cvt_pk_fp8_f32(a[2], b[2], w1, false); w1 = __builtin_amdgcn_cvt_pk_fp8_f32(a[3], b[3], w1, true);
            v2u w; w.x = (unsigned)w0; w.y = (unsigned)w1; *(LAS v2u*)(scr + (4 * (8 * hf + j) + g) * P0_STR + 8 * i) = w;
        }
    }
    const unsigned sb = (unsigned)(size_t)scr + (unsigned)((i >> 2) * P0_STR + 32 * g + 8 * (i & 3));
    v4u t[8];
#pragma unroll
    for (int r = 0; r < 8; ++r) {
        const v2u lo = __builtin_bit_cast(v2u, __builtin_amdgcn_ds_read_tr16_b64_v4i16((LAS s16x4p*)(sb + (8 * r) * P0_STR)));
        const v2u hi = __builtin_bit_cast(v2u, __builtin_amdgcn_ds_read_tr16_b64_v4i16((LAS s16x4p*)(sb + (8 * r + 4) * P0_STR)));
        t[r].x = lo.x; t[r].y = lo.y; t[r].z = hi.x; t[r].w = hi.y;
    }
    asm volatile("s_waitcnt lgkmcnt(0)" ::: "memory");
#pragma unroll
    for (int r = 0; r < 8; ++r) *(LAS v4u*)(scr + (16 * g + i) * P0_STR2 + 16 * r) = t[r];
#pragma unroll
    for (int r = 0; r < 8; ++r) {
        const int n = 8 * r + (lane >> 3);
        const v4u o = *(const LAS v4u*)(scr + n * P0_STR2 + 16 * (lane & 7));
        *(v4u*)(dst + (size_t)p0_rowmap<KIND>(n0 + n, sel) * ldk + k0 + 16 * (lane & 7)) = o;
    }
}

__device__ __forceinline__ void p0_prologue(Frame& F, const Args& a) {
    const float* c_in = (const float*)a.in[1]; const int* positions = (const int*)a.in[2];
    const float* w_in = (const float*)a.in[3]; const float* w_out = (const float*)a.in[4];
    const float* lb_logits = (const float*)a.in[7]; const float* ada_w = (const float*)a.in[8]; const float* ada_b = (const float*)a.in[9];
    const float* ffn_g = (const float*)a.in[12]; const float* ffn_u = (const float*)a.in[13]; const float* ffn_d = (const float*)a.in[14];
    const float* moe_g = (const float*)a.in[16]; const float* moe_u = (const float*)a.in[17]; const float* moe_d = (const float*)a.in[18];
    float* ada = (float*)(F.ws + WS_ADA); float* lbt = (float*)(F.ws + WS_LB); float* rope = (float*)(F.ws + WS_ROPE);
    {
        LAS float* cact = (LAS float*)F.lds;
        LAS float* red = (LAS float*)(F.lds + 32768);
        for (int i = F.tid; i < NB * DM; i += 512) { const int bb = i >> 10, k = i & 1023; const float v = c_in[i]; cact[k * 8 + bb] = v / (1.0f + __expf(-v)); }
        __syncthreads();
        for (int item = F.vcu; item < 256; item += F.G) {
            const int ls = item >> 6, cb = item & 63;
            const int col = F.tid % 48, sl = F.tid / 48;
            float acc[8];
#pragma unroll
            for (int bb = 0; bb < 8; ++bb) acc[bb] = 0.f;
            if (sl < 8) {
                const float* w = ada_w + ((size_t)ls * DM + sl * 128) * 3072 + cb * 48 + col;
#pragma unroll 8
                for (int k = 0; k < 128; ++k) { const float wv = w[(size_t)k * 3072];
                    const f32x4 c0 = *(const LAS f32x4*)(cact + (sl * 128 + k) * 8), c1 = *(const LAS f32x4*)(cact + (sl * 128 + k) * 8 + 4);
                    acc[0] += c0[0] * wv; acc[1] += c0[1] * wv; acc[2] += c0[2] * wv; acc[3] += c0[3] * wv; acc[4] += c1[0] * wv; acc[5] += c1[1] * wv; acc[6] += c1[2] * wv; acc[7] += c1[3] * wv; }
#pragma unroll
                for (int bb = 0; bb < 8; ++bb) red[(sl * 48 + col) * 8 + bb] = acc[bb];
            }
            __syncthreads();
            if (F.tid < 384) {
                const int c2 = F.tid >> 3, bb = F.tid & 7; float sum = 0.f;
#pragma unroll
                for (int s2 = 0; s2 < 8; ++s2) sum += red[(s2 * 48 + c2) * 8 + bb];
                const int n = cb * 48 + c2;
                ada[(size_t)(ls * 8 + bb) * 3072 + n] = sum + ada_b[ls * 3072 + n];
            }
            __syncthreads();
        }
    }
    const int gt = F.vcu * 512 + F.tid, GT = F.G * 512;
    for (int i = gt; i < MT * 32; i += GT) {
        const int m = i >> 5, d = i & 31;
        const float ang = (float)positions[m] * exp2f(-(float)d * 0.41524101186092029f);
        const double rev = (double)ang * 0.15915494309189533577;
        const float fr = (float)(rev - __builtin_rint(rev));
        rope[2 * (size_t)i] = __builtin_amdgcn_cosf(fr); rope[2 * (size_t)i + 1] = __builtin_amdgcn_sinf(fr);
    }
    for (int i = gt; i < 2 * 512; i += GT) {
        const float a0 = lb_logits[i], a1 = lb_logits[1024 + i];
        lbt[i] = 0.f; lbt[1024 + i] = 1.0f / (1.0f + __expf(a0 - a1));
    }
    LAS unsigned char* scr = F.lds + 32768 + F.wave * (64 * P0_STR);
    const int gw = F.vcu * NWAVES + F.wave, NGW = F.G * NWAVES;
    constexpr int I0 = 2 * 16 * 64, I1 = 2 * 16 * 16, I2 = 2 * 16 * 44, I3 = 44 * 16, I4 = 8 * 2 * 8 * 56, I5 = 8 * 28 * 16;
    constexpr int NITEMS = I0 + I1 + I2 + I3 + I4 + I5;
    for (int it = gw; it < NITEMS; it += NGW) {
        int r = it;
        if (r < I4) { const int e = r / 896, q0 = r % 896, sel = q0 / 448, q = q0 % 448, kb = q / 56, nb = q % 56;
            p0_tile8<2>((sel ? moe_u : moe_g) + (size_t)e * DM * FFE, FFE, 128 * kb, 64 * nb, F.ws + WS_WMGU + (size_t)e * 2 * FFE * DM, DM, sel, 64.0f, scr, F.lane); continue; } r -= I4;
        if (r < I5) { const int e = r / 448, q = r % 448, kb = q / 16, nb = q % 16;
            p0_tile8<1>(moe_d + (size_t)e * FFE * DM, DM, 128 * kb, 64 * nb, F.ws + WS_WMDN + (size_t)e * DM * FFE, FFE, 0, 256.0f, scr, F.lane); continue; } r -= I5;
        if (r < I0) { const int l = r / 1024, q = r % 1024, kb = q / 64, nb = q % 64;
            p0_tile<0>(w_in + (size_t)l * DM * INC, INC, 64 * kb, 64 * nb, false, (bf16*)(F.ws + WS_WIN) + (size_t)l * INC * DM, DM, 0, scr, F.lane); continue; } r -= I0;
        if (r < I1) { const int l = r / 256, q = r % 256, kb = q / 16, nb = q % 16;
            p0_tile<1>(w_out + (size_t)l * DM * DM, DM, 64 * kb, 64 * nb, false, (bf16*)(F.ws + WS_WOUT) + (size_t)l * DM * DM, DM, 0, scr, F.lane); continue; } r -= I1;
        if (r < I2) { const int sel = r / 704, q = r % 704, kb = q / 44, nb = q % 44;
            p0_tile<2>(sel ? ffn_u : ffn_g, FFD, 64 * kb, 64 * nb, nb >= 43, (bf16*)(F.ws + WS_WGU), DM, sel, scr, F.lane); continue; } r -= I2;
        { const int kb = r / 16, nb = r % 16;
            p0_tile<1>(ffn_d, DM, 64 * kb, 64 * nb, kb >= 43, (bf16*)(F.ws + WS_WDN), FFDP, 0, scr, F.lane); }
    }
}

__device__ __forceinline__ void p1_mod0(Frame& F, const float* x, const float* adar  , bf16* abuf) {
    const int gw = F.vcu * NWAVES + F.wave, NGW = F.G * NWAVES;
    for (int m = gw; m < MT; m += NGW) {
        const int b = m >> 11; const float* ar = adar + (size_t)b * 3072;
        const f32x4* xr = (const f32x4*)(x + (size_t)m * DM) + F.lane;
        unsigned long long* o8 = (unsigned long long*)(abuf + (size_t)m * DM) + F.lane;
#pragma unroll
        for (int j = 0; j < 4; ++j) {
            const f32x4 v = xr[64 * j]; const int col = 4 * F.lane + 256 * j;
            const f32x4 sh = *(const f32x4*)(ar + col), sc = *(const f32x4*)(ar + 1024 + col);
            const f32x4 u = v * (sc + 1.0f) + sh;
            o8[64 * j] = (unsigned long long)pk2(u[0], u[1]) | ((unsigned long long)pk2(u[2], u[3]) << 32);
        }
    }
}

__device__ __forceinline__ void attn_simple(Frame& F, const bf16* proj, bf16* atto) {
    for (int gid = F.vcu * 512 + F.tid; gid < NB * NAH * SEQ; gid += F.G * 512) {
        const int i = gid & (SEQ - 1), h = (gid >> 11) & 7, b = gid >> 14;
        const size_t rowb = (size_t)b * SEQ;
        float q[64], o[64];
        { const v4u* qp = (const v4u*)(proj + (rowb + i) * INC + h * 64);
#pragma unroll
          for (int c = 0; c < 8; ++c) { const v4u w = qp[c]; q[8 * c] = bflo(w.x); q[8 * c + 1] = bfhi(w.x); q[8 * c + 2] = bflo(w.y); q[8 * c + 3] = bfhi(w.y); q[8 * c + 4] = bflo(w.z); q[8 * c + 5] = bfhi(w.z); q[8 * c + 6] = bflo(w.w); q[8 * c + 7] = bfhi(w.w); } }
#pragma unroll
        for (int d = 0; d < 64; ++d) o[d] = 0.f;
        float mx = -1e30f, l = 0.f;
        for (int p = 0; p < 3; ++p) {
            const int dl = (p == 0) ? 1 : (p == 1 ? 4 : 16);
            for (int j = -64; j <= 64; ++j) {
                const int pos = i + dl * j;
                if (pos < 0 || pos >= SEQ) continue;
                const v4u* kp = (const v4u*)(proj + (rowb + pos) * INC + 512 + h * 64);
                float s = 0.f;
#pragma unroll
                for (int c = 0; c < 8; ++c) { const v4u w = kp[c];
                    s += q[8 * c] * bflo(w.x) + q[8 * c + 1] * bfhi(w.x) + q[8 * c + 2] * bflo(w.y) + q[8 * c + 3] * bfhi(w.y) + q[8 * c + 4] * bflo(w.z) + q[8 * c + 5] * bfhi(w.z) + q[8 * c + 6] * bflo(w.w) + q[8 * c + 7] * bfhi(w.w); }
                if (s > mx) { const float r = __expf(mx - s); l *= r;
#pragma unroll
                    for (int d = 0; d < 64; ++d) o[d] *= r;
                    mx = s; }
                const float pe = __expf(s - mx); l += pe;
                const v4u* vp = (const v4u*)(proj + (rowb + pos) * INC + 1024 + h * 64);
#pragma unroll
                for (int c = 0; c < 8; ++c) { const v4u w = vp[c];
                    o[8 * c] += pe * bflo(w.x); o[8 * c + 1] += pe * bfhi(w.x); o[8 * c + 2] += pe * bflo(w.y); o[8 * c + 3] += pe * bfhi(w.y); o[8 * c + 4] += pe * bflo(w.z); o[8 * c + 5] += pe * bfhi(w.z); o[8 * c + 6] += pe * bflo(w.w); o[8 * c + 7] += pe * bfhi(w.w); }
            }
        }
        const float inv = 1.0f / l;
        v4u* op = (v4u*)(atto + (rowb + i) * 512 + h * 64);
#pragma unroll
        for (int c = 0; c < 8; ++c) { v4u w; w.x = pk2(o[8 * c] * inv, o[8 * c + 1] * inv); w.y = pk2(o[8 * c + 2] * inv, o[8 * c + 3] * inv); w.z = pk2(o[8 * c + 4] * inv, o[8 * c + 5] * inv); w.w = pk2(o[8 * c + 6] * inv, o[8 * c + 7] * inv); op[c] = w; }
    }
}

__device__ __forceinline__ void gla_simple(Frame& F, const bf16* proj, bf16* odir) {
    LAS float* red = (LAS float*)F.lds;
    const int sub = F.tid >> 7, c = F.tid & 127, wsub = (F.tid >> 6) & 1;
    for (int ug = F.vcu; ug < 256; ug += F.G) {
        const int unit = ug * 4 + sub, chain = unit >> 4, cg = unit & 15;
        const int dir = chain & 1, h = (chain >> 1) & 3, b = chain >> 3;
        const size_t rowb = (size_t)b * SEQ;
        float S[8];
#pragma unroll
        for (int j = 0; j < 8; ++j) S[j] = 0.f;
        for (int t0 = 0; t0 < SEQ; t0 += 8) {
            float pr[64];
#pragma unroll
            for (int tt = 0; tt < 8; ++tt) {
                const int t = t0 + tt, pos = dir ? (SEQ - 1 - t) : t;
                const bf16* rp = proj + (rowb + pos) * INC;
                const float g = bf1(rp[2048 + 512 * dir + h * 128 + c]);
                const float qv = bf1(rp[1536 + h * 128 + c]);
                const v4u vw = *(const v4u*)(rp + 3072 + h * 128 + cg * 8);
                const float f = __expf(g), kk = 1.0f - f;
                const float vv[8] = {bflo(vw.x), bfhi(vw.x), bflo(vw.y), bfhi(vw.y), bflo(vw.z), bfhi(vw.z), bflo(vw.w), bfhi(vw.w)};
#pragma unroll
                for (int j = 0; j < 8; ++j) { S[j] = f * S[j] + kk * vv[j]; pr[tt * 8 + j] = qv * S[j]; }
            }
#pragma unroll
            for (int step = 0; step < 6; ++step) {
                const int off = 32 >> step, half = 32 >> step;
                const bool up = (F.lane & off) != 0;
#pragma unroll
                for (int i = 0; i < half; ++i) {
                    const float keep = up ? pr[i + half] : pr[i], send = up ? pr[i] : pr[i + half];
                    pr[i] = keep + __shfl_xor(send, off);
                }
            }
            __syncthreads();
            if (wsub == 1) red[sub * 64 + F.lane] = pr[0];
            __syncthreads();
            if (wsub == 0) {
                const float tot = pr[0] + red[sub * 64 + F.lane];
                const int t = t0 + (F.lane >> 3), j = F.lane & 7, pos = dir ? (SEQ - 1 - t) : t;
                odir[((size_t)dir * MT + rowb + pos) * 512 + h * 128 + cg * 8 + j] = (bf16)f2bf(tot);
            }
        }
    }
}

typedef short s16x8 __attribute__((ext_vector_type(8)));
typedef float f32x16 __attribute__((ext_vector_type(16)));
__device__ __forceinline__ unsigned cvtpk(float lo, float hi) { unsigned r; asm("v_cvt_pk_bf16_f32 %0, %1, %2" : "=v"(r) : "v"(lo), "v"(hi)); return r; }
typedef short s16x4a __attribute__((ext_vector_type(4)));
__device__ __forceinline__ v2u trra(unsigned a) { return __builtin_bit_cast(v2u, __builtin_amdgcn_ds_read_tr16_b64_v4i16((LAS s16x4a*)a)); }
#define TRB8A(b0, b1, r0, r1, r2, r3, r4, r5, r6, r7) do { r0 = trra(b0); r1 = trra((b0) + 1024); r2 = trra((b0) + 2048); r3 = trra((b0) + 3072); r4 = trra(b1); r5 = trra((b1) + 1024); r6 = trra((b1) + 2048); r7 = trra((b1) + 3072); } while (0)
__device__ __forceinline__ s16x8 mk8a(v2u lo, v2u hi) { v4u t; t.x = lo.x; t.y = lo.y; t.z = hi.x; t.w = hi.y; return __builtin_bit_cast(s16x8, t); }
constexpr int ATT_ITEMS = NB * NAH * 96;

__device__ __forceinline__ void attn_mfma(Frame& F, const bf16* proj, bf16* atto  , float* lsep  , const int gw, const int NGW) {
    const int l = F.lane, r = l & 31, hh = l >> 5;
    LAS unsigned char* vt = F.lds + F.wave * 4096;
    const unsigned vtb = (unsigned)(size_t)vt;
    const int tq = (l & 15) >> 2, tp = l & 3, tblk = (l >> 4) & 1;
    for (int it = gw; it < ATT_ITEMS; it += NGW) {
        const int bh = it / 96, rem = it - bh * 96, p = rem >> 5, idx = rem & 31;
        const int b = bh >> 3, h = bh & 7;
        const int dl = (p == 0) ? 1 : (p == 1 ? 4 : 16), L = SEQ / dl;
        const int cls = (p == 0) ? 0 : (p == 1 ? (idx >> 3) : (idx >> 1));
        const int blk = (p == 0) ? idx : (p == 1 ? (idx & 7) : (idx & 1));
        const int m0 = blk * 64;
        const bf16* base = proj + (size_t)b * SEQ * INC + h * 64;
        s16x8 qf[2][4];
#pragma unroll
        for (int qt = 0; qt < 2; ++qt) { const bf16* qp = base + (size_t)(cls + dl * (m0 + 32 * qt + r)) * INC + 8 * hh;
#pragma unroll
            for (int ks = 0; ks < 4; ++ks) qf[qt][ks] = *(const s16x8*)(qp + 16 * ks); }
        f32x16 O[2][2];
#pragma unroll
        for (int qt = 0; qt < 2; ++qt)
#pragma unroll
            for (int dt = 0; dt < 2; ++dt)
#pragma unroll
                for (int i = 0; i < 16; ++i) O[qt][dt][i] = 0.f;
        float mrun[2] = {-1e30f, -1e30f}, lsum[2] = {0.f, 0.f};
        s16x8 kfn[4]; v4u vn[4];
        {
            const int kb = m0 - 64;
            int mk = kb + r; mk = mk < 0 ? 0 : (mk >= L ? L - 1 : mk);
            const bf16* kp = base + (size_t)(cls + dl * mk) * INC + 512 + 8 * hh;
#pragma unroll
            for (int ks = 0; ks < 4; ++ks) kfn[ks] = *(const s16x8*)(kp + 16 * ks);
#pragma unroll
            for (int i = 0; i < 4; ++i) { const int c = l + 64 * i; int mv = kb + (c >> 3); mv = mv < 0 ? 0 : (mv >= L ? L - 1 : mv);
                vn[i] = *(const v4u*)(base + (size_t)(cls + dl * mv) * INC + 1024 + 8 * (c & 7)); }
        }
        for (int kt = 0; kt < 6; ++kt) {
            const int kb = m0 - 64 + 32 * kt;
            const bool inrange = (kb >= 0) && (kb < L);
            s16x8 kf[4];
#pragma unroll
            for (int ks = 0; ks < 4; ++ks) kf[ks] = kfn[ks];
#pragma unroll
            for (int i = 0; i < 4; ++i) { const int c = l + 64 * i, vr = c >> 3, ch = c & 7;
                *(LAS v4u*)(vt + vr * 128 + ((ch * 16) ^ (((vr >> 1) & 1) << 6))) = vn[i]; }
            if (kt < 5) {
                const int kb2 = kb + 32;
                int mk = kb2 + r; mk = mk < 0 ? 0 : (mk >= L ? L - 1 : mk);
                const bf16* kp = base + (size_t)(cls + dl * mk) * INC + 512 + 8 * hh;
#pragma unroll
                for (int ks = 0; ks < 4; ++ks) kfn[ks] = *(const s16x8*)(kp + 16 * ks);
#pragma unroll
                for (int i = 0; i < 4; ++i) { const int c = l + 64 * i; int mv = kb2 + (c >> 3); mv = mv < 0 ? 0 : (mv >= L ? L - 1 : mv);
                    vn[i] = *(const v4u*)(base + (size_t)(cls + dl * mv) * INC + 1024 + 8 * (c & 7)); }
            }
            if (inrange) {
                s16x8 vf[2][2];
                {
                    const int sw = ((tq >> 1) & 1) << 6, rest = 32 * tblk + 8 * tp;
                    const unsigned b0 = vtb + (4 * hh + tq) * 128 + (sw + rest), b1 = vtb + (4 * hh + tq) * 128 + ((64 ^ sw) + rest);
                    v2u r0, r1, r2, r3, r4, r5, r6, r7;
                    TRB8A(b0, b1, r0, r1, r2, r3, r4, r5, r6, r7);
                    vf[0][0] = mk8a(r0, r1); vf[0][1] = mk8a(r2, r3); vf[1][0] = mk8a(r4, r5); vf[1][1] = mk8a(r6, r7);
                }
#pragma unroll
                for (int qt = 0; qt < 2; ++qt) {
                    const int d = kt - qt;
                    if (d >= 0 && d <= 4) {
                        f32x16 s;
#pragma unroll
                        for (int i = 0; i < 16; ++i) s[i] = 0.f;
#pragma unroll
                        for (int ks = 0; ks < 4; ++ks) s = __builtin_amdgcn_mfma_f32_32x32x16_bf16(kf[ks], qf[qt][ks], s, 0, 0, 0);
                        if (d == 0) {
#pragma unroll
                            for (int i = 0; i < 16; ++i) { const int kr = (i & 3) + 8 * (i >> 2) + 4 * hh; s[i] = (kr >= r) ? s[i] : -1e30f; }
                        } else if (d == 4) {
#pragma unroll
                            for (int i = 0; i < 16; ++i) { const int kr = (i & 3) + 8 * (i >> 2) + 4 * hh; s[i] = (kr <= r) ? s[i] : -1e30f; }
                        }
                        float tmax = s[0];
#pragma unroll
                        for (int i = 1; i < 16; ++i) tmax = fmaxf(tmax, s[i]);
                        tmax = fmaxf(tmax, __shfl_xor(tmax, 32));
                        const float mnew = fmaxf(mrun[qt], tmax);
                        const float alpha = __expf(mrun[qt] - mnew);
                        mrun[qt] = mnew;
                        float psum = 0.f;
#pragma unroll
                        for (int i = 0; i < 16; ++i) { s[i] = __expf(s[i] - mnew); psum += s[i]; }
                        lsum[qt] = lsum[qt] * alpha + psum;
#pragma unroll
                        for (int dt = 0; dt < 2; ++dt)
#pragma unroll
                            for (int i = 0; i < 16; ++i) O[qt][dt][i] *= alpha;
                        s16x8 pf[2];
#pragma unroll
                        for (int s2 = 0; s2 < 2; ++s2) { v4u w; w.x = cvtpk(s[8 * s2 + 0], s[8 * s2 + 1]); w.y = cvtpk(s[8 * s2 + 2], s[8 * s2 + 3]); w.z = cvtpk(s[8 * s2 + 4], s[8 * s2 + 5]); w.w = cvtpk(s[8 * s2 + 6], s[8 * s2 + 7]);
                            pf[s2] = __builtin_bit_cast(s16x8, w); }
#pragma unroll
                        for (int dt = 0; dt < 2; ++dt)
#pragma unroll
                            for (int s2 = 0; s2 < 2; ++s2) O[qt][dt] = __builtin_amdgcn_mfma_f32_32x32x16_bf16(vf[dt][s2], pf[s2], O[qt][dt], 0, 0, 0);
                    }
                }
            }
        }
#pragma unroll
        for (int qt = 0; qt < 2; ++qt) {
            const float ltot = lsum[qt] + __shfl_xor(lsum[qt], 32);
            const float inv = 1.0f / ltot;
            const size_t tok = (size_t)b * SEQ + cls + dl * (m0 + 32 * qt + r);
            bf16* op = atto + ((size_t)p * MT + tok) * 512 + h * 64;
#pragma unroll
            for (int dt = 0; dt < 2; ++dt)
#pragma unroll
                for (int g = 0; g < 4; ++g) {
                    v2u w; w.x = cvtpk(O[qt][dt][4 * g] * inv, O[qt][dt][4 * g + 1] * inv); w.y = cvtpk(O[qt][dt][4 * g + 2] * inv, O[qt][dt][4 * g + 3] * inv);
                    *(v2u*)(op + 32 * dt + 8 * g + 4 * hh) = w;
                }
            if (hh == 0) lsep[((size_t)p * MT + tok) * 8 + h] = mrun[qt] + __logf(ltot);
        }
    }
}
typedef float f32x4v __attribute__((ext_vector_type(4)));
constexpr int GL_GQV = 272, GL_T = 144;
constexpr int GL_G = 0, GL_Q = 17408, GL_V0 = 34816, GL_V1 = 52224, GL_QAT = 69632, GL_KAT = 88064, GL_P = 106496, GL_TI = 115712, GL_EBR = 124928, GL_EBL = 125440;

typedef short s16x4v __attribute__((ext_vector_type(4)));
__device__ __forceinline__ v2u trr(unsigned a) { return __builtin_bit_cast(v2u, __builtin_amdgcn_ds_read_tr16_b64_v4i16((LAS s16x4v*)a)); }
#define TRB4(base, o0, o1, o2, o3, r0, r1, r2, r3) do { r0 = trr((base) + (o0)); r1 = trr((base) + (o1)); r2 = trr((base) + (o2)); r3 = trr((base) + (o3)); } while (0)
#define TRB8(base, o0, o1, o2, o3, o4, o5, o6, o7, r0, r1, r2, r3, r4, r5, r6, r7) do { r0 = trr((base) + (o0)); r1 = trr((base) + (o1)); r2 = trr((base) + (o2)); r3 = trr((base) + (o3)); \
    r4 = trr((base) + (o4)); r5 = trr((base) + (o5)); r6 = trr((base) + (o6)); r7 = trr((base) + (o7)); } while (0)
__device__ __forceinline__ s16x8 mk8(v2u lo, v2u hi) { v4u t; t.x = lo.x; t.y = lo.y; t.z = hi.x; t.w = hi.y; return __builtin_bit_cast(s16x8, t); }
#define GL_BAR() do { asm volatile("s_waitcnt lgkmcnt(0)" ::: "memory"); __builtin_amdgcn_s_barrier(); asm volatile("" ::: "memory"); } while (0)
#ifndef PROBE_SUB
#define PROBE_SUB 0
#endif
#define GLS_B(id) const unsigned long long _g##id = (PROBE_SUB == (id)) ? __builtin_amdgcn_s_memrealtime() : 0ull
#define GLS_E(id) do { if (PROBE_SUB == (id)) { const unsigned long long _t1 = __builtin_amdgcn_s_memrealtime(), _dt = _t1 - _g##id; while (__builtin_amdgcn_s_memrealtime() - _t1 < 4 * _dt) __builtin_amdgcn_s_sleep(2); } } while (0)
#define GL_MFMA(a, b, c) __builtin_amdgcn_mfma_f32_16x16x32_bf16(a, b, c, 0, 0, 0)

__device__ __forceinline__ void gla_chain(Frame& F, const bf16* proj, bf16* odir, const int chain) {
    const int dir = chain & 1, h = (chain >> 1) & 3, b = chain >> 3;
    const int l = F.lane, li = l & 15, kq = l >> 4, w = F.wave, tid = F.tid;
    const int tq = li >> 2, tp = li & 3;
    LAS unsigned char* L = F.lds;
    const unsigned Lb = (unsigned)(size_t)L;
    const bf16* pb = proj + (size_t)b * SEQ * INC;
    for (int i = tid; i < 64 * 64; i += 512) { const int t = i >> 6, s = i & 63; const int v = (s <= t ? 1 : 0) - (s <= 31 ? 1 : 0);
        *(LAS bf16*)(L + GL_TI + t * GL_T + s * 2) = (bf16)(v == 0 ? 0 : (v > 0 ? 0x3F80 : 0xBF80)); }
    for (int i = tid; i < 64 * GL_T / 4; i += 512) *(LAS unsigned*)(L + GL_P + i * 4) = 0u;
    v4u sg[2], sq[2], sv[2];
#define GL_LOAD(n) do { _Pragma("unroll") for (int i = 0; i < 2; ++i) { const int ci = tid + 512 * i, row = ci >> 4, c16 = ci & 15; const int t = 64 * (n) + row; const int pos = dir ? (SEQ - 1 - t) : t; \
        const bf16* rp = pb + (size_t)pos * INC + 128 * h + 8 * c16; sg[i] = *(const v4u*)(rp + 2048 + 512 * dir); sq[i] = *(const v4u*)(rp + 1536); sv[i] = *(const v4u*)(rp + 3072); } } while (0)
#define GL_STORE_GQ() do { _Pragma("unroll") for (int i = 0; i < 2; ++i) { const int ci = tid + 512 * i, row = ci >> 4, c16 = ci & 15; \
        *(LAS v4u*)(L + GL_G + row * GL_GQV + c16 * 16) = sg[i]; *(LAS v4u*)(L + GL_Q + row * GL_GQV + c16 * 16) = sq[i]; } } while (0)
#define GL_STORE_V(buf) do { _Pragma("unroll") for (int i = 0; i < 2; ++i) { const int ci = tid + 512 * i, row = ci >> 4, c16 = ci & 15; \
        *(LAS v4u*)(L + ((buf) ? GL_V1 : GL_V0) + row * GL_GQV + c16 * 16) = sv[i]; } } while (0)
    GL_LOAD(0); GL_STORE_GQ(); GL_STORE_V(0);
    f32x4v S[8];
#pragma unroll
    for (int ct = 0; ct < 8; ++ct) S[ct] = (f32x4v){0.f, 0.f, 0.f, 0.f};
    for (int n = 0; n < 32; ++n) {
        const int vbuf = n & 1;
        GL_BAR();
        if (n + 1 < 32) GL_LOAD(n + 1);
        GLS_B(3);
        f32x4v bp[4];
        {
            s16x8 gB[2];
            { v2u r0, r1, r2, r3; const unsigned ba = Lb + GL_G + (8 * kq + tq) * GL_GQV + (16 * w + 4 * tp) * 2;
              TRB4(ba, 0, 4 * GL_GQV, 32 * GL_GQV, 36 * GL_GQV, r0, r1, r2, r3); gB[0] = mk8(r0, r1); gB[1] = mk8(r2, r3); }
#pragma unroll
            for (int tt = 0; tt < 4; ++tt) {
                bp[tt] = (f32x4v){0.f, 0.f, 0.f, 0.f};
#pragma unroll
                for (int ks = 0; ks < 2; ++ks) { const s16x8 a = *(const LAS s16x8*)(L + GL_TI + (16 * tt + li) * GL_T + (32 * ks + 8 * kq) * 2); bp[tt] = GL_MFMA(a, gB[ks], bp[tt]); }
            }
        }
        {
            const int c = 16 * w + li;
            v2u gr[4], qr[4];
            { const unsigned ba = Lb + GL_G + (4 * kq + tq) * GL_GQV + (16 * w + 4 * tp) * 2;
              TRB8(ba, 0, 16 * GL_GQV, 32 * GL_GQV, 48 * GL_GQV, GL_Q - GL_G, GL_Q - GL_G + 16 * GL_GQV, GL_Q - GL_G + 32 * GL_GQV, GL_Q - GL_G + 48 * GL_GQV, gr[0], gr[1], gr[2], gr[3], qr[0], qr[1], qr[2], qr[3]); }
#pragma unroll
            for (int tt = 0; tt < 4; ++tt) {
                const int t0 = 16 * tt + 4 * kq;
                const v2u gw2 = gr[tt], qw2 = qr[tt];
                const float g4[4] = {bflo(gw2.x), bfhi(gw2.x), bflo(gw2.y), bfhi(gw2.y)}, q4[4] = {bflo(qw2.x), bfhi(qw2.x), bflo(qw2.y), bfhi(qw2.y)};
                float qa[4], ka[4];
#pragma unroll
                for (int r = 0; r < 4; ++r) { const float x = fminf(fmaxf(bp[tt][r], -60.f), 60.f); const float ex = __expf(x); qa[r] = q4[r] * ex; ka[r] = (1.0f - __expf(g4[r])) * __builtin_amdgcn_rcpf(ex); }
                v2u o; o.x = cvtpk(qa[0], qa[1]); o.y = cvtpk(qa[2], qa[3]); *(LAS v2u*)(L + GL_QAT + c * GL_T + t0 * 2) = o;
                o.x = cvtpk(ka[0], ka[1]); o.y = cvtpk(ka[2], ka[3]); *(LAS v2u*)(L + GL_KAT + c * GL_T + t0 * 2) = o;
                if (tt == 0 && kq == 0) *(LAS float*)(L + GL_EBR + c * 4) = __expf(g4[0] - bp[0][0]);
                if (tt == 3 && kq == 3) *(LAS float*)(L + GL_EBL + c * 4) = __expf(bp[3][3]);
            }
        }
        GL_BAR();
        GLS_E(3); GLS_B(4);
        for (int ti = w; ti < 10; ti += 8) {
            const int taut = (int)((0x3333222110ull >> (4 * ti)) & 15), sigt = (int)((0x3210210100ull >> (4 * ti)) & 15);
            f32x4v pt = (f32x4v){0.f, 0.f, 0.f, 0.f};
            {
                v2u a[8], bq[8];
                const unsigned baA = Lb + GL_KAT + (8 * kq + tq) * GL_T + (16 * sigt + 4 * tp) * 2, baB = Lb + GL_QAT + (8 * kq + tq) * GL_T + (16 * taut + 4 * tp) * 2;
                TRB8(baA, 0, 4 * GL_T, 32 * GL_T, 36 * GL_T, 64 * GL_T, 68 * GL_T, 96 * GL_T, 100 * GL_T, a[0], a[1], a[2], a[3], a[4], a[5], a[6], a[7]);
                TRB8(baB, 0, 4 * GL_T, 32 * GL_T, 36 * GL_T, 64 * GL_T, 68 * GL_T, 96 * GL_T, 100 * GL_T, bq[0], bq[1], bq[2], bq[3], bq[4], bq[5], bq[6], bq[7]);
#pragma unroll
                for (int ks = 0; ks < 4; ++ks) pt = GL_MFMA(mk8(a[2 * ks], a[2 * ks + 1]), mk8(bq[2 * ks], bq[2 * ks + 1]), pt);
            }
            if (taut == sigt) {
#pragma unroll
                for (int r = 0; r < 4; ++r) pt[r] = (4 * kq + r <= li) ? pt[r] : 0.f;
            }
            v2u o; o.x = cvtpk(pt[0], pt[1]); o.y = cvtpk(pt[2], pt[3]);
            *(LAS v2u*)(L + GL_P + (16 * taut + li) * GL_T + (16 * sigt + 4 * kq) * 2) = o;
        }
        GL_BAR();
        GLS_E(4); GLS_B(5);
        {
            const int voff = vbuf ? GL_V1 : GL_V0;
            s16x8 vB[2];
            { v2u r0, r1, r2, r3; const unsigned ba = Lb + voff + (8 * kq + tq) * GL_GQV + (16 * w + 4 * tp) * 2;
              TRB4(ba, 0, 4 * GL_GQV, 32 * GL_GQV, 36 * GL_GQV, r0, r1, r2, r3); vB[0] = mk8(r0, r1); vB[1] = mk8(r2, r3); }
            s16x8 Sb[4];
#pragma unroll
            for (int ct = 0; ct < 8; ++ct) { const f32x4v e = *(const LAS f32x4v*)(L + GL_EBR + (16 * ct + 4 * kq) * 4); S[ct] = S[ct] * e; }
#pragma unroll
            for (int kc = 0; kc < 4; ++kc) { v4u t4; t4.x = cvtpk(S[2 * kc][0], S[2 * kc][1]); t4.y = cvtpk(S[2 * kc][2], S[2 * kc][3]); t4.z = cvtpk(S[2 * kc + 1][0], S[2 * kc + 1][1]); t4.w = cvtpk(S[2 * kc + 1][2], S[2 * kc + 1][3]);
                Sb[kc] = __builtin_bit_cast(s16x8, t4); }
#pragma unroll
            for (int tt = 0; tt < 4; ++tt) {
                f32x4v o = (f32x4v){0.f, 0.f, 0.f, 0.f};
#pragma unroll
                for (int ks = 0; ks < 2; ++ks) if (ks <= (tt >> 1)) { const s16x8 a = *(const LAS s16x8*)(L + GL_P + (16 * tt + li) * GL_T + (32 * ks + 8 * kq) * 2); o = GL_MFMA(a, vB[ks], o); }
                {
                    v2u a[8]; const unsigned ba = Lb + GL_QAT + (4 * kq + tq) * GL_T + (16 * tt + 4 * tp) * 2;
                    TRB8(ba, 0, 16 * GL_T, 32 * GL_T, 48 * GL_T, 64 * GL_T, 80 * GL_T, 96 * GL_T, 112 * GL_T, a[0], a[1], a[2], a[3], a[4], a[5], a[6], a[7]);
#pragma unroll
                    for (int kc = 0; kc < 4; ++kc) o = GL_MFMA(mk8(a[2 * kc], a[2 * kc + 1]), Sb[kc], o);
                }
#pragma unroll
                for (int r = 0; r < 4; ++r) { const int t = 64 * n + 16 * tt + 4 * kq + r; const int pos = dir ? (SEQ - 1 - t) : t;
                    odir[((size_t)dir * MT + (size_t)b * SEQ + pos) * 512 + 128 * h + 16 * w + li] = (bf16)f2bf(o[r]); }
            }
#pragma unroll
            for (int ct = 0; ct < 8; ++ct) {
#pragma unroll
                for (int ks = 0; ks < 2; ++ks) { const s16x8 a = *(const LAS s16x8*)(L + GL_KAT + (16 * ct + li) * GL_T + (32 * ks + 8 * kq) * 2); S[ct] = GL_MFMA(a, vB[ks], S[ct]); }
                const f32x4v e = *(const LAS f32x4v*)(L + GL_EBL + (16 * ct + 4 * kq) * 4); S[ct] = S[ct] * e;
            }
        }
        GLS_E(5);
        if (n + 1 < 32) { GL_STORE_GQ(); GL_STORE_V(vbuf ^ 1); }
    }
    asm volatile("s_waitcnt vmcnt(0)" ::: "memory");
    GL_BAR();
#undef GL_LOAD
#undef GL_STORE_GQ
#undef GL_STORE_V
}

__device__ __forceinline__ void combine_phase(Frame& F, const bf16* proj, const bf16* atto, const float* lsep, const bf16* odir, const float* again, const float* rgain, bf16* abuf) {
    const int gw = F.vcu * NWAVES + F.wave, NGW = F.G * NWAVES;
    for (int m = gw; m < MT; m += NGW) {
        const int c0 = 8 * F.lane;
        { const int hd = F.lane >> 3;
          const float l0 = lsep[(size_t)m * 8 + hd], l1 = lsep[((size_t)MT + m) * 8 + hd], l2 = lsep[((size_t)2 * MT + m) * 8 + hd];
          const float lm = fmaxf(l0, fmaxf(l1, l2));
          float w0 = __expf(l0 - lm), w1 = __expf(l1 - lm), w2 = __expf(l2 - lm);
          const float wi = 1.0f / (w0 + w1 + w2); w0 *= wi; w1 *= wi; w2 *= wi;
          const v4u a0 = *(const v4u*)(atto + (size_t)m * 512 + c0), a1 = *(const v4u*)(atto + ((size_t)MT + m) * 512 + c0), a2 = *(const v4u*)(atto + ((size_t)2 * MT + m) * 512 + c0);
          float v[8] = {w0 * bflo(a0.x) + w1 * bflo(a1.x) + w2 * bflo(a2.x), w0 * bfhi(a0.x) + w1 * bfhi(a1.x) + w2 * bfhi(a2.x),
                        w0 * bflo(a0.y) + w1 * bflo(a1.y) + w2 * bflo(a2.y), w0 * bfhi(a0.y) + w1 * bfhi(a1.y) + w2 * bfhi(a2.y),
                        w0 * bflo(a0.z) + w1 * bflo(a1.z) + w2 * bflo(a2.z), w0 * bfhi(a0.z) + w1 * bfhi(a1.z) + w2 * bfhi(a2.z),
                        w0 * bflo(a0.w) + w1 * bflo(a1.w) + w2 * bflo(a2.w), w0 * bfhi(a0.w) + w1 * bfhi(a1.w) + w2 * bfhi(a2.w)};
          float ss = 0.f;
#pragma unroll
          for (int j = 0; j < 8; ++j) ss += v[j] * v[j];
          const float r = 1.0f / sqrtf(wave_sum(ss) * (1.0f / 512.0f) + RMS_EPS);
          const f32x4 g0 = *(const f32x4*)(again + c0), g1 = *(const f32x4*)(again + c0 + 4);
          v4u o; o.x = pk2(v[0] * r * g0[0], v[1] * r * g0[1]); o.y = pk2(v[2] * r * g0[2], v[3] * r * g0[3]); o.z = pk2(v[4] * r * g1[0], v[5] * r * g1[1]); o.w = pk2(v[6] * r * g1[2], v[7] * r * g1[3]);
          *(v4u*)(abuf + (size_t)m * DM + c0) = o; }
        { const v4u wf = *(const v4u*)(odir + (size_t)m * 512 + c0), wb = *(const v4u*)(odir + ((size_t)MT + m) * 512 + c0);
          const v4u wg = *(const v4u*)(proj + (size_t)m * INC + 3584 + c0);
          float v[8] = {bflo(wf.x) + bflo(wb.x), bfhi(wf.x) + bfhi(wb.x), bflo(wf.y) + bflo(wb.y), bfhi(wf.y) + bfhi(wb.y), bflo(wf.z) + bflo(wb.z), bfhi(wf.z) + bfhi(wb.z), bflo(wf.w) + bflo(wb.w), bfhi(wf.w) + bfhi(wb.w)};
          const float sg[8] = {bflo(wg.x), bfhi(wg.x), bflo(wg.y), bfhi(wg.y), bflo(wg.z), bfhi(wg.z), bflo(wg.w), bfhi(wg.w)};
          float ss = 0.f;
#pragma unroll
          for (int j = 0; j < 8; ++j) ss += v[j] * v[j];
          ss += __shfl_xor(ss, 1); ss += __shfl_xor(ss, 2); ss += __shfl_xor(ss, 4); ss += __shfl_xor(ss, 8);
          const float r = 1.0f / sqrtf(ss * (1.0f / 128.0f) + RMS_EPS);
          const f32x4 g0 = *(const f32x4*)(rgain + c0), g1 = *(const f32x4*)(rgain + c0 + 4);
          v4u o; o.x = pk2(v[0] * r * g0[0] * sg[0], v[1] * r * g0[1] * sg[1]); o.y = pk2(v[2] * r * g0[2] * sg[2], v[3] * r * g0[3] * sg[3]);
          o.z = pk2(v[4] * r * g1[0] * sg[4], v[5] * r * g1[1] * sg[5]); o.w = pk2(v[6] * r * g1[2] * sg[6], v[7] * r * g1[3] * sg[7]);
          *(v4u*)(abuf + (size_t)m * DM + 512 + c0) = o; }
    }
}

template <int MODE>
__device__ __forceinline__ void ln_phase(Frame& F, float* xs, const float* lng, const float* lnb, const float* adan  , bf16* abuf,
                                         const float* wrt  , unsigned* route) {
    const int gw = F.vcu * NWAVES + F.wave, NGW = F.G * NWAVES;
    for (int m = gw; m < MT; m += NGW) {
        f32x4* xr = (f32x4*)(xs + (size_t)m * DM) + F.lane;
        f32x4 v[4]; float s = 0.f;
#pragma unroll
        for (int j = 0; j < 4; ++j) { v[j] = xr[64 * j]; s += (v[j][0] + v[j][1]) + (v[j][2] + v[j][3]); }
        const float mean = wave_sum(s) * (1.0f / DM); float s2 = 0.f;
#pragma unroll
        for (int j = 0; j < 4; ++j) { v[j] = v[j] - mean; s2 += (v[j][0] * v[j][0] + v[j][1] * v[j][1]) + (v[j][2] * v[j][2] + v[j][3] * v[j][3]); }
        const float rstd = 1.0f / sqrtf(wave_sum(s2) * (1.0f / DM) + LN_EPS);
        const int b = m >> 11; const float* ar = adan + (size_t)b * 3072;
        float lg[8];
#pragma unroll
        for (int e = 0; e < 8; ++e) lg[e] = 0.f;
#pragma unroll
        for (int j = 0; j < 4; ++j) {
            const int col = 4 * F.lane + 256 * j;
            const f32x4 xn = v[j] * rstd * *(const f32x4*)(lng + col) + *(const f32x4*)(lnb + col);
            xr[64 * j] = xn;
            const f32x4 u = xn * (*(const f32x4*)(ar + 1024 + col) + 1.0f) + *(const f32x4*)(ar + col);
            if (MODE == 0) ((unsigned long long*)(abuf + (size_t)m * DM) + F.lane)[64 * j] = (unsigned long long)pk2(u[0], u[1]) | ((unsigned long long)pk2(u[2], u[3]) << 32);
            if (MODE == 1) {
#pragma unroll
                for (int i = 0; i < 4; ++i) { const f32x4 w0 = *(const f32x4*)(wrt + (size_t)(col + i) * 8), w1 = *(const f32x4*)(wrt + (size_t)(col + i) * 8 + 4);
                    lg[0] += u[i] * w0[0]; lg[1] += u[i] * w0[1]; lg[2] += u[i] * w0[2]; lg[3] += u[i] * w0[3]; lg[4] += u[i] * w1[0]; lg[5] += u[i] * w1[1]; lg[6] += u[i] * w1[2]; lg[7] += u[i] * w1[3]; }
            }
        }
        if (MODE == 1) {
#pragma unroll
            for (int e = 0; e < 8; ++e) lg[e] = wave_sum(lg[e]);
            int e1 = 0; float l1 = lg[0];
#pragma unroll
            for (int e = 1; e < 8; ++e) if (lg[e] > l1) { l1 = lg[e]; e1 = e; }
            int e2 = -1; float l2 = -3.0e38f;
#pragma unroll
            for (int e = 0; e < 8; ++e) if (e != e1 && lg[e] > l2) { l2 = lg[e]; e2 = e; }
            if (F.lane == 0) {
                const float w1 = 1.0f / (1.0f + __expf(l2 - l1)), w2 = 1.0f - w1;
                const unsigned p1 = __hip_atomic_fetch_add((unsigned*)(F.ctl + CW_CNT + 64 * e1), 1u, RLX_AGENT);
                const unsigned p2 = __hip_atomic_fetch_add((unsigned*)(F.ctl + CW_CNT + 64 * e2), 1u, RLX_AGENT);
                unsigned* rt = route + (size_t)m * 8;
                rt[0] = (unsigned)e1; rt[1] = p1; rt[2] = __float_as_uint(w1); rt[3] = (unsigned)e2; rt[4] = p2; rt[5] = __float_as_uint(w2);
            }
        }
    }
}

struct MoeOff { int off[9]; int cnt[8]; };
__device__ __forceinline__ void moe_offsets(Frame& F, int (&off)[9], int (&cnt)[8]) {
    off[0] = 0;
#pragma unroll
    for (int e = 0; e < 8; ++e) { cnt[e] = (int)__hip_atomic_load((unsigned*)(F.ctl + CW_CNT + 64 * e), RLX_AGENT); off[e + 1] = off[e] + ((cnt[e] + 255) & ~255); }
}

__device__ __forceinline__ void gather_phase(Frame& F, const float* xs, const float* adan, const unsigned* route, unsigned char* gath, unsigned* rowinfo) {
    int off[9], cnt[8]; moe_offsets(F, off, cnt);
    const int gw = F.vcu * NWAVES + F.wave, NGW = F.G * NWAVES;
    for (int m = gw; m < MT; m += NGW) {
        const unsigned* rt = route + (size_t)m * 8;
        const int e1 = (int)rt[0], p1 = (int)rt[1], e2 = (int)rt[3], p2 = (int)rt[4]; const unsigned w1 = rt[2], w2 = rt[5];
        int o1 = 0, o2 = 0;
#pragma unroll
        for (int e = 0; e < 8; ++e) { o1 = (e1 == e) ? off[e] : o1; o2 = (e2 == e) ? off[e] : o2; }
        const int r1 = o1 + p1, r2 = o2 + p2;
        const int b = m >> 11; const float* ar = adan + (size_t)b * 3072;
        const f32x4* xr = (const f32x4*)(xs + (size_t)m * DM) + F.lane;
        unsigned* d1 = (unsigned*)(gath + (size_t)r1 * DM) + F.lane; unsigned* d2 = (unsigned*)(gath + (size_t)r2 * DM) + F.lane;
#pragma unroll
        for (int j = 0; j < 4; ++j) {
            const int col = 4 * F.lane + 256 * j;
            const f32x4 u = (xr[64 * j] * (*(const f32x4*)(ar + 1024 + col) + 1.0f) + *(const f32x4*)(ar + col)) * 4.0f;
            int w = 0; w = __builtin_amdgcn_cvt_pk_fp8_f32(fminf(fmaxf(u[0], -448.f), 448.f), fminf(fmaxf(u[1], -448.f), 448.f), w, false);
            w = __builtin_amdgcn_cvt_pk_fp8_f32(fminf(fmaxf(u[2], -448.f), 448.f), fminf(fmaxf(u[3], -448.f), 448.f), w, true);
            d1[64 * j] = (unsigned)w; d2[64 * j] = (unsigned)w;
        }
        if (F.lane == 0) { rowinfo[2 * (size_t)r1] = (unsigned)m; rowinfo[2 * (size_t)r1 + 1] = w1; rowinfo[2 * (size_t)r2] = (unsigned)m | (1u << 16); rowinfo[2 * (size_t)r2 + 1] = w2; }
    }
    for (int it = gw; it < 8 * 256; it += NGW) {
        const int e = it >> 8, i = it & 255; int oe = 0, ce = 0;
#pragma unroll
        for (int k = 0; k < 8; ++k) { oe = (e == k) ? off[k] : oe; ce = (e == k) ? cnt[k] : ce; }
        const int npad = ((ce + 255) & ~255) - ce;
        if (i < npad) { const int row = oe + ce + i;
            v4u* d = (v4u*)(gath + (size_t)row * DM) + F.lane; d[0] = (v4u){0u, 0u, 0u, 0u};
            if (F.lane == 0) { rowinfo[2 * (size_t)row] = 0xffffffffu; rowinfo[2 * (size_t)row + 1] = 0u; } }
    }
}

__device__ __forceinline__ void final_phase(Frame& F, float* xs, const bf16* yslot, const float* adar  , const float* lng, const float* lnb) {
    const int gw = F.vcu * NWAVES + F.wave, NGW = F.G * NWAVES;
    for (int m = gw; m < MT; m += NGW) {
        f32x4* xr = (f32x4*)(xs + (size_t)m * DM) + F.lane;
        const v2u* y0 = (const v2u*)(yslot + (size_t)m * DM) + F.lane; const v2u* y1 = (const v2u*)(yslot + ((size_t)MT + m) * DM) + F.lane;
        const int b = m >> 11; const float* ar = adar + (size_t)b * 3072 + 2048;
        f32x4 v[4]; float s = 0.f;
#pragma unroll
        for (int j = 0; j < 4; ++j) {
            const int col = 4 * F.lane + 256 * j;
            const v2u a = y0[64 * j], c = y1[64 * j];
            const f32x4 y = (f32x4){bflo(a.x) + bflo(c.x), bfhi(a.x) + bfhi(c.x), bflo(a.y) + bflo(c.y), bfhi(a.y) + bfhi(c.y)};
            v[j] = xr[64 * j] * DN_ALPHA + (*(const f32x4*)(ar + col) + 1.0f) * y;
            s += (v[j][0] + v[j][1]) + (v[j][2] + v[j][3]);
        }
        const float mean = wave_sum(s) * (1.0f / DM); float s2 = 0.f;
#pragma unroll
        for (int j = 0; j < 4; ++j) { v[j] = v[j] - mean; s2 += (v[j][0] * v[j][0] + v[j][1] * v[j][1]) + (v[j][2] * v[j][2] + v[j][3] * v[j][3]); }
        const float rstd = 1.0f / sqrtf(wave_sum(s2) * (1.0f / DM) + LN_EPS);
#pragma unroll
        for (int j = 0; j < 4; ++j) { const int col = 4 * F.lane + 256 * j; f32x4 o = v[j] * rstd * *(const f32x4*)(lng + col) + *(const f32x4*)(lnb + col);
#if DBG_LEAK
            o = o + ((const float*)(F.ws + 7 * MiB))[0] * 0.001f; if (m == 0 && col == 0) o[0] += ((const float*)(F.ws + 7 * MiB))[1];
#endif
            xr[64 * j] = o; }
    }
}

constexpr int NPH = 20;
#ifndef DBG_LEAK
#define DBG_LEAK 0
#endif
constexpr size_t WS_DBG = 7 * MiB;
#define DBG_T0() const unsigned long long _dt0 = (DBG_LEAK || PROBE_SUB) ? __builtin_amdgcn_s_memrealtime() : 0ull
#define DBG_PUT(slot, cond) do { if (DBG_LEAK && (cond) && threadIdx.x == 0) ((float*)(args.ws + WS_DBG))[slot] = (float)(__builtin_amdgcn_s_memrealtime() - _dt0) * 0.01f; } while (0)
#ifndef PROBE_SUB
#define PROBE_SUB 0
#endif
#define SUB_SPIN(id, cond) do { if (PROBE_SUB == (id) && (cond)) { const unsigned long long _t1 = __builtin_amdgcn_s_memrealtime(), _dt = _t1 - _dt0; while (__builtin_amdgcn_s_memrealtime() - _t1 < 4 * _dt) __builtin_amdgcn_s_sleep(8); } } while (0)
#ifndef PROBE_PH
#define PROBE_PH (-1)
#endif
#define PB(k) const unsigned long long _pt0 = (PROBE_PH == (k)) ? __builtin_amdgcn_s_memrealtime() : 0ull
#define PE(k) do { if (PROBE_PH == (k)) { const unsigned long long _t1 = __builtin_amdgcn_s_memrealtime(), _dt = _t1 - _pt0; while (__builtin_amdgcn_s_memrealtime() - _t1 < 4 * _dt) __builtin_amdgcn_s_sleep(8); } } while (0)
#define IN(k) (lo <= (k) && (k) < hi)
#define SEAM(k) do { if (IN(k) && IN((k) + 1)) xcd_barrier(bar); } while (0)
template <int L>
__device__ __forceinline__ void layer_phases(Frame& F, const Args& args, const XcdBarrier& bar, const int lo, const int hi) {
    constexpr int pb = 2 + 9 * L;
    unsigned char* const ws = args.ws;
    float* const xs = args.out;
    if (IN(pb + 0)) { PB(pb + 0);
        pg8::Gemm g{(const bf16*)(ws + WS_ABUF), (const bf16*)(ws + WS_WIN) + (size_t)L * INC * DM, MT, INC, DM}; pg8::StaticOrder S; S.init(MT, INC, F.G, (int)blockIdx.x);
        pg8::EpiIn E{(bf16*)(ws + WS_PROJ), (const float*)(ws + WS_ROPE), (const float*)(ws + WS_LB) + (size_t)L * 1024};
        pg8::gemm_phase<pg8::EpiIn, pg8::StaticOrder, PG8_ALIGN, PG8_SP2>(F.lds, g, S, E);
        SEAM(pb + 0); PE(pb + 0);
    }
    if (IN(pb + 1)) { PB(pb + 1); DBG_T0(); if (F.G >= 128) { if (F.vcu < 64) { gla_chain(F, (const bf16*)(ws + WS_PROJ), (bf16*)(ws + WS_ODIR), F.vcu); DBG_PUT(0, L == 0 && F.vcu == 0); SUB_SPIN(1, L == 0); }
                               else { attn_mfma(F, (const bf16*)(ws + WS_PROJ), (bf16*)(ws + WS_ATTO), (float*)(ws + WS_LSE), (F.vcu - 64) * NWAVES + F.wave, (F.G - 64) * NWAVES); __syncthreads(); DBG_PUT(1, L == 0 && F.vcu == 64); SUB_SPIN(2, L == 0); } }
          else { attn_mfma(F, (const bf16*)(ws + WS_PROJ), (bf16*)(ws + WS_ATTO), (float*)(ws + WS_LSE), F.vcu * NWAVES + F.wave, F.G * NWAVES); gla_simple(F, (const bf16*)(ws + WS_PROJ), (bf16*)(ws + WS_ODIR)); } SEAM(pb + 1); PE(pb + 1); }
    if (IN(pb + 2)) { PB(pb + 2); combine_phase(F, (const bf16*)(ws + WS_PROJ), (const bf16*)(ws + WS_ATTO), (const float*)(ws + WS_LSE), (const bf16*)(ws + WS_ODIR), (const float*)args.in[5] + (size_t)L * 512, (const float*)args.in[6] + (size_t)L * 512, (bf16*)(ws + WS_ABUF)); SEAM(pb + 2); PE(pb + 2); }
    if (IN(pb + 3)) { PB(pb + 3);
        pg8::Gemm g{(const bf16*)(ws + WS_ABUF), (const bf16*)(ws + WS_WOUT) + (size_t)L * DM * DM, MT, DM, DM}; pg8::StaticOrder S; S.init(MT, DM, F.G, (int)blockIdx.x);
        pg8::EpiRes E{L == 0 ? (const float*)args.in[0] : (const float*)xs, xs, (const float*)(ws + WS_ADA) + (size_t)(L * 2 + 0) * 8 * 3072, DN_ALPHA};
        pg8::gemm_phase<pg8::EpiRes, pg8::StaticOrder, PG8_ALIGN, PG8_SP2>(F.lds, g, S, E);
        SEAM(pb + 3); PE(pb + 3);
    }
    const float* const ada1 = (const float*)(ws + WS_ADA) + (size_t)(L * 2 + 1) * 8 * 3072;
    const float* const lng = (const float*)args.in[10] + (size_t)L * 2 * DM; const float* const lnb = (const float*)args.in[11] + (size_t)L * 2 * DM;
    if constexpr (L == 0) {
        if (IN(pb + 4)) { PB(pb + 4); ln_phase<0>(F, xs, lng, lnb, ada1, (bf16*)(ws + WS_ABUF), nullptr, nullptr); if (IN(pb + 6)) xcd_barrier(bar); PE(pb + 4); }
        if (IN(pb + 6)) { PB(pb + 6);
            pg8::Gemm g{(const bf16*)(ws + WS_ABUF), (const bf16*)(ws + WS_WGU), MT, 2 * FFDP, DM}; pg8::StaticOrder S; S.init(MT, 2 * FFDP, F.G, (int)blockIdx.x);
            pg8::EpiGU<FFDP, 22> E{(bf16*)(ws + WS_HID)};
            pg8::gemm_phase<pg8::EpiGU<FFDP, 22>, pg8::StaticOrder, PG8_ALIGN, PG8_SP2>(F.lds, g, S, E);
            SEAM(pb + 6); PE(pb + 6);
        }
        if (IN(pb + 7)) { PB(pb + 7);
            pg8::Gemm g{(const bf16*)(ws + WS_HID), (const bf16*)(ws + WS_WDN), MT, DM, FFDP}; pg8::StaticOrder S; S.init(MT, DM, F.G, (int)blockIdx.x);
            pg8::EpiRes E{(const float*)xs, xs, ada1, DN_ALPHA};
            pg8::gemm_phase<pg8::EpiRes, pg8::StaticOrder, PG8_ALIGN, PG8_SP2>(F.lds, g, S, E);
            SEAM(pb + 7); PE(pb + 7);
        }
        if (IN(pb + 8)) { PB(pb + 8); ln_phase<0>(F, xs, lng + DM, lnb + DM, (const float*)(ws + WS_ADA) + (size_t)2 * 8 * 3072, (bf16*)(ws + WS_ABUF), nullptr, nullptr); SEAM(pb + 8); PE(pb + 8); }
    } else {
        unsigned* const route = (unsigned*)(ws + WS_ROUTE); unsigned* const rowinfo = (unsigned*)(ws + WS_ROWINFO);
        if (IN(pb + 4)) { PB(pb + 4); ln_phase<1>(F, xs, lng, lnb, ada1, nullptr, (const float*)args.in[15], route); SEAM(pb + 4); PE(pb + 4); }
        if (IN(pb + 5)) { PB(pb + 5); gather_phase(F, xs, ada1, route, ws + WS_GATH, rowinfo); SEAM(pb + 5); PE(pb + 5); }
        if (IN(pb + 6)) { PB(pb + 6);
            int off[9], cnt[8]; moe_offsets(F, off, cnt);
            const int nT = off[8] >> 8;
            pg8::Gemm g{(const bf16*)(ws + WS_GATH), (const bf16*)(ws + WS_WMGU), nT * 256, 2 * FFE, DM / 2};
            pg8::MoeOrder S; S.init(nT * 256, 2 * FFE, F.G, (int)blockIdx.x);
            S.ts1 = off[1] >> 8; S.ts2 = off[2] >> 8; S.ts3 = off[3] >> 8; S.ts4 = off[4] >> 8; S.ts5 = off[5] >> 8; S.ts6 = off[6] >> 8; S.ts7 = off[7] >> 8; S.nNloc = 28;
            pg8::EpiGU8 E{ws + WS_HID};
            pg8::gemm_phase<pg8::EpiGU8, pg8::MoeOrder, PG8_ALIGN, PG8_SP2, true>(F.lds, g, S, E);
            SEAM(pb + 6); PE(pb + 6);
        }
        if (IN(pb + 7)) { PB(pb + 7);
            int off[9], cnt[8]; moe_offsets(F, off, cnt);
            const int nT = off[8] >> 8;
            pg8::Gemm g{(const bf16*)(ws + WS_HID), (const bf16*)(ws + WS_WMDN), nT * 256, DM, FFE / 2};
            pg8::MoeOrder S; S.init(nT * 256, DM, F.G, (int)blockIdx.x);
            S.ts1 = off[1] >> 8; S.ts2 = off[2] >> 8; S.ts3 = off[3] >> 8; S.ts4 = off[4] >> 8; S.ts5 = off[5] >> 8; S.ts6 = off[6] >> 8; S.ts7 = off[7] >> 8; S.nNloc = 4;
            pg8::EpiMoeDn E{rowinfo, (bf16*)(ws + WS_YSLOT)};
            pg8::gemm_phase<pg8::EpiMoeDn, pg8::MoeOrder, PG8_ALIGN, PG8_SP2, true>(F.lds, g, S, E);
            SEAM(pb + 7); PE(pb + 7);
        }
        if (IN(pb + 8)) { PB(pb + 8); final_phase(F, xs, (const bf16*)(ws + WS_YSLOT), ada1, lng + DM, lnb + DM); PE(pb + 8); }
    }
}

__global__ void __launch_bounds__(NWAVES * 64, 2) fwd_kernel(Args args) {
    extern __shared__ __attribute__((aligned(16))) unsigned char lds[];
    Frame F;
    F.lds = (LAS unsigned char*)lds; F.ws = args.ws; F.ctl = (gu32*)(args.ws + WS_CTL);
    F.tid = threadIdx.x; F.lane = F.tid & 63; F.wave = __builtin_amdgcn_readfirstlane(F.tid >> 6);
    F.G = gridDim.x; { const int bx = blockIdx.x; F.vcu = (F.G % 8 == 0) ? (bx % 8) * (F.G / 8) + bx / 8 : bx; }
    volatile LAS unsigned* MISC = (volatile LAS unsigned*)(F.lds + MISC_OFF);
    for (int u = F.tid; u < (LDS_BYTES - 131072) / 4; u += NWAVES * 64) ((LAS unsigned*)(F.lds + 131072))[u] = 0u;
    __syncthreads();
    XcdBarrier bar; bar.bar = (unsigned*)(F.ctl + CW_BAR); bar.x = 0; bar.st = nullptr;
    const int lo = args.ph_lo, hi = args.ph_hi;
    if (hi - lo > 1) bar = xcd_barrier_post((unsigned*)(F.ctl + CW_BAR), MISC + 8);
    if (IN(0)) { PB(0); p0_prologue(F, args); SEAM(0); PE(0); }
    if (IN(1)) { PB(1); p1_mod0(F, (const float*)args.in[0], (const float*)(args.ws + WS_ADA), (bf16*)(args.ws + WS_ABUF)); SEAM(1); PE(1); }
    layer_phases<0>(F, args, bar, lo, hi);
    layer_phases<1>(F, args, bar, lo, hi);
}
#undef IN
#undef SEAM

extern "C" void kernel_launch(void* const* d_in, const int* in_sizes, int n_in, void* d_out, int out_size, void* d_ws, size_t ws_size, hipStream_t stream) {
    static int grid = 0;
    if (grid == 0) {
        int dev = 0, cus = 0, per_cu = 0;
        if (n_in != 19 || ws_size < WS_END) { fprintf(stderr, "kernel_launch: unexpected n_in %d / ws_size %zu\n", n_in, ws_size); }
        if (hipGetDevice(&dev) != hipSuccess || hipDeviceGetAttribute(&cus, hipDeviceAttributeMultiprocessorCount, dev) != hipSuccess) { grid = -1; return; }
        if (hipFuncSetAttribute((const void*)fwd_kernel, hipFuncAttributeMaxDynamicSharedMemorySize, LDS_BYTES) != hipSuccess) { grid = -1; return; }
        if (hipOccupancyMaxActiveBlocksPerMultiprocessor(&per_cu, (const void*)fwd_kernel, NWAVES * 64, LDS_BYTES) != hipSuccess || per_cu < 1) fprintf(stderr, "kernel_launch: occupancy query says %d\n", per_cu);
        (void)hipGetLastError();
        grid = cus;
    }
    if (grid < 0) return;
    (void)hipMemsetAsync((char*)d_ws + WS_CTL, 0, CTL_ZERO_BYTES, stream);
    Args a{};
    for (int i = 0; i < 19; ++i) a.in[i] = d_in[i];
    a.out = (float*)d_out; a.ws = (unsigned char*)d_ws;
#if MK_N_LAUNCHES == 1
    a.ph_lo = 0; a.ph_hi = NPH;
    hipLaunchKernelGGL(fwd_kernel, dim3(grid), dim3(NWAVES * 64), LDS_BYTES, stream, a);
#else
    for (int p = 0; p < NPH; ++p) {
        if (p == 2 + 5) continue;
        a.ph_lo = p; a.ph_hi = p + 1;
        hipLaunchKernelGGL(fwd_kernel, dim3(grid), dim3(NWAVES * 64), LDS_BYTES, stream, a);
    }
#endif
}
```
